# Optimizing an MI355X kernel written in HIP

```python
import numpy as np
import jax
import jax.numpy as jnp
from jax import lax

D_MODEL = 2048
BATCH = 4
SEQ = 4096
DEPTH = 4

GRID_W = 64
CTX_LEN = 256
HEAD_DIM = 128
N_HEADS = D_MODEL // HEAD_DIM
NA_HEADS = N_HEADS // 2
GLA_HEADS = N_HEADS - NA_HEADS
NA_ROWS_MAX = 8
NA_COLS = 16
GLA_DK = HEAD_DIM // 2
GLA_DV = HEAD_DIM
GLA_GATE_RANK = 16
GLA_TAU = 16.0
GLA_CHUNK = 64
POOL_WINDOWS = (2, 4, 8, 16)
POOL_GROUP = D_MODEL // 4
D_FF = 5632
ROPE_BASE = 10000.0
EPS = 1e-6
N_EVEN = (DEPTH + 1) // 2
N_ODD = DEPTH // 2
A_W = NA_HEADS * HEAD_DIM
BQK_W = GLA_HEADS * GLA_DK
BV_W = GLA_HEADS * GLA_DV
IN_SPLITS = (A_W, A_W, A_W, BQK_W, BQK_W, BV_W, BV_W, 2 * GLA_GATE_RANK)
D_IN = 3 * A_W + 2 * BQK_W + 2 * BV_W + 2 * GLA_GATE_RANK

kernel_name = 'hybrid_natten_gla_pool_dit'


def _rmsnorm(x, g):
    xf = x.astype(jnp.float32)
    y = xf * lax.rsqrt(jnp.mean(xf * xf, axis=-1, keepdims=True) + EPS)
    return (y * g.astype(jnp.float32)).astype(x.dtype)


def _modulate(h, shift, scale):
    return h * (1 + scale) + shift


def _split_heads(a, n):
    b, l, _ = a.shape
    return a.reshape(b, l, n, -1).transpose(0, 2, 1, 3)


def _merge_heads(a):
    b, h, l, d = a.shape
    return a.transpose(0, 2, 1, 3).reshape(b, l, h * d)


def _flip(a):
    return a[:, :, ::-1]


def _axial_rope(x, seq_len):
    t = jnp.arange(seq_len)
    row = (t // GRID_W).astype(jnp.float32)
    col = (t % GRID_W).astype(jnp.float32)
    half = x.shape[-1] // 2
    nf = half // 2
    inv = ROPE_BASE ** (-jnp.arange(nf, dtype=jnp.float32) / nf)

    def rot(xh, pos):
        ang = pos[:, None] * inv[None, :]
        cos = jnp.cos(ang).astype(xh.dtype)
        sin = jnp.sin(ang).astype(xh.dtype)
        x1, x2 = xh[..., :nf], xh[..., nf:]
        return jnp.concatenate([x1 * cos - x2 * sin, x2 * cos + x1 * sin], axis=-1)

    return jnp.concatenate([rot(x[..., :half], row), rot(x[..., half:], col)], axis=-1)


def _dense_attention(q, k, v):
    s = jnp.einsum('bhqd,bhkd->bhqk', q, k).astype(jnp.float32) * (q.shape[-1] ** -0.5)
    p = jax.nn.softmax(s, axis=-1).astype(v.dtype)
    return jnp.einsum('bhqk,bhkd->bhqd', p, v)


def _neighbourhood_attention(q, k, v, k_ctx, v_ctx, rpb):
    b, h, seq_len, dh = q.shape
    rows = seq_len // GRID_W
    wr = min(NA_ROWS_MAX, rows)
    band = wr * GRID_W
    scale = dh ** -0.5
    qcol = jnp.arange(GRID_W)
    kcol = jnp.arange(GRID_W)
    cstart = jnp.clip(qcol - NA_COLS // 2, 0, GRID_W - NA_COLS)
    col_in = (kcol[None, :] >= cstart[:, None]) & (kcol[None, :] < cstart[:, None] + NA_COLS)
    mask = jnp.broadcast_to(col_in[:, None, :], (GRID_W, wr, GRID_W)).reshape(GRID_W, band)
    dc_idx = jnp.clip(kcol[None, :] - qcol[:, None] + NA_COLS - 1, 0, 2 * NA_COLS - 2)
    col_bias = rpb[:, :, dc_idx]

    def row_block(r):
        rstart = jnp.clip(r - wr // 2, 0, rows - wr)
        qr = lax.dynamic_slice_in_dim(q, r * GRID_W, GRID_W, axis=2)
        kb = lax.dynamic_slice_in_dim(k, rstart * GRID_W, band, axis=2)
        vb = lax.dynamic_slice_in_dim(v, rstart * GRID_W, band, axis=2)
        dr_idx = rstart + jnp.arange(wr) - r + NA_ROWS_MAX - 1
        bias = col_bias[:, dr_idx].transpose(0, 2, 1, 3).reshape(h, GRID_W, band)
        s_loc = jnp.einsum('bhqd,bhkd->bhqk', qr, kb).astype(jnp.float32) * scale + bias[None].astype(jnp.float32)
        s_loc = jnp.where(mask, s_loc, -jnp.inf)
        s_ctx = jnp.einsum('bhqd,bhkd->bhqk', qr, k_ctx).astype(jnp.float32) * scale
        p = jax.nn.softmax(jnp.concatenate([s_loc, s_ctx], axis=-1), axis=-1).astype(v.dtype)
        return (jnp.einsum('bhqk,bhkd->bhqd', p[..., :band], vb)
                + jnp.einsum('bhqk,bhkd->bhqd', p[..., band:], v_ctx))

    out = lax.map(row_block, jnp.arange(rows))
    return out.transpose(1, 2, 0, 3, 4).reshape(b, h, seq_len, dh)


def _gla_chunked(q, k, v, g, s0):
    b, h, seq_len, dk = q.shape
    dv = v.shape[-1]
    n = seq_len // GLA_CHUNK
    out_dtype = v.dtype

    def to_chunks(a):
        return a.astype(jnp.float32).reshape(b, h, n, GLA_CHUNK, a.shape[-1]).transpose(2, 0, 1, 3, 4)

    lower = jnp.tril(jnp.ones((GLA_CHUNK, GLA_CHUNK), dtype=bool))

    def step(s, inp):
        qc, kc, vc, gc = inp
        cum = jnp.cumsum(gc, axis=2)
        o_inter = jnp.einsum('bhcd,bhde->bhce', qc * jnp.exp(cum), s)
        diff = cum[:, :, :, None, :] - cum[:, :, None, :, :]
        decay = jnp.where(lower[:, :, None], jnp.exp(jnp.minimum(diff, 0.0)), 0.0)
        attn = jnp.einsum('bhid,bhjd,bhijd->bhij', qc, kc, decay)
        o_intra = jnp.einsum('bhij,bhje->bhie', attn, vc)
        last = cum[:, :, -1:, :]
        s_new = jnp.exp(last[:, :, 0, :])[..., None] * s + jnp.einsum('bhcd,bhce->bhde', kc * jnp.exp(last - cum), vc)
        return s_new, o_inter + o_intra

    s_fin, o = lax.scan(step, s0, (to_chunks(q), to_chunks(k), to_chunks(v), to_chunks(g)))
    o = o.transpose(1, 2, 0, 3, 4).reshape(b, h, seq_len, dv)
    return o.astype(out_dtype), s_fin


def _gla_final_state(k, v, g):
    cum = jnp.cumsum(g, axis=2)
    return jnp.einsum('bhld,bhle->bhde', k.astype(jnp.float32) * jnp.exp(cum[:, :, -1:] - cum), v.astype(jnp.float32))


def _project_even(h, w_in, w_gate2, b_gate):
    p = h @ w_in
    offs = np.cumsum(IN_SPLITS)[:-1].tolist()
    qa, ka, va, qb, kb, vb, gb, ab = jnp.split(p, offs, axis=-1)
    log_gates = []
    for d in range(2):
        z = ab[..., d * GLA_GATE_RANK:(d + 1) * GLA_GATE_RANK] @ w_gate2[d] + b_gate[d]
        log_gates.append(_split_heads(jax.nn.log_sigmoid(z.astype(jnp.float32)) / GLA_TAU, GLA_HEADS))
    return (_split_heads(qa, NA_HEADS), _split_heads(ka, NA_HEADS), _split_heads(va, NA_HEADS),
            _split_heads(qb, GLA_HEADS), _split_heads(kb, GLA_HEADS), _split_heads(vb, GLA_HEADS),
            gb, log_gates[0], log_gates[1])


def _combine(oa, ob, gb, gla_g, w_out):
    ob = _rmsnorm(ob, gla_g[:, None, :])
    ob = _merge_heads(ob) * jax.nn.silu(gb)
    return jnp.concatenate([_merge_heads(oa), ob], axis=-1) @ w_out


def _even_mixer(h_lat, h_ctx, w_in, w_gate2, b_gate, rpb, gla_g, w_out, need_ctx):
    qa, ka, va, qb, kb, vb, gb, lgf, lgb = _project_even(h_lat, w_in, w_gate2, b_gate)
    qa_c, ka_c, va_c, qb_c, kb_c, vb_c, gb_c, lgf_c, lgb_c = _project_even(h_ctx, w_in, w_gate2, b_gate)
    seq_len = h_lat.shape[1]
    bsz = h_lat.shape[0]
    oa = _neighbourhood_attention(qa, ka, va, ka_c, va_c, rpb)
    qs = GLA_DK ** -0.5
    qb_r = _axial_rope(qb, seq_len) * qs
    kb_r = _axial_rope(kb, seq_len)
    s0 = jnp.zeros((bsz, GLA_HEADS, GLA_DK, GLA_DV), jnp.float32)
    if need_ctx:
        ob_cf, s_f = _gla_chunked(qb_c * qs, kb_c, vb_c, lgf_c, s0)
        ob_cb, s_b = _gla_chunked(_flip(qb_c * qs), _flip(kb_c), _flip(vb_c), _flip(lgb_c), s0)
    else:
        s_f = _gla_final_state(kb_c, vb_c, lgf_c)
        s_b = _gla_final_state(_flip(kb_c), _flip(vb_c), _flip(lgb_c))
    ob_f, _ = _gla_chunked(qb_r, kb_r, vb, lgf, s_f)
    ob_b, _ = _gla_chunked(_flip(qb_r), _flip(kb_r), _flip(vb), _flip(lgb), s_b)
    y_lat = _combine(oa, ob_f + _flip(ob_b), gb, gla_g, w_out)
    y_ctx = None
    if need_ctx:
        oa_c = _dense_attention(qa_c, ka_c, va_c)
        y_ctx = _combine(oa_c, ob_cf + _flip(ob_cb), gb_c, gla_g, w_out)
    return y_lat, y_ctx


def _pool_mix(h, w_pool, pool_scale):
    b, seq_len, d = h.shape
    hf = h.astype(jnp.float32)
    cs = jnp.concatenate([jnp.zeros((b, 1, d), jnp.float32), jnp.cumsum(hf, axis=1)], axis=1)
    t = jnp.arange(seq_len)
    groups = []
    for gi, w in enumerate(POOL_WINDOWS):
        lo = jnp.clip(t - w // 2, 0, seq_len)
        hi = jnp.clip(t + w // 2, 0, seq_len)
        sl = slice(gi * POOL_GROUP, (gi + 1) * POOL_GROUP)
        csg = cs[:, :, sl]
        cnt = (hi - lo).astype(jnp.float32)[None, :, None]
        groups.append((csg[:, hi] - csg[:, lo]) / cnt - hf[:, :, sl])
    pooled = jnp.stack(groups, axis=2).astype(h.dtype)
    y = jnp.einsum('blgc,gcd->blgd', pooled, w_pool).reshape(b, seq_len, d)
    return y * pool_scale


def _conv_ffn(h, w_up, conv_w, conv_b, w_down):
    u = h @ w_up
    val, gate = jnp.split(u, 2, axis=-1)
    gp = jnp.pad(gate, ((0, 0), (1, 1), (0, 0)))
    gate = gp[:, :-2] * conv_w[0] + gp[:, 1:-1] * conv_w[1] + gp[:, 2:] * conv_w[2] + conv_b
    return (jax.nn.gelu(gate, approximate=False) * val) @ w_down


def setup_inputs(seed: int = 0) -> dict:
    key = jax.random.key(seed)
    ks = jax.random.split(key, 24)
    f32 = jnp.float32

    def nrm(k, shape, scale):
        return jax.random.normal(k, shape, f32) * scale

    d = D_MODEL
    return {
        'x': nrm(ks[0], (BATCH, SEQ, d), 1.0),
        'c': nrm(ks[1], (BATCH, d), 1.0),
        'ctx': nrm(ks[2], (BATCH, CTX_LEN, d), 1.0),
        'c_ctx': nrm(ks[3], (d,), 1.0),
        'w_mod': nrm(ks[4], (DEPTH, d, 6 * d), 0.5 * d ** -0.5),
        'b_mod': nrm(ks[5], (DEPTH, 6 * d), 0.01),
        'norm1_g': 1.0 + nrm(ks[6], (DEPTH, d), 0.01),
        'norm2_g': 1.0 + nrm(ks[7], (DEPTH, d), 0.01),
        'w_in': nrm(ks[8], (N_EVEN, d, D_IN), d ** -0.5),
        'w_gate2': nrm(ks[9], (N_EVEN, 2, GLA_GATE_RANK, BQK_W), GLA_GATE_RANK ** -0.5),
        'b_gate': nrm(ks[10], (N_EVEN, 2, BQK_W), 0.1),
        'rpb': nrm(ks[11], (N_EVEN, NA_HEADS, 2 * NA_ROWS_MAX - 1, 2 * NA_COLS - 1), 0.1),
        'gla_norm_g': 1.0 + nrm(ks[12], (N_EVEN, GLA_HEADS, GLA_DV), 0.01),
        'w_out': nrm(ks[13], (N_EVEN, A_W + BV_W, d), (A_W + BV_W) ** -0.5),
        'pool_w': nrm(ks[14], (N_ODD, 4, POOL_GROUP, POOL_GROUP), POOL_GROUP ** -0.5),
        'pool_scale': 1.0 + nrm(ks[15], (N_ODD, d), 0.05),
        'w_up': nrm(ks[16], (DEPTH, d, 2 * D_FF), d ** -0.5),
        'conv_w': nrm(ks[17], (DEPTH, 3, D_FF), 3 ** -0.5),
        'conv_b': nrm(ks[18], (DEPTH, D_FF), 0.01),
        'w_down': nrm(ks[19], (DEPTH, D_FF, d), D_FF ** -0.5),
        'final_g': 1.0 + nrm(ks[20], (d,), 0.01),
    }


def reference(x, c, ctx, c_ctx, w_mod, b_mod, norm1_g, norm2_g, w_in, w_gate2, b_gate, rpb,
              gla_norm_g, w_out, pool_w, pool_scale, w_up, conv_w, conv_b, w_down, final_g):
    silu_c = jax.nn.silu(c)
    silu_cc = jax.nn.silu(c_ctx)
    x_lat = x
    x_ctx = ctx
    for i in range(DEPTH):
        is_even = i % 2 == 0
        need_ctx = any(j % 2 == 0 for j in range(i + 1, DEPTH))
        ctx_in = is_even or need_ctx
        sh1, sc1, g1, sh2, sc2, g2 = [m[:, None, :] for m in jnp.split(silu_c @ w_mod[i] + b_mod[i], 6, axis=-1)]
        h_lat = _modulate(_rmsnorm(x_lat, norm1_g[i]), sh1, sc1)
        if ctx_in:
            shc1, scc1, gc1, shc2, scc2, gc2 = jnp.split(silu_cc @ w_mod[i] + b_mod[i], 6, axis=-1)
            h_ctx = _modulate(_rmsnorm(x_ctx, norm1_g[i]), shc1, scc1)
        else:
            h_ctx = None
        if is_even:
            e = i // 2
            y_lat, y_ctx = _even_mixer(h_lat, h_ctx, w_in[e], w_gate2[e], b_gate[e], rpb[e],
                                       gla_norm_g[e], w_out[e], need_ctx)
        else:
            o = i // 2
            y_lat = _pool_mix(h_lat, pool_w[o], pool_scale[o])
            y_ctx = _pool_mix(h_ctx, pool_w[o], pool_scale[o]) if need_ctx else None
        x_lat = x_lat + g1 * y_lat
        x_lat = x_lat + g2 * _conv_ffn(_modulate(_rmsnorm(x_lat, norm2_g[i]), sh2, sc2),
                                       w_up[i], conv_w[i], conv_b[i], w_down[i])
        if need_ctx:
            x_ctx = x_ctx + gc1 * y_ctx
            x_ctx = x_ctx + gc2 * _conv_ffn(_modulate(_rmsnorm(x_ctx, norm2_g[i]), shc2, scc2),
                                            w_up[i], conv_w[i], conv_b[i], w_down[i])
    return _rmsnorm(x_lat, final_g)
```

```cpp
#include <hip/hip_runtime.h>
#include <cstdio>
#include <cstdint>

namespace pg8 {
#define PG8_LAS __attribute__((address_space(3)))
typedef unsigned short bf16_t;
typedef short bf16x8 __attribute__((ext_vector_type(8)));
typedef float f32x4 __attribute__((ext_vector_type(4)));
typedef float f32x2 __attribute__((ext_vector_type(2)));
typedef unsigned u32x4 __attribute__((ext_vector_type(4)));
constexpr int BM = 256, BK = 64, HALF = 128, HTB = HALF * BK * 2  , STAGE_BYTES = 8 * HTB, NXCD = 8;

__host__ __device__ __forceinline__ int lds_byte(int r, int c) { const int st = (r >> 4) * 2 + (c >> 5), rr = r & 15, cc = c & 31, ob = rr * 64 + cc * 2; return st * 1024 + (ob ^ (((ob >> 9) & 1) << 5)); }
__host__ __device__ __forceinline__ void stage_rc(int b, int& R, int& C) { const int st = b / 1024, sb = b % 1024, swz = sb ^ (((sb >> 9) & 1) << 5); R = (st >> 1) * 16 + swz / 64; C = (st & 1) * 32 + (swz % 64) / 2; }
__host__ __device__ __forceinline__ int perm32(int rho) { const int n = rho >> 4, i = rho & 15; return 8 * (i >> 2) + 4 * n + (i & 3); }

struct Unit { int pm, pn, grp, kt0, nkt, atomic; };
struct Gemm { const bf16_t* A; const bf16_t* Bt; int M, N, K, lda, ldb, ngrp; size_t gsA, gsB; };

struct StaticOrder {
    int nM, nN, nNr, nwg, G, c, nktK, WGM = 4;
    __host__ __device__ void init(int M, int N, int K, int ngrp, int G_, int c_) { nM = M / BM; nNr = N / BM; nN = nNr * ngrp; nwg = nM * nN; G = G_; c = c_; nktK = K / BK; }
    __host__ __device__ bool next(int i, Unit& u) const {
        const long L = (long)i * G + c; if (L >= nwg) return false;
        int wgid = (int)L; { const int q = nwg / NXCD, r = nwg % NXCD, xcd = wgid % NXCD, off = wgid / NXCD; wgid = (xcd < r ? xcd * (q + 1) : r * (q + 1) + (xcd - r) * q) + off; }
        int nig = WGM * nN, nr = nNr;
#if defined(__HIP_DEVICE_COMPILE__)
        asm volatile("" : "+s"(nig), "+s"(nr));
#endif
        const int gid = wgid / nig, fm = gid * WGM, gsz = (nM - fm) < WGM ? (nM - fm) : WGM;
        u.pm = fm + ((wgid % nig) % gsz); const int vn = (wgid % nig) / gsz; u.pn = vn % nr; u.grp = vn / nr; u.kt0 = 0; u.nkt = nktK; u.atomic = 0; return true;
    }
    __device__ __forceinline__ void a_ready(const Unit&) const {}
    __device__ __forceinline__ void done(const Unit&) const {}
};
struct SplitTailOrder {
    StaticOrder main; int nA, nB, nNr, SK, nks, pmB, G, c;
    __host__ __device__ void init(int MA, int MB, int N, int K, int SK_, int G_, int c_) { main.init(MA, N, K, 1, G_, c_); nA = main.nwg; nNr = N / BM; SK = SK_; nks = (K / BK) / SK_; pmB = MA / BM; nB = (MB / BM) * nNr * SK_; G = G_; c = c_; }
    __host__ __device__ bool next(int i, Unit& u) const {
        const long L = (long)i * G + c;
        if (L < nA) return main.next(i, u);
        const int Lb = (int)(L - nA); if (Lb >= nB) return false;
        const int ks = Lb % SK, tile = Lb / SK; u.pn = tile % nNr; u.pm = pmB + tile / nNr; u.grp = 0; u.kt0 = ks * nks; u.nkt = nks; u.atomic = 1 + ks; return true;
    }
    __device__ __forceinline__ void a_ready(const Unit&) const {}
    __device__ __forceinline__ void done(const Unit&) const {}
};

__device__ __forceinline__ unsigned cvt_pk_bf16(float lo, float hi) { unsigned r; asm volatile("v_cvt_pk_bf16_f32 %0, %1, %2" : "=v"(r) : "v"(lo), "v"(hi)); return r; }
typedef _Float16 f16x2 __attribute__((ext_vector_type(2)));
__device__ __forceinline__ unsigned pk_h2(float lo, float hi) { f16x2 p; p.x = (_Float16)__builtin_amdgcn_fmed3f(lo, -65504.0f, 65504.0f); p.y = (_Float16)__builtin_amdgcn_fmed3f(hi, -65504.0f, 65504.0f); return __builtin_bit_cast(unsigned, p); }
__device__ __forceinline__ float h_lo(unsigned w) { return (float)__builtin_bit_cast(f16x2, w).x; }
__device__ __forceinline__ float h_hi(unsigned w) { return (float)__builtin_bit_cast(f16x2, w).y; }
template <unsigned BITS> __device__ __forceinline__ float kc() { float r; asm volatile("s_mov_b32 %0, %1" : "=s"(r) : "n"(BITS)); return r; }
__device__ __forceinline__ void gelu4(const f32x2 (&v)[4], f32x2 (&o)[4]) {
    f32x2 c[4], w[4], q[4];
#pragma unroll
    for (int p = 0; p < 4; ++p) { c[p].x = __builtin_amdgcn_fmed3f(v[p].x, -5.0f, 5.0f); c[p].y = __builtin_amdgcn_fmed3f(v[p].y, -5.0f, 5.0f); w[p] = (c[p] * c[p]) * 0.08f + (-1.0f); }
    { const float ka = kc<0x3a40c646u>(), kb = kc<0xbadbc5c1u>();
#pragma unroll
      for (int p = 0; p < 4; ++p) q[p] = w[p] * ka + kb; }
    { const float kk = kc<0x3ab42bcbu>();
#pragma unroll
      for (int p = 0; p < 4; ++p) q[p] = q[p] * w[p] + kk; }
    { const float kk = kc<0xbb259aa1u>();
#pragma unroll
      for (int p = 0; p < 4; ++p) q[p] = q[p] * w[p] + kk; }
    { const float kk = kc<0x3bddb9bfu>();
#pragma unroll
      for (int p = 0; p < 4; ++p) q[p] = q[p] * w[p] + kk; }
    { const float kk = kc<0xbc394185u>();
#pragma unroll
      for (int p = 0; p < 4; ++p) q[p] = q[p] * w[p] + kk; }
    { const float kk = kc<0x3c85018cu>();
#pragma unroll
      for (int p = 0; p < 4; ++p) q[p] = q[p] * w[p] + kk; }
    { const float kk = kc<0xbcbe2975u>();
#pragma unroll
      for (int p = 0; p < 4; ++p) q[p] = q[p] * w[p] + kk; }
    { const float kk = kc<0x3d00edc6u>();
#pragma unroll
      for (int p = 0; p < 4; ++p) q[p] = q[p] * w[p] + kk; }
    { const float kk = kc<0xbd25b03eu>();
#pragma unroll
      for (int p = 0; p < 4; ++p) q[p] = q[p] * w[p] + kk; }
    { const float kk = kc<0x3d530477u>();
#pragma unroll
      for (int p = 0; p < 4; ++p) q[p] = q[p] * w[p] + kk; }
    { const float kk = kc<0xbd8ff74du>();
#pragma unroll
      for (int p = 0; p < 4; ++p) q[p] = q[p] * w[p] + kk; }
    { const float kk = kc<0x3e10c1adu>();
#pragma unroll
      for (int p = 0; p < 4; ++p) q[p] = q[p] * w[p] + kk; }
#pragma unroll
    for (int p = 0; p < 4; ++p) o[p] = v[p] * (q[p] * c[p] + 0.5f);
}

__device__ __forceinline__ f32x2 gelu_pk(f32x2 v) {
    f32x2 c; c.x = __builtin_amdgcn_fmed3f(v.x, -5.0f, 5.0f); c.y = __builtin_amdgcn_fmed3f(v.y, -5.0f, 5.0f);
    const f32x2 w = (c * c) * 0.08f + (-1.0f);
    f32x2 q = w * 7.353763795e-04f + (-1.676730928e-03f);
    q = q * w + 1.374596148e-03f; q = q * w + (-2.526916796e-03f); q = q * w + 6.766527425e-03f; q = q * w + (-1.130712498e-02f); q = q * w + 1.623608917e-02f;
    q = q * w + (-2.321312763e-02f); q = q * w + 3.147675842e-02f; q = q * w + (-4.045128077e-02f); q = q * w + 5.151792988e-02f; q = q * w + (-7.029590756e-02f); q = q * w + 1.413638145e-01f;
    return v * (q * c + 0.5f);
}

struct EpiBf16 {
    static constexpr bool PERM = true;
    bf16_t* O; int ldc;
    __device__ __forceinline__ void operator()(const f32x4 (&acc)[2][2][4][2], const Unit& u, int wr, int wc, int fr, int fq) const {
        const int row0 = u.pm * BM + wr * 64 + fr; const int col0 = u.pn * BM + wc * 32 + 8 * fq;
#pragma unroll
        for (int ai = 0; ai < 2; ++ai)
#pragma unroll
            for (int m = 0; m < 4; ++m) { bf16_t* rowp = O + (size_t)(row0 + ai * HALF + m * 16) * ldc + col0;
#pragma unroll
                for (int bj = 0; bj < 2; ++bj) { const f32x4 v0 = acc[ai][bj][m][0], v1 = acc[ai][bj][m][1];
                    u32x4 w; w.x = cvt_pk_bf16(v0[0], v0[1]); w.y = cvt_pk_bf16(v0[2], v0[3]); w.z = cvt_pk_bf16(v1[0], v1[1]); w.w = cvt_pk_bf16(v1[2], v1[3]);
                    *(u32x4*)(rowp + bj * HALF) = w; } }
    }
};
struct EpiGlu {
    static constexpr bool PERM = true;
    bf16_t* ACT; int ldc; const float* cw; const float* cb; float* SB; int dff; PG8_LAS float* XB;
    static __device__ __forceinline__ float ror1(float v)  { return __builtin_bit_cast(float, __builtin_amdgcn_update_dpp(0, __builtin_bit_cast(int, v), 0x121, 0xf, 0xf, true)); }
    static __device__ __forceinline__ float ror15(float v) { return __builtin_bit_cast(float, __builtin_amdgcn_update_dpp(0, __builtin_bit_cast(int, v), 0x12f, 0xf, 0xf, true)); }
    __device__ __forceinline__ void operator()(const f32x4 (&acc)[2][2][4][2], const Unit& u, int wr, int wc, int fr, int fq) const {
        const int ch0 = u.pn * HALF + wc * 32 + 8 * fq; const bool l0 = (fr == 0), l15 = (fr == 15);
        PG8_LAS float* xme = XB + ((wr * 4 + wc) * 4) * 32 + fq * 8;
#pragma unroll
        for (int ai = 0; ai < 2; ++ai) {
            if (fr == 0)  { *(PG8_LAS f32x4*)(xme + (ai * 2 + 0) * 32) = acc[ai][1][0][0]; *(PG8_LAS f32x4*)(xme + (ai * 2 + 0) * 32 + 4) = acc[ai][1][0][1]; }
            if (fr == 15) { *(PG8_LAS f32x4*)(xme + (ai * 2 + 1) * 32) = acc[ai][1][3][0]; *(PG8_LAS f32x4*)(xme + (ai * 2 + 1) * 32 + 4) = acc[ai][1][3][1]; }
        }
        asm volatile("s_waitcnt lgkmcnt(0)" ::: "memory"); __builtin_amdgcn_s_barrier(); asm volatile("" ::: "memory");
        f32x4 w0[2], w1[2], w2[2], bb[2];
#pragma unroll
        for (int n = 0; n < 2; ++n) { w0[n] = *(const f32x4*)(cw + ch0 + 4 * n); w1[n] = *(const f32x4*)(cw + dff + ch0 + 4 * n); w2[n] = *(const f32x4*)(cw + 2 * dff + ch0 + 4 * n); bb[n] = *(const f32x4*)(cb + ch0 + 4 * n); }
#pragma unroll
        for (int ai = 0; ai < 2; ++ai) {
            const int rp = 128 * ai + 64 * wr - 1, rn = 128 * ai + 64 * wr + 64;
            f32x4 xp[2], xn[2];
#pragma unroll
            for (int n = 0; n < 2; ++n) { xp[n] = (f32x4){0.f, 0.f, 0.f, 0.f}; xn[n] = (f32x4){0.f, 0.f, 0.f, 0.f}; }
            if (rp >= 0)  { const PG8_LAS float* s = XB + ((((rp >> 6) & 1) * 4 + wc) * 4 + (rp >> 7) * 2 + 1) * 32 + fq * 8; xp[0] = *(const PG8_LAS f32x4*)s; xp[1] = *(const PG8_LAS f32x4*)(s + 4); }
            if (rn < 256) { const PG8_LAS float* s = XB + ((((rn >> 6) & 1) * 4 + wc) * 4 + (rn >> 7) * 2 + 0) * 32 + fq * 8; xn[0] = *(const PG8_LAS f32x4*)s; xn[1] = *(const PG8_LAS f32x4*)(s + 4); }
#pragma unroll
            for (int m = 0; m < 4; ++m) {
                const int row = u.pm * BM + ai * HALF + wr * 64 + m * 16 + fr;
                u32x4 ow; float cv[8];
#pragma unroll
                for (int n = 0; n < 2; ++n)
#pragma unroll
                    for (int j = 0; j < 4; ++j) {
                        const float g = acc[ai][1][m][n][j];
                        const float tp = l15 ? ((m > 0) ? acc[ai][1][m > 0 ? m - 1 : 0][n][j] : xp[n][j]) : g;
                        const float tn = l0  ? ((m < 3) ? acc[ai][1][m < 3 ? m + 1 : 3][n][j] : xn[n][j]) : g;
                        const float gp = ror1(tp), gn = ror15(tn);
                        cv[4 * n + j] = fmaf(w0[n][j], gp, fmaf(w1[n][j], g, fmaf(w2[n][j], gn, bb[n][j])));
                    }
                const int tr = ai * HALF + wr * 64 + m * 16 + fr;
                if (tr == 0 || tr == 255) { float* sb = SB + ((size_t)(u.pm * 2 + (tr ? 1 : 0)) * 3) * dff + ch0;
#pragma unroll
                    for (int n = 0; n < 2; ++n) { *(f32x4*)(sb + 4 * n) = (f32x4){cv[4 * n], cv[4 * n + 1], cv[4 * n + 2], cv[4 * n + 3]}; *(f32x4*)(sb + dff + 4 * n) = acc[ai][0][m][n]; *(f32x4*)(sb + 2 * dff + 4 * n) = acc[ai][1][m][n]; } }
                f32x2 gv[4], go[4]; float a[8];
#pragma unroll
                for (int p = 0; p < 4; ++p) gv[p] = (f32x2){cv[2 * p], cv[2 * p + 1]};
                gelu4(gv, go);
#pragma unroll
                for (int e = 0; e < 8; e += 2) { a[e] = go[e >> 1].x * acc[ai][0][m][e >> 2][e & 3]; a[e + 1] = go[e >> 1].y * acc[ai][0][m][(e + 1) >> 2][(e + 1) & 3]; }
                ow.x = cvt_pk_bf16(a[0], a[1]); ow.y = cvt_pk_bf16(a[2], a[3]); ow.z = cvt_pk_bf16(a[4], a[5]); ow.w = cvt_pk_bf16(a[6], a[7]);
                *(u32x4*)(ACT + (size_t)row * ldc + ch0) = ow;
            }
        }
    }
};
struct EpiResid {
    static constexpr bool PERM = true;
    float* PART; bf16_t* X16; int ldx; const float* gate; int gstride; const float* cscale; int gcols; int mlat; int mctx;
    __device__ __forceinline__ void operator()(const f32x4 (&acc)[2][2][4][2], const Unit& u, int wr, int wc, int fr_, int fq_) const {
        int fr = fr_, fq = fq_; asm volatile("" : "+v"(fr), "+v"(fq));
        const int row0 = u.pm * BM + wr * 64 + fr, col0 = u.grp * gcols + u.pn * BM + wc * 32 + 8 * fq;
        const int rowt = u.pm * BM; const int bidx = rowt < mlat ? (rowt >> 12) : 4;
        const float* gp = gate + (size_t)bidx * gstride + col0;
        f32x4 gv[2][2];
#pragma unroll
        for (int bj = 0; bj < 2; ++bj)
#pragma unroll
            for (int n = 0; n < 2; ++n) { gv[bj][n] = *(const f32x4*)(gp + bj * HALF + n * 4); if (cscale) gv[bj][n] = gv[bj][n] * *(const f32x4*)(cscale + col0 + bj * HALF + n * 4); }
        if (rowt >= mlat) {
            float* base = PART + ((size_t)(u.atomic ? u.atomic - 1 : 0) * mctx + (size_t)(row0 - mlat)) * ldx + col0;
            f32x4 gc[2][2] = {{gv[0][0], gv[0][1]}, {gv[1][0], gv[1][1]}}; asm volatile("" : "+v"(gc[0][0]), "+v"(gc[0][1]), "+v"(gc[1][0]), "+v"(gc[1][1]));
#pragma unroll
            for (int ai = 0; ai < 2; ++ai)
#pragma unroll
                for (int m = 0; m < 4; ++m) { float* rowp = base + (size_t)(ai * HALF + m * 16) * ldx;
#pragma unroll
                    for (int bj = 0; bj < 2; ++bj)
#pragma unroll
                        for (int n = 0; n < 2; ++n) *(f32x4*)(rowp + bj * HALF + n * 4) = acc[ai][bj][m][n] * gc[bj][n]; }
        } else {
            u32x4 xin[2][4][2];
#pragma unroll
            for (int ai = 0; ai < 2; ++ai)
#pragma unroll
                for (int m = 0; m < 4; ++m)
#pragma unroll
                    for (int bj = 0; bj < 2; ++bj) xin[ai][m][bj] = *(const u32x4*)(X16 + (size_t)(row0 + ai * HALF + m * 16) * ldx + col0 + bj * HALF);
            asm volatile("" ::: "memory");
#pragma unroll
            for (int ai = 0; ai < 2; ++ai)
#pragma unroll
                for (int m = 0; m < 4; ++m)
#pragma unroll
                    for (int bj = 0; bj < 2; ++bj) { const u32x4 h = xin[ai][m][bj]; const f32x4 a0 = acc[ai][bj][m][0] * gv[bj][0], a1 = acc[ai][bj][m][1] * gv[bj][1];
                        u32x4 w;
                        w.x = pk_h2(h_lo(h.x) + a0[0], h_hi(h.x) + a0[1]); w.y = pk_h2(h_lo(h.y) + a0[2], h_hi(h.y) + a0[3]);
                        w.z = pk_h2(h_lo(h.z) + a1[0], h_hi(h.z) + a1[1]); w.w = pk_h2(h_lo(h.w) + a1[2], h_hi(h.w) + a1[3]);
                        *(u32x4*)(X16 + (size_t)(row0 + ai * HALF + m * 16) * ldx + col0 + bj * HALF) = w; }
        }
    }
};

template <class Epi, class Sched, bool ALIGN_EPI = true>
__device__ __forceinline__ void gemm_phase(PG8_LAS unsigned char* lds, const Gemm g, const Sched& S, const Epi& E, const int tid) {
    const int wid = __builtin_amdgcn_readfirstlane(tid >> 6), lane = tid & 63, wr = wid >> 2, wc = wid & 3, fr = lane & 15, fq = lane >> 4;
    unsigned voffA[2], voffB[2];
#pragma unroll
    for (int i = 0; i < 2; ++i) { int R, C; stage_rc(tid * 16 + i * 8192, R, C); const int Rb = Epi::PERM ? ((R & ~31) + perm32(R & 31)) : R;
        voffA[i] = (unsigned)(R * g.lda + C) * 2u; voffB[i] = (unsigned)(Rb * g.ldb + C) * 2u; }
    const size_t kstep = (size_t)(BK * 2);
    const size_t hstepA = (size_t)HALF * g.lda * 2, hstepB = (size_t)HALF * g.ldb * 2;
    const size_t tstepA = 2 * hstepA, tstepB = 2 * hstepB;
    const unsigned ldsw = (unsigned)wid * 1024u;
    const int aoff = lds_byte(wr * 64 + fr, fq * 8), boff = lds_byte(wc * 32 + fr, fq * 8);
#define PG8_SA(b, h) (((b) * 2 + (h)) * HTB)
#define PG8_SB(b, h) ((4 + (b) * 2 + (h)) * HTB)
#define PG8_STAGE(bufoff, gbase, voff) do { _Pragma("unroll") for (int _i = 0; _i < 2; ++_i) \
        __builtin_amdgcn_global_load_lds((const unsigned*)((const char*)(gbase) + (voff)[_i]), (PG8_LAS unsigned*)(lds + (bufoff) + ldsw + _i * 8192), 16, 0, 0); } while (0)
#define PG8_LDA(dst, b, h) do { _Pragma("unroll") for (int m = 0; m < 4; ++m) _Pragma("unroll") for (int k = 0; k < 2; ++k) dst[m][k] = *(const PG8_LAS bf16x8*)(lds + PG8_SA(b, h) + aoff + m * 2048 + k * 1024); } while (0)
#define PG8_LDB(dst, b, h) do { _Pragma("unroll") for (int n = 0; n < 2; ++n) _Pragma("unroll") for (int k = 0; k < 2; ++k) dst[n][k] = *(const PG8_LAS bf16x8*)(lds + PG8_SB(b, h) + boff + n * 2048 + k * 1024); } while (0)
#define PG8_MMA(ai, bj, At, Bt) do { __builtin_amdgcn_s_setprio(1); _Pragma("unroll") for (int m = 0; m < 4; ++m) _Pragma("unroll") for (int n = 0; n < 2; ++n) _Pragma("unroll") for (int k = 0; k < 2; ++k) \
        acc[ai][bj][m][n] = __builtin_amdgcn_mfma_f32_16x16x32_bf16(Bt[n][k], At[m][k], acc[ai][bj][m][n], 0, 0, 0); __builtin_amdgcn_s_setprio(0); } while (0)
#define PG8_WAIT_V(n) asm volatile("s_waitcnt vmcnt(" #n ")" ::: "memory")
#define PG8_WAIT_L(n) asm volatile("s_waitcnt lgkmcnt(" #n ")" ::: "memory")
#define PG8_BAR __builtin_amdgcn_s_barrier()
#define PG8_SCHED __builtin_amdgcn_sched_barrier(0)
    Unit cur, nxt; int ui = 0;
    if (!S.next(0, cur)) return;
    f32x4 acc[2][2][4][2];
#pragma unroll
    for (int a = 0; a < 2; ++a)
#pragma unroll
        for (int b = 0; b < 2; ++b)
#pragma unroll
            for (int m = 0; m < 4; ++m)
#pragma unroll
                for (int n = 0; n < 2; ++n) acc[a][b][m][n] = (f32x4){0.f, 0.f, 0.f, 0.f};
    bf16x8 At[4][2], B0[2][2], B1[2][2];
    const char* cA = (const char*)g.A + (size_t)cur.pm * tstepA + (size_t)cur.grp * g.gsA + (size_t)cur.kt0 * kstep; const char* cB = (const char*)g.Bt + (size_t)cur.pn * tstepB + (size_t)cur.grp * g.gsB + (size_t)cur.kt0 * kstep;
    S.a_ready(cur);
    PG8_STAGE(PG8_SB(0, 0), cB, voffB); PG8_STAGE(PG8_SB(0, 1), cB + hstepB, voffB); PG8_STAGE(PG8_SA(0, 0), cA, voffA); PG8_STAGE(PG8_SA(0, 1), cA + hstepA, voffA);
    if (wr == 1) PG8_BAR;
    PG8_WAIT_V(2); PG8_BAR;
    PG8_STAGE(PG8_SB(1, 0), cB + kstep, voffB); PG8_STAGE(PG8_SA(1, 0), cA + kstep, voffA); PG8_STAGE(PG8_SB(1, 1), cB + hstepB + kstep, voffB);
    PG8_WAIT_V(6); PG8_BAR;
    for (;;) {
        const bool has_next = S.next(ui + 1, nxt);
        const char* nA = has_next ? (const char*)g.A + (size_t)nxt.pm * tstepA + (size_t)nxt.grp * g.gsA + (size_t)nxt.kt0 * kstep : cA;
        const char* nB = has_next ? (const char*)g.Bt + (size_t)nxt.pn * tstepB + (size_t)nxt.grp * g.gsB + (size_t)nxt.kt0 * kstep : cB;
        const int nt = cur.nkt;
        for (int t = 0; t < nt; t += 2) {
            const bool last = (t == nt - 2);
            const char* a1 = cA + (size_t)(t + 1) * kstep;
            const char* a2 = last ? nA : cA + (size_t)(t + 2) * kstep; const char* b2 = last ? nB : cB + (size_t)(t + 2) * kstep;
            const char* a3 = a2 + kstep; const char* b3 = b2 + kstep;
            if (last && has_next) S.a_ready(nxt);
            PG8_LDB(B0, 0, 0); PG8_LDB(B1, 0, 1); PG8_SCHED; PG8_LDA(At, 0, 0); PG8_STAGE(PG8_SA(1, 1), a1 + hstepA, voffA);
            PG8_WAIT_V(8); PG8_WAIT_L(0); PG8_BAR; PG8_MMA(0, 0, At, B0); PG8_MMA(0, 1, At, B1); PG8_BAR; PG8_SCHED;
            PG8_LDA(At, 0, 1); PG8_STAGE(PG8_SB(0, 0), b2, voffB); PG8_STAGE(PG8_SB(0, 1), b2 + hstepB, voffB); PG8_STAGE(PG8_SA(0, 0), a2, voffA);
            PG8_WAIT_V(8); PG8_WAIT_L(0); PG8_BAR; PG8_MMA(1, 0, At, B0); PG8_MMA(1, 1, At, B1); PG8_BAR; PG8_SCHED;
            PG8_LDB(B0, 1, 0); PG8_LDB(B1, 1, 1); PG8_SCHED; PG8_LDA(At, 1, 0); PG8_STAGE(PG8_SA(0, 1), a2 + hstepA, voffA);
            PG8_WAIT_V(8); PG8_WAIT_L(0); PG8_BAR; PG8_MMA(0, 0, At, B0); PG8_MMA(0, 1, At, B1); PG8_BAR; PG8_SCHED;
            PG8_LDA(At, 1, 1); PG8_STAGE(PG8_SB(1, 0), b3, voffB); PG8_STAGE(PG8_SB(1, 1), b3 + hstepB, voffB); PG8_STAGE(PG8_SA(1, 0), a3, voffA);
            PG8_WAIT_V(8); PG8_WAIT_L(0); PG8_BAR; PG8_MMA(1, 0, At, B0); PG8_MMA(1, 1, At, B1); PG8_BAR; PG8_SCHED;
        }
        if constexpr (ALIGN_EPI) { if (wr == 0) PG8_BAR; }
        E(acc, cur, wr, wc, fr, fq); S.done(cur);
        if (!has_next) break;
#pragma unroll
        for (int a = 0; a < 2; ++a)
#pragma unroll
            for (int b = 0; b < 2; ++b)
#pragma unroll
                for (int m = 0; m < 4; ++m)
#pragma unroll
                    for (int n = 0; n < 2; ++n) acc[a][b][m][n] = (f32x4){0.f, 0.f, 0.f, 0.f};
        cur = nxt; cA = nA; cB = nB; ++ui;
        if constexpr (ALIGN_EPI) { if (wr == 1) PG8_BAR; }
    }
    PG8_WAIT_V(0);
    if constexpr (!ALIGN_EPI) { if (wr == 0) PG8_BAR; }
    PG8_BAR;
#undef PG8_SA
#undef PG8_SB
#undef PG8_STAGE
#undef PG8_LDA
#undef PG8_LDB
#undef PG8_MMA
#undef PG8_WAIT_V
#undef PG8_WAIT_L
#undef PG8_BAR
#undef PG8_SCHED
}
}

namespace na {
typedef unsigned short bf16;
using bf16x8 = __attribute__((ext_vector_type(8))) short;
using s16x4  = __attribute__((ext_vector_type(4))) short;
using f32x16 = __attribute__((ext_vector_type(16))) float;
using u32x4  = __attribute__((ext_vector_type(4))) unsigned;
constexpr int   D = 128, NW = 8, QBLK = 32, KVBLK = 64;
constexpr float SCALE = 0.088388347648318440f;
constexpr float THR = 8.f;
constexpr float NEG = -1.0e30f;
constexpr size_t SHM_V = KVBLK * D * 2, SHM_K = KVBLK * D * 2, SHM_ATTN = 2 * SHM_V + 2 * SHM_K + NW * 64 * 4;
constexpr size_t BIAS_OFF = 69632;
constexpr size_t PEN_OFF = BIAS_OFF + 640 * 4;
constexpr size_t QS_OFF = 73728;
constexpr size_t LDS_END = QS_OFF + NW * 8192;
#define NA_KSWZ(row, colB) ((row) * 256 + ((colB) ^ (((row) & 7) << 4)))
#define NA_SBAR() __builtin_amdgcn_sched_barrier(0)
__device__ __forceinline__ int crow(int r, int hi) { return (r & 3) + 8 * (r >> 2) + 4 * hi; }
__device__ __forceinline__ unsigned cvtpk(float lo, float hi) { unsigned r; asm volatile("v_cvt_pk_bf16_f32 %0, %1, %2" : "=v"(r) : "v"(lo), "v"(hi)); return r; }

__device__ __forceinline__ void partialSM(f32x16& p0, f32x16& p1, float& m_reg, float& mn, float& alpha) {
  constexpr float C = SCALE * 1.4426950408889634f;
  float pmax = p0[0];
#pragma unroll
  for (int r = 1; r < 16; ++r) pmax = fmaxf(pmax, p0[r]);
#pragma unroll
  for (int r = 0; r < 16; ++r) pmax = fmaxf(pmax, p1[r]);
  { auto rr = __builtin_amdgcn_permlane32_swap(__float_as_uint(pmax), __float_as_uint(pmax), false, false);
    pmax = fmaxf(__uint_as_float(rr[0]), __uint_as_float(rr[1])); }
  if (__builtin_expect(__all(pmax - m_reg <= THR / SCALE), 1)) { mn = m_reg; alpha = 1.f; }
  else { mn = fmaxf(m_reg, pmax); alpha = __builtin_amdgcn_exp2f((m_reg - mn) * C); m_reg = mn; }
  float mnC = -mn * C;
#pragma unroll
  for (int r = 0; r < 16; ++r) p0[r] = fmaf(p0[r], C, mnC);
#pragma unroll
  for (int r = 0; r < 16; ++r) p1[r] = fmaf(p1[r], C, mnC);
#pragma unroll
  for (int r = 0; r < 16; ++r) p0[r] = __builtin_amdgcn_exp2f(p0[r]);
}
__device__ __forceinline__ void finishSM(f32x16& p0, f32x16& p1, float alpha, float& l_reg, bf16x8& pa0, bf16x8& pa1, bf16x8& pa2, bf16x8& pa3) {
#pragma unroll
  for (int r = 0; r < 16; ++r) p1[r] = __builtin_amdgcn_exp2f(p1[r]);
  float ps = 0;
#pragma unroll
  for (int r = 0; r < 16; ++r) ps += p0[r];
#pragma unroll
  for (int r = 0; r < 16; ++r) ps += p1[r];
  { auto rr = __builtin_amdgcn_permlane32_swap(__float_as_uint(ps), __float_as_uint(ps), false, false);
    ps = __uint_as_float(rr[0]) + __uint_as_float(rr[1]); }
  l_reg = l_reg * alpha + ps;
#define NA_PK4(P, BASE, OUT) do { unsigned a0 = cvtpk(P[BASE + 0], P[BASE + 1]), a1 = cvtpk(P[BASE + 2], P[BASE + 3]);   \
    unsigned b0 = cvtpk(P[BASE + 4], P[BASE + 5]), b1 = cvtpk(P[BASE + 6], P[BASE + 7]);                              \
    auto r0 = __builtin_amdgcn_permlane32_swap(a0, b0, false, false); auto r1 = __builtin_amdgcn_permlane32_swap(a1, b1, false, false); \
    u32x4 w = {r0[0], r1[0], r0[1], r1[1]}; OUT = *reinterpret_cast<bf16x8*>(&w); } while (0)
  NA_PK4(p0, 0, pa0); NA_PK4(p0, 8, pa1); NA_PK4(p1, 0, pa2); NA_PK4(p1, 8, pa3);
#undef NA_PK4
}
__device__ __forceinline__ void qkt(f32x16& p0, f32x16& p1, const bf16* Ks, const bf16x8* qs, int r32, int hi) {
#pragma unroll
  for (int d0 = 0; d0 < 8; ++d0) { int cb = (d0 * 16 + hi * 8) * 2; const bf16x8 q = qs[d0 * 64];
    bf16x8 b0 = *reinterpret_cast<const bf16x8*>((const char*)Ks + NA_KSWZ(r32, cb));
    bf16x8 b1 = *reinterpret_cast<const bf16x8*>((const char*)Ks + NA_KSWZ(32 + r32, cb));
    p0 = __builtin_amdgcn_mfma_f32_32x32x16_bf16(b0, q, p0, 0, 0, 0);
    p1 = __builtin_amdgcn_mfma_f32_32x32x16_bf16(b1, q, p1, 0, 0, 0); }
}
__device__ __forceinline__ int v_st(int k, int c) { const int kk = (k & ~0xC) | ((k & 4) << 1) | ((k & 8) >> 1); return ((kk >> 3) * 4 + (c >> 5)) * 512 + ((kk & 7) * 32 + (c & 31)) * 2; }
__device__ __forceinline__ int v_rd_base(int lane) { return ((lane & 3) << 3) | (((lane >> 2) & 3) << 6) | (((lane >> 4) & 1) << 5) | (((lane >> 5) & 1) << 8); }
constexpr int v_rd_off(int d0, int ks, int half) { return d0 * 512 + ks * 4096 + half * 2048; }
template <int OFF> __device__ __forceinline__ s16x4 tr_read(int vb) {
  s16x4 r; asm volatile("ds_read_b64_tr_b16 %0, %1 offset:%2" : "=&v"(r) : "v"(vb), "i"(OFF) : "memory"); return r;
}
template <int D0> __device__ __forceinline__ void pv_one(f32x16& od, int vb, bf16x8 pa0, bf16x8 pa1, bf16x8 pa2, bf16x8 pa3) {
  const s16x4 l0 = tr_read<v_rd_off(D0, 0, 0)>(vb), h0 = tr_read<v_rd_off(D0, 0, 1)>(vb), l1 = tr_read<v_rd_off(D0, 1, 0)>(vb), h1 = tr_read<v_rd_off(D0, 1, 1)>(vb);
  const s16x4 l2 = tr_read<v_rd_off(D0, 2, 0)>(vb), h2 = tr_read<v_rd_off(D0, 2, 1)>(vb), l3 = tr_read<v_rd_off(D0, 3, 0)>(vb), h3 = tr_read<v_rd_off(D0, 3, 1)>(vb);
  asm volatile("s_waitcnt lgkmcnt(0)" ::: "memory"); NA_SBAR();
#define NA_PK(L, H) (bf16x8){L[0], L[1], L[2], L[3], H[0], H[1], H[2], H[3]}
  od = __builtin_amdgcn_mfma_f32_32x32x16_bf16(pa0, NA_PK(l0, h0), od, 0, 0, 0);
  od = __builtin_amdgcn_mfma_f32_32x32x16_bf16(pa1, NA_PK(l1, h1), od, 0, 0, 0);
  od = __builtin_amdgcn_mfma_f32_32x32x16_bf16(pa2, NA_PK(l2, h2), od, 0, 0, 0);
  od = __builtin_amdgcn_mfma_f32_32x32x16_bf16(pa3, NA_PK(l3, h3), od, 0, 0, 0);
#undef NA_PK
}
__device__ __forceinline__ void pv_d0(f32x16* o, int vb, bf16x8 pa0, bf16x8 pa1, bf16x8 pa2, bf16x8 pa3) {
  pv_one<0>(o[0], vb, pa0, pa1, pa2, pa3); pv_one<1>(o[1], vb, pa0, pa1, pa2, pa3); pv_one<2>(o[2], vb, pa0, pa1, pa2, pa3); pv_one<3>(o[3], vb, pa0, pa1, pa2, pa3);
}

__device__ __forceinline__ void init_scores(f32x16& p0, f32x16& p1, int j, int klo, int qrow, const float* bt_l, const float* pen_l) {
  if (j < 4) { p0 = f32x16{}; p1 = f32x16{}; return; }
  const int kr = klo + j - 4, rs = min(max(qrow - 4, 0), 56);
  if (kr < rs || kr >= rs + 8) {
#pragma unroll
    for (int r = 0; r < 16; ++r) { p0[r] = NEG; p1[r] = NEG; }
    return;
  }
  int zo; asm volatile("v_mov_b32 %0, 0" : "=v"(zo));
  const float* bl = bt_l + (kr - qrow + 7) * 32; pen_l += zo;
#pragma unroll
  for (int r = 0; r < 16; ++r) { const int c = (r & 3) + 8 * (r >> 2); p0[r] = bl[c] + pen_l[c]; p1[r] = bl[32 + c] + pen_l[32 + c]; }
}

template <int LDP, int LDO>
__device__ __forceinline__ void na_unit(const bf16* __restrict__ P, int qcol, int kcol, int vcol, long qrow0, long crow0, long brow0, int nband, int klo, int qg0,
                                        bf16* __restrict__ O, int ocol, const float* __restrict__ rpbh, char* lds, const int tid) {
  const int wid = tid >> 6, lane = tid & 63, r32 = lane & 31, hi = lane >> 5;
  bf16* V_lds = (bf16*)lds; bf16* K_lds = (bf16*)(lds + 2 * SHM_V);
  float* ws = (float*)(lds + 2 * SHM_V + 2 * SHM_K) + wid * 64; float* li_l = ws; float* al_l = ws + 32;
  float* blds = (float*)(lds + BIAS_OFF); float* pens = (float*)(lds + PEN_OFF);
  __syncthreads();
  if (nband > 0) {
    for (int i = tid; i < 640; i += 512) { const int t2 = i - 64, dri = t2 >> 5, dci = t2 & 31; blds[i] = (t2 >= 0 && t2 < 480 && dci < 31) ? rpbh[dri * 31 + dci] * (1.0f / SCALE) : 0.f; }
    if (tid < 128) pens[tid] = (tid >= 48 && tid < 64) ? 0.f : NEG;
  }
  float m_reg = -1e30f, l_reg = 0; f32x16 o[4] = {};
  bf16x8* qs = (bf16x8*)(lds + QS_OFF + wid * 8192) + lane;
  { const bf16* Qw = P + (qrow0 + wid * QBLK + r32) * LDP + qcol + hi * 8;
#pragma unroll
    for (int d0 = 0; d0 < 8; ++d0) qs[d0 * 64] = *reinterpret_cast<const bf16x8*>(Qw + d0 * 16); }
  const int sr = tid >> 4, sc = (tid & 15) * 8, vst0 = v_st(sr, sc), vst1 = v_st(32 + sr, sc);
  const int vb0 = (int)(uintptr_t)V_lds + v_rd_base(lane);
  const int qrow = qg0 + (wid >> 1), qc = (wid & 1) * 32 + r32;
  const float* bt_l = blds + 64 + 15 - qc + 4 * hi; const float* pen_l = pens + 48 - min(max(qc - 8, 0), 48) + 4 * hi;
  const bf16* Kh = P + kcol; const bf16* Vh = P + vcol;
  bf16x8 vs0, vs1, ks0, ks1;
#define NA_TROW(j) ((j) < 4 ? crow0 + (long)(j) * 64 : brow0 + (long)((j) - 4) * 64)
#define NA_SLOAD(j) do { const long _k0 = NA_TROW(j); vs0 = *reinterpret_cast<const bf16x8*>(&Vh[(_k0 + sr) * LDP + sc]); vs1 = *reinterpret_cast<const bf16x8*>(&Vh[(_k0 + 32 + sr) * LDP + sc]); \
    ks0 = *reinterpret_cast<const bf16x8*>(&Kh[(_k0 + sr) * LDP + sc]); ks1 = *reinterpret_cast<const bf16x8*>(&Kh[(_k0 + 32 + sr) * LDP + sc]); } while (0)
#define NA_SWRITE(b) do { *(bf16x8*)((char*)V_lds + (b) * SHM_V + vst0) = vs0; *(bf16x8*)((char*)V_lds + (b) * SHM_V + vst1) = vs1; const int kc = sc * 2; \
    *(bf16x8*)((char*)K_lds + (b) * SHM_K + NA_KSWZ(sr, kc)) = ks0; *(bf16x8*)((char*)K_lds + (b) * SHM_K + NA_KSWZ(32 + sr, kc)) = ks1; } while (0)
#define NA_RESC(a) do { if (__any((a) < 1.f)) { if (hi == 0) al_l[r32] = (a); asm volatile("s_waitcnt lgkmcnt(0)" ::: "memory"); \
    _Pragma("unroll") for (int d = 0; d < 4; ++d) _Pragma("unroll") for (int r = 0; r < 16; ++r) o[d][r] *= al_l[crow(r, hi)]; } } while (0)
  f32x16 p0, p1; float mn, al; bf16x8 pa0, pa1, pa2, pa3; const int NT = 4 + nband; const int rs_ = min(max(qrow - 4, 0), 56);
  NA_SLOAD(0);
  for (int j = 0; j < NT; ++j) {
    const int b = j & 1;
    NA_SWRITE(b);
    if (j + 1 < NT) NA_SLOAD(j + 1);
    __syncthreads();
    const int kr_ = klo + j - 4;
    if (j < 4 || (kr_ >= rs_ && kr_ < rs_ + 8)) {
      init_scores(p0, p1, j, klo, qrow, bt_l, pen_l);
      qkt(p0, p1, (const bf16*)((const char*)K_lds + b * SHM_K), qs, r32, hi);
      partialSM(p0, p1, m_reg, mn, al);
      NA_RESC(al);
      finishSM(p0, p1, al, l_reg, pa0, pa1, pa2, pa3); NA_SBAR();
      pv_d0(o, vb0 + b * (int)SHM_V, pa0, pa1, pa2, pa3);
    }
  }
  if (hi == 0) li_l[r32] = l_reg; asm volatile("s_waitcnt lgkmcnt(0)" ::: "memory");
  float rli[16];
#pragma unroll
  for (int r = 0; r < 16; ++r) rli[r] = __builtin_amdgcn_rcpf(li_l[crow(r, hi)]);
  bf16* Ow = O + (qrow0 + wid * QBLK) * LDO + ocol;
#pragma unroll
  for (int r = 0; r < 16; ++r) { const int orow = crow(r, hi);
#pragma unroll
    for (int d0 = 0; d0 < 4; ++d0) { const float v = o[d0][r] * rli[r]; unsigned u = __float_as_uint(v); u = (u + 0x7fffu + ((u >> 16) & 1u)) >> 16; Ow[(long)orow * LDO + d0 * 32 + r32] = (bf16)u; } }
#undef NA_TROW
#undef NA_SLOAD
#undef NA_SWRITE
#undef NA_RESC
}
}

constexpr int NWAVES = 8;
constexpr int D = 2048, NBATCH = 4, SEQ = 4096, MLAT = NBATCH * SEQ, CTXL = 256, MCTX = NBATCH * CTXL, MR = MLAT + MCTX;
#ifndef PADF
#define PADF 128
#endif
constexpr int DFF = 5632, DUP = 2 * DFF, DIN = 6176, DINP = 6400, DEPTH = 4, LDF = DFF + PADF;
constexpr int MODW = 6 * D;
constexpr float EPS = 1e-6f;
constexpr int C_QA = 0, C_KA = 1024, C_VA = 2048, C_QB = 3072, C_KB = 3584, C_VB = 4096, C_GB = 5120, C_AB = 6144;

constexpr size_t MiB = 1u << 20;
constexpr size_t WS_CTL = 0, CTL_ZERO_BYTES = 32768;
constexpr size_t WS_MOD = 1 * MiB;
constexpr size_t WS_ROPE = WS_MOD + (size_t)DEPTH * 5 * MODW * 4;
constexpr size_t WS_WIN = 2 * MiB;
constexpr size_t WS_WOUT = WS_WIN + (size_t)2 * DINP * D * 2;
constexpr size_t WS_WPOOL = WS_WOUT + (size_t)2 * D * D * 2;
constexpr size_t WS_WUP = WS_WPOOL + (size_t)2 * 4 * 512 * 512 * 2;
constexpr size_t WS_WDOWN = WS_WUP + (size_t)DEPTH * DUP * D * 2;
constexpr size_t WS_XR = WS_WDOWN + (size_t)DEPTH * D * LDF * 2;
constexpr size_t WS_X16 = WS_XR;
constexpr size_t WS_PART = WS_XR + (size_t)MLAT * D * 2;
constexpr size_t WS_H = WS_XR + (size_t)MR * D * 4;
constexpr size_t WS_MIX = WS_H + (size_t)MR * D * 2;
constexpr size_t WS_BIG = WS_MIX + (size_t)MR * D * 2;
constexpr size_t WS_U = WS_BIG;
constexpr size_t WS_ACT = WS_U + (size_t)MR * DUP * 2;
constexpr size_t WS_P = WS_BIG;
constexpr size_t WS_QF = WS_P + (size_t)MR * DINP * 2;
constexpr size_t WS_KF = WS_QF + (size_t)MR * 512 * 2;
constexpr size_t WS_QB = WS_KF + (size_t)MR * 512 * 2;
constexpr size_t WS_KB = WS_QB + (size_t)MR * 512 * 2;
constexpr size_t WS_KHT = WS_KB + (size_t)MR * 512 * 2;
constexpr size_t WS_AL = WS_KHT + (size_t)2 * MR * 512 * 2;
constexpr size_t WS_UT = WS_AL + (size_t)2 * (MR / 64) * 512 * 4;
constexpr size_t WS_ST = WS_UT + (size_t)64 * 68 * 8192 * 2;
constexpr size_t WS_MIXEND = WS_ST + (size_t)64 * 68 * 8192 * 2;
constexpr size_t WS_SB = WS_ACT + (size_t)MR * LDF * 2;
constexpr size_t WS_END = WS_SB + (size_t)(MR / 256) * 2 * 3 * DFF * 4;
static_assert(WS_MIXEND <= WS_END, "even-mixer view fits inside the FFN view");
static_assert(WS_ROPE + 2 * 64 * 16 * 4 <= WS_WIN, "small tables fit below the weights");
constexpr int CW_BAR = 4096;

constexpr int RING_OFF = 0, RING_BYTES = 143360;
constexpr int LDSCTL_OFF = RING_BYTES, MISC_OFF = LDSCTL_OFF + 320;
constexpr int LDS_BYTES = 147456;
static_assert(na::LDS_END <= RING_BYTES, "attention LDS fits the ring");

#define GAS __attribute__((address_space(1)))
#define LAS __attribute__((address_space(3)))
typedef unsigned short bf16;
typedef unsigned v4u __attribute__((ext_vector_type(4)));
typedef unsigned v2u __attribute__((ext_vector_type(2)));
typedef float f32x4 __attribute__((ext_vector_type(4)));
#define LDS_WAIT() asm volatile("s_waitcnt lgkmcnt(0)" ::: "memory")
__device__ __forceinline__ unsigned f2bf(float f) { unsigned u = __builtin_bit_cast(unsigned, f); return (u + 0x7fffu + ((u >> 16) & 1u)) >> 16; }
__device__ __forceinline__ unsigned pk2(float lo, float hi) { return f2bf(lo) | (f2bf(hi) << 16); }
__device__ __forceinline__ float bflo(unsigned w) { return __builtin_bit_cast(float, w << 16); }
__device__ __forceinline__ float bfhi(unsigned w) { return __builtin_bit_cast(float, w & 0xffff0000u); }
__device__ __forceinline__ float bf2f(bf16 b) { return __builtin_bit_cast(float, (unsigned)b << 16); }

#define XB_TMO      128
#define XB_XCNT(j)  (256  + 64 * (j))
#define XB_XSUB(j)  (1280 + 64 * (j))
#define XB_XGEN(j)  (2304 + 64 * (j))
#define XB_TOP      3328
#define XB_TOPGEN   3392
#define XCD_BAR_WORDS 3456
#define XB_SPIN_CAP (1u << 18)
__device__ __forceinline__ unsigned xb_ld(unsigned* p)              { return __hip_atomic_load(p, __ATOMIC_RELAXED, __HIP_MEMORY_SCOPE_AGENT); }
__device__ __forceinline__ unsigned xb_add(unsigned* p, unsigned v) { return __hip_atomic_fetch_add(p, v, __ATOMIC_RELAXED, __HIP_MEMORY_SCOPE_AGENT); }
__device__ __forceinline__ unsigned xb_xcc_id() { return (unsigned)__builtin_amdgcn_s_getreg((3 << 11) | 20) & 0xFu; }
#define XB_SPIN(cond, bar) do { unsigned _sp = 0; while (cond) { __builtin_amdgcn_s_sleep(1); \
    if ((++_sp & 255u) == 0u) { if (xb_ld(&(bar)[XB_TMO])) break; if (_sp > XB_SPIN_CAP) { atomicAdd(&(bar)[XB_TMO], 1u); break; } } } } while (0)
struct XcdBarrier { unsigned* bar; unsigned x; volatile LAS unsigned* st; };
__device__ __forceinline__ XcdBarrier xcd_barrier_post(unsigned* bar, volatile LAS unsigned* st) {
    XcdBarrier b; b.bar = bar; b.x = xb_xcc_id(); b.st = st;
    if (threadIdx.x == 0) (void)xb_add(&bar[XB_XCNT(b.x)], 1u);
    return b;
}
__device__ __forceinline__ void xcd_barrier_complete(unsigned* bar, unsigned x, unsigned& nloc, unsigned& nx) {
    const unsigned G = gridDim.x * gridDim.y * gridDim.z;
    unsigned sum, cnt, mine, sp = 0u;
    for (;;) {
        sum = 0u; cnt = 0u; mine = 0u;
#pragma unroll
        for (unsigned j = 0; j < 16; ++j) { const unsigned c = xb_ld(&bar[XB_XCNT(j)]); sum += c; cnt += (c > 0u) ? 1u : 0u; mine = (j == x) ? c : mine; }
        if (sum == G) break;
        __builtin_amdgcn_s_sleep(1);
        if ((++sp & 255u) == 0u) { if (xb_ld(&bar[XB_TMO])) break; if (sp > XB_SPIN_CAP) { atomicAdd(&bar[XB_TMO], 1u); break; } }
    }
    nloc = mine > 0u ? mine : 1u; nx = cnt > 0u ? cnt : 1u;
}
__device__ __forceinline__ void xcd_barrier(const XcdBarrier& b) {
    asm volatile("s_waitcnt vmcnt(0)" ::: "memory");
    __syncthreads();
    if (threadIdx.x == 0) {
        unsigned* bar = b.bar;
        __builtin_amdgcn_s_waitcnt(0);
        unsigned nloc = b.st[0], nx = b.st[1];
        if (nloc == 0u) { xcd_barrier_complete(bar, b.x, nloc, nx); b.st[0] = nloc; b.st[1] = nx; }
        const unsigned old = xb_add(&bar[XB_XSUB(b.x)], 1u);
        const unsigned gen = old / nloc;
        if (old + 1u == (gen + 1u) * nloc) {
            __builtin_amdgcn_fence(__ATOMIC_RELEASE, "agent");
            asm volatile("s_waitcnt vmcnt(0)" ::: "memory");
            const unsigned og = xb_add(&bar[XB_TOP], 1u);
            const unsigned tg = og / nx;
            if (og + 1u == (tg + 1u) * nx) xb_add(&bar[XB_TOPGEN], 1u);
            else XB_SPIN(xb_ld(&bar[XB_TOPGEN]) == tg, bar);
            __builtin_amdgcn_fence(__ATOMIC_ACQUIRE, "agent");
            xb_add(&bar[XB_XGEN(b.x)], 1u);
            asm volatile("s_waitcnt vmcnt(0)" ::: "memory");
        } else {
            XB_SPIN(xb_ld(&bar[XB_XGEN(b.x)]) == gen, bar);
            __builtin_amdgcn_fence(__ATOMIC_ACQUIRE, "agent");
            asm volatile("s_waitcnt vmcnt(0)" ::: "memory");
        }
    }
    __syncthreads();
}

struct Args { const float* in[21]; float* out; unsigned char* ws; int ph_lo, ph_hi; };
static_assert(sizeof(Args) == 23 * 8 + 8, "Args has no padding bytes");
typedef const __attribute__((address_space(4))) Args* KArgs;
enum { I_X = 0, I_C, I_CTX, I_CCTX, I_WMOD, I_BMOD, I_N1G, I_N2G, I_WIN, I_WG2, I_BG, I_RPB, I_GLAG, I_WOUT, I_POOLW, I_POOLS, I_WUP, I_CONVW, I_CONVB, I_WDOWN, I_FING };
struct Frame {
    LAS unsigned char* lds; unsigned char* ldsg;
    volatile LAS unsigned* MISC;
    int tid, lane, wave, vcu, G;
    KArgs ka; unsigned char* ws;
};
__device__ __forceinline__ float wave_sum(float v) {
#pragma unroll
    for (int o = 1; o < 64; o <<= 1) v += __shfl_xor(v, o);
    return v;
}

__device__ __forceinline__ void p0_transpose_item(const float* W, int K, int N, bf16* WT, LAS float* scr, int item, int lane, int ldt = 0) {
    if (ldt == 0) ldt = K;
    const int nblk = N / 32, kb = item / nblk, nb = item % nblk, k0 = 64 * kb, n0 = 32 * nb;
#pragma unroll 8
    for (int i = 0; i < 32; ++i) { const int kk = 2 * i + (lane >> 5); scr[kk * 33 + (lane & 31)] = W[(size_t)(k0 + kk) * N + n0 + (lane & 31)]; }
    LDS_WAIT(); asm volatile("" ::: "memory");
    const int c = lane & 7;
#pragma unroll
    for (int j = 0; j < 4; ++j) { const int n = (lane >> 3) + 8 * j; const LAS float* s = scr + (8 * c) * 33 + n;
        v4u o; o.x = pk2(s[0 * 33], s[1 * 33]); o.y = pk2(s[2 * 33], s[3 * 33]); o.z = pk2(s[4 * 33], s[5 * 33]); o.w = pk2(s[6 * 33], s[7 * 33]);
        *(GAS v4u*)(WT + (size_t)(n0 + n) * ldt + k0 + 8 * c) = o; }
    LDS_WAIT(); asm volatile("" ::: "memory");
}
__device__ __forceinline__ void p0_transpose_item_up(const float* W, bf16* WT, LAS float* scr, int item, int lane) {
    constexpr int K = D, N = DUP;
    const int nblk = N / 32, kb = item / nblk, nb = item % nblk, k0 = 64 * kb, n0 = 32 * nb;
    const int isg = n0 >= DFF, c0 = isg ? n0 - DFF : n0, d0 = 256 * (c0 >> 7) + (isg ? 128 : 0) + (c0 & 127);
#pragma unroll 8
    for (int i = 0; i < 32; ++i) { const int kk = 2 * i + (lane >> 5); scr[kk * 33 + (lane & 31)] = W[(size_t)(k0 + kk) * N + n0 + (lane & 31)]; }
    LDS_WAIT(); asm volatile("" ::: "memory");
    const int c = lane & 7;
#pragma unroll
    for (int j = 0; j < 4; ++j) { const int n = (lane >> 3) + 8 * j; const LAS float* s = scr + (8 * c) * 33 + n;
        v4u o; o.x = pk2(s[0 * 33], s[1 * 33]); o.y = pk2(s[2 * 33], s[3 * 33]); o.z = pk2(s[4 * 33], s[5 * 33]); o.w = pk2(s[6 * 33], s[7 * 33]);
        *(GAS v4u*)(WT + (size_t)(d0 + n) * K + k0 + 8 * c) = o; }
    LDS_WAIT(); asm volatile("" ::: "memory");
}
__device__ __forceinline__ void ph_prologue(Frame& F) {
    const int gw = F.vcu * NWAVES + F.wave, NGW = F.G * NWAVES;
    const int gt = F.vcu * NWAVES * 64 + F.tid, NGT = F.G * NWAVES * 64;
    {
        LAS float* scr = (LAS float*)(F.lds + RING_OFF + F.wave * 16384);
        constexpr int I_IN = (D / 64) * (DIN / 32), I_OUT = (D / 64) * (D / 32), I_POOL = (512 / 64) * (512 / 32), I_UP = (D / 64) * (DUP / 32), I_DOWN = (DFF / 64) * (D / 32);
        constexpr int NITEMS = 2 * I_IN + 2 * I_OUT + 8 * I_POOL + 4 * I_UP + 4 * I_DOWN;
        bf16* WIN = (bf16*)(F.ws + WS_WIN); bf16* WOUT = (bf16*)(F.ws + WS_WOUT); bf16* WPOOL = (bf16*)(F.ws + WS_WPOOL); bf16* WUP = (bf16*)(F.ws + WS_WUP); bf16* WDOWN = (bf16*)(F.ws + WS_WDOWN);
        for (int it = gw; it < NITEMS; it += NGW) {
            int r = it;
            if (r < 4 * I_UP) { const int l = r / I_UP; p0_transpose_item_up((F.ka->in[I_WUP]) + (size_t)l * D * DUP, WUP + (size_t)l * DUP * D, scr, r % I_UP, F.lane); continue; } r -= 4 * I_UP;
            if (r < 4 * I_DOWN) { const int l = r / I_DOWN; p0_transpose_item((F.ka->in[I_WDOWN]) + (size_t)l * DFF * D, DFF, D, WDOWN + (size_t)l * D * LDF, scr, r % I_DOWN, F.lane, LDF); continue; } r -= 4 * I_DOWN;
            if (r < 2 * I_IN) { const int l = r / I_IN; p0_transpose_item((F.ka->in[I_WIN]) + (size_t)l * D * DIN, D, DIN, WIN + (size_t)l * DINP * D, scr, r % I_IN, F.lane); continue; } r -= 2 * I_IN;
            if (r < 2 * I_OUT) { const int l = r / I_OUT; p0_transpose_item((F.ka->in[I_WOUT]) + (size_t)l * D * D, D, D, WOUT + (size_t)l * D * D, scr, r % I_OUT, F.lane); continue; } r -= 2 * I_OUT;
            { const int l = r / I_POOL; p0_transpose_item((F.ka->in[I_POOLW]) + (size_t)l * 512 * 512, 512, 512, WPOOL + (size_t)l * 512 * 512, scr, r % I_POOL, F.lane); }
        }
        constexpr int ZV = (DINP - DIN) * D / 8;
        for (int i = gt; i < 2 * ZV; i += NGT) { const int l = i / ZV, j = i % ZV; *(GAS v4u*)(WIN + (size_t)l * DINP * D + (size_t)DIN * D + (size_t)j * 8) = (v4u){0u, 0u, 0u, 0u}; }
    }
    if (blockIdx.x == 0) {
        float* rc = (float*)(F.ws + WS_ROPE); float* rs = rc + 64 * 16;
        for (int i = F.tid; i < 64 * 16; i += NWAVES * 64) { const int pos = i >> 4, f = i & 15; const float inv = powf(10000.0f, -(float)f / 16.0f); const float ang = (float)pos * inv; rc[i] = cosf(ang); rs[i] = sinf(ang); }
    }
    __syncthreads();
    {
        LAS float* S = (LAS float*)(F.lds + RING_OFF);
        LAS float* RED = (LAS float*)(F.lds + RING_OFF + 40960);
        float* MOD = (float*)(F.ws + WS_MOD);
        constexpr int NTASK = DEPTH * (MODW / 256);
        if ((int)blockIdx.x < NTASK) {
            for (int i = F.tid; i < 5 * D; i += NWAVES * 64) { const int r = i / D, k = i % D; const float v = r < 4 ? (F.ka->in[I_C])[r * D + k] : (F.ka->in[I_CCTX])[k]; S[i] = v / (1.0f + __expf(-v)); }
            __syncthreads();
            for (int t = blockIdx.x; t < NTASK; t += F.G) {
                const int l = t / (MODW / 256), n0 = (t % (MODW / 256)) * 256, k0 = F.wave * 256;
                float acc[5][4];
#pragma unroll
                for (int r = 0; r < 5; ++r)
#pragma unroll
                    for (int cc = 0; cc < 4; ++cc) acc[r][cc] = 0.f;
                const float* Wp = (F.ka->in[I_WMOD]) + ((size_t)l * D + k0) * MODW + n0 + 4 * F.lane;
                for (int kk = 0; kk < 256; kk += 8) {
                    f32x4 wv[8];
#pragma unroll
                    for (int u = 0; u < 8; ++u) wv[u] = *(const f32x4*)(Wp + (size_t)(kk + u) * MODW);
#pragma unroll
                    for (int u = 0; u < 8; ++u)
#pragma unroll
                        for (int r = 0; r < 5; ++r) { const float s = S[r * D + k0 + kk + u];
#pragma unroll
                            for (int cc = 0; cc < 4; ++cc) acc[r][cc] = fmaf(s, wv[u][cc], acc[r][cc]); }
                }
#pragma unroll
                for (int r = 0; r < 5; ++r)
#pragma unroll
                    for (int cc = 0; cc < 4; ++cc) RED[(F.wave * 5 + r) * 256 + 4 * F.lane + cc] = acc[r][cc];
                __syncthreads();
                for (int o = F.tid; o < 5 * 256; o += NWAVES * 64) { const int r = o >> 8, ci = o & 255; float s = (F.ka->in[I_BMOD])[l * MODW + n0 + ci];
#pragma unroll
                    for (int w = 0; w < 8; ++w) s += RED[(w * 5 + r) * 256 + ci];
                    MOD[((size_t)l * 5 + r) * MODW + n0 + ci] = s; }
                __syncthreads();
            }
        }
    }
}

__device__ __forceinline__ f32x4 bf4_unpack(v2u h) { f32x4 r; r.x = pg8::h_lo(h.x); r.y = pg8::h_hi(h.x); r.z = pg8::h_lo(h.y); r.w = pg8::h_hi(h.y); return r; }
template <bool L16, bool CPY, bool CI>
__device__ __forceinline__ void norm_rows(Frame& F, const int ra, const int rb, const void* src, const int rbase, const float* g, const float* modl, const int off_sh, const int off_sc, const int nparts) {
    if (ra >= rb) return;
    bf16* H = (bf16*)(F.ws + WS_H);
    f32x4 gm[8], sh[8]; int cb = -1;
    f32x4 v[8], w[8]; v2u hv[8], hw[8];
#define NORM_P32(m) ((const f32x4*)((const float*)src + (size_t)((m) - rbase) * D) + F.lane)
#define NORM_P16(m) ((const v2u*)((const bf16*)src + (size_t)((m) - rbase) * D) + F.lane)
    if constexpr (L16) { const v2u* xr = NORM_P16(ra);
#pragma unroll
        for (int j = 0; j < 8; ++j) hv[j] = xr[64 * j];
    } else { const f32x4* xr = NORM_P32(ra);
#pragma unroll
        for (int j = 0; j < 8; ++j) v[j] = xr[64 * j]; }
    for (int m = ra; m < rb; ++m) {
        if (m + 1 < rb) {
            if constexpr (L16) { const v2u* xn = NORM_P16(m + 1);
#pragma unroll
                for (int j = 0; j < 8; ++j) hw[j] = xn[64 * j];
            } else { const f32x4* xn = NORM_P32(m + 1);
#pragma unroll
                for (int j = 0; j < 8; ++j) w[j] = xn[64 * j]; } }
        const int bidx = m < MLAT ? (m >> 12) : 4;
        if (bidx != cb) { cb = bidx;
            const f32x4* gp = (const f32x4*)g + F.lane; const f32x4* shp = (const f32x4*)(modl + (size_t)bidx * MODW + off_sh) + F.lane; const f32x4* scp = (const f32x4*)(modl + (size_t)bidx * MODW + off_sc) + F.lane;
#pragma unroll
            for (int j = 0; j < 8; ++j) { gm[j] = gp[64 * j] * (scp[64 * j] + 1.0f); sh[j] = shp[64 * j]; } }
        if constexpr (L16) {
#pragma unroll
            for (int j = 0; j < 8; ++j) v[j] = bf4_unpack(hv[j]); }
        if constexpr (CI) {
            for (int k = 0; k < nparts; ++k) { const f32x4* pp = (const f32x4*)((const float*)(F.ws + WS_PART) + ((size_t)k * MCTX + (size_t)(m - rbase)) * D) + F.lane;
#pragma unroll
                for (int j = 0; j < 8; ++j) v[j] = v[j] + pp[64 * j]; }
            f32x4* xw = (f32x4*)((float*)(F.ws + WS_XR) + (size_t)m * D) + F.lane;
#pragma unroll
            for (int j = 0; j < 8; ++j) xw[64 * j] = v[j]; }
        float s = 0.f;
#pragma unroll
        for (int j = 0; j < 8; ++j) s += (v[j].x * v[j].x + v[j].y * v[j].y) + (v[j].z * v[j].z + v[j].w * v[j].w);
        const float r = 1.0f / sqrtf(wave_sum(s) * (1.0f / D) + EPS);
        v2u* o8 = (v2u*)(H + (size_t)m * D) + F.lane;
#pragma unroll
        for (int j = 0; j < 8; ++j) { const f32x4 y = v[j] * r * gm[j] + sh[j]; v2u ww; ww.x = pk2(y.x, y.y); ww.y = pk2(y.z, y.w); o8[64 * j] = ww; }
        if constexpr (CPY) { v2u* c8 = (v2u*)((bf16*)(F.ws + WS_X16) + (size_t)m * D) + F.lane;
#pragma unroll
            for (int j = 0; j < 8; ++j) { v2u ww; ww.x = pg8::pk_h2(v[j].x, v[j].y); ww.y = pg8::pk_h2(v[j].z, v[j].w); c8[64 * j] = ww; } }
        if constexpr (L16) {
#pragma unroll
            for (int j = 0; j < 8; ++j) hv[j] = hw[j];
        } else {
#pragma unroll
            for (int j = 0; j < 8; ++j) v[j] = w[j]; }
    }
#undef NORM_P32
#undef NORM_P16
}
__device__ __forceinline__ void ph_norm(Frame& F, int nrows, const float* xl32, const float* xc, const float* g, const float* modl, int off_sh, int off_sc, int nparts) {
    const int gw = F.vcu * NWAVES + F.wave; int NGW = F.G * NWAVES; asm volatile("" : "+s"(NGW));
    const int nctx = nrows - MLAT;
    const int r0 = (int)((unsigned)gw * (unsigned)MLAT / (unsigned)NGW), r1 = (int)((unsigned)(gw + 1) * (unsigned)MLAT / (unsigned)NGW);
    const int c0 = MLAT + (int)((unsigned)gw * (unsigned)nctx / (unsigned)NGW), c1 = MLAT + (int)((unsigned)(gw + 1) * (unsigned)nctx / (unsigned)NGW);
    if (xl32) { norm_rows<false, true, false>(F, r0, r1, xl32, 0, g, modl, off_sh, off_sc, 0); norm_rows<false, false, false>(F, c0, c1, xc, MLAT, g, modl, off_sh, off_sc, 0); }
    else      { norm_rows<true, false, false>(F, r0, r1, F.ws + WS_X16, 0, g, modl, off_sh, off_sc, 0); norm_rows<false, false, true>(F, c0, c1, xc, MLAT, g, modl, off_sh, off_sc, nparts); }
}
__device__ __forceinline__ void ph_final(Frame& F) {
    const int gw = F.vcu * NWAVES + F.wave, NGW = F.G * NWAVES;
    const bf16* X16 = (const bf16*)(F.ws + WS_X16);
    const int r0 = (int)((long)gw * MLAT / NGW), r1 = (int)((long)(gw + 1) * MLAT / NGW);
    if (r0 >= r1) return;
    f32x4 gf[8], v[8]; v2u hv[8], hw[8];
    { const f32x4* gp = (const f32x4*)(F.ka->in[I_FING]) + F.lane; const v2u* xr = (const v2u*)(X16 + (size_t)r0 * D) + F.lane;
#pragma unroll
      for (int j = 0; j < 8; ++j) { gf[j] = gp[64 * j]; hv[j] = xr[64 * j]; } }
    for (int m = r0; m < r1; ++m) {
        if (m + 1 < r1) { const v2u* xn = (const v2u*)(X16 + (size_t)(m + 1) * D) + F.lane;
#pragma unroll
            for (int j = 0; j < 8; ++j) hw[j] = xn[64 * j]; }
#pragma unroll
        for (int j = 0; j < 8; ++j) v[j] = bf4_unpack(hv[j]);
        float s = 0.f;
#pragma unroll
        for (int j = 0; j < 8; ++j) s += (v[j].x * v[j].x + v[j].y * v[j].y) + (v[j].z * v[j].z + v[j].w * v[j].w);
        const float r = 1.0f / sqrtf(wave_sum(s) * (1.0f / D) + EPS);
        f32x4* op = (f32x4*)((F.ka->out) + (size_t)m * D) + F.lane;
#pragma unroll
        for (int j = 0; j < 8; ++j) __builtin_nontemporal_store(v[j] * r * gf[j], op + 64 * j);
#pragma unroll
        for (int j = 0; j < 8; ++j) hv[j] = hw[j];
    }
}
template <int HW>
__device__ __forceinline__ void pool_strip(const bf16* H, bf16* HP, int m0, int t0, int L, int c8) {
    constexpr int NR = 8 + 2 * HW - 1;
    v4u R[NR];
#pragma unroll
    for (int j = 0; j < NR; ++j) { const int tr = t0 - HW + j; R[j] = (v4u){0u, 0u, 0u, 0u}; if (tr >= 0 && tr < L) R[j] = *(const v4u*)(H + (size_t)(m0 - HW + j) * D + c8); }
    float s[8];
#pragma unroll
    for (int e = 0; e < 8; ++e) s[e] = 0.f;
#pragma unroll
    for (int j = 0; j < 2 * HW; ++j) { s[0] += bflo(R[j].x); s[1] += bfhi(R[j].x); s[2] += bflo(R[j].y); s[3] += bfhi(R[j].y); s[4] += bflo(R[j].z); s[5] += bfhi(R[j].z); s[6] += bflo(R[j].w); s[7] += bfhi(R[j].w); }
#pragma unroll
    for (int r = 0; r < 8; ++r) {
        const int t = t0 + r; const float inv = 1.0f / (float)(min(t + HW, L) - max(t - HW, 0));
        const v4u w = R[r + HW];
        v4u o; o.x = pk2(s[0] * inv - bflo(w.x), s[1] * inv - bfhi(w.x)); o.y = pk2(s[2] * inv - bflo(w.y), s[3] * inv - bfhi(w.y));
        o.z = pk2(s[4] * inv - bflo(w.z), s[5] * inv - bfhi(w.z)); o.w = pk2(s[6] * inv - bflo(w.w), s[7] * inv - bfhi(w.w));
        *(v4u*)(HP + (size_t)(m0 + r) * D + c8) = o;
        if (r < 7) { const v4u a = R[r + 2 * HW], b = R[r];
            s[0] += bflo(a.x) - bflo(b.x); s[1] += bfhi(a.x) - bfhi(b.x); s[2] += bflo(a.y) - bflo(b.y); s[3] += bfhi(a.y) - bfhi(b.y);
            s[4] += bflo(a.z) - bflo(b.z); s[5] += bfhi(a.z) - bfhi(b.z); s[6] += bflo(a.w) - bflo(b.w); s[7] += bfhi(a.w) - bfhi(b.w); }
    }
}
__device__ __forceinline__ void ph_pool(Frame& F, int nrows) {
    const int gt = F.vcu * NWAVES * 64 + F.tid, NGT = F.G * NWAVES * 64;
    const bf16* H = (const bf16*)(F.ws + WS_H); bf16* HP = (bf16*)(F.ws + WS_MIX);
    const int nitems = (nrows / 8) * (D / 8);
    for (int it = gt; it < nitems; it += NGT) {
        const int strip = it >> 8, c8 = (it & 255) * 8, gi = __builtin_amdgcn_readfirstlane(c8 >> 9), m0 = strip * 8;
        int t0, L;
        if (m0 < MLAT) { t0 = m0 & (SEQ - 1); L = SEQ; } else { t0 = (m0 - MLAT) & (CTXL - 1); L = CTXL; }
        if (gi == 0) pool_strip<1>(H, HP, m0, t0, L, c8); else if (gi == 1) pool_strip<2>(H, HP, m0, t0, L, c8); else if (gi == 2) pool_strip<4>(H, HP, m0, t0, L, c8); else pool_strip<8>(H, HP, m0, t0, L, c8);
    }
}
__device__ __forceinline__ void ph_glufix(Frame& F, int nrows, const float* cw, const float* cb) {
    const int gt = F.vcu * NWAVES * 64 + F.tid, NGT = F.G * NWAVES * 64;
    const float* SB = (const float*)(F.ws + WS_SB); bf16* ACT = (bf16*)(F.ws + WS_ACT);
    constexpr int C4 = DFF / 4;
    const int nitems = (nrows / 256) * 2 * C4;
    for (int it = gt; it < nitems; it += NGT) {
        const int c4 = (it % C4) * 4, pw = it / C4, which = pw & 1, pm = pw >> 1, row = 256 * pm + (which ? 255 : 0);
        int t, L;
        if (row < MLAT) { t = row & (SEQ - 1); L = SEQ; } else { t = (row - MLAT) & (CTXL - 1); L = CTXL; }
        const float* sb = SB + ((size_t)(pm * 2 + which) * 3) * DFF + c4;
        f32x4 cv = *(const f32x4*)sb; const f32x4 vl = *(const f32x4*)(sb + DFF);
        if (which == 0 && t > 0)     cv = cv + *(const f32x4*)(cw + c4) * *(const f32x4*)(SB + ((size_t)((pm - 1) * 2 + 1) * 3 + 2) * DFF + c4);
        if (which == 1 && t < L - 1) cv = cv + *(const f32x4*)(cw + 2 * DFF + c4) * *(const f32x4*)(SB + ((size_t)((pm + 1) * 2 + 0) * 3 + 2) * DFF + c4);
        const pg8::f32x2 g0 = pg8::gelu_pk((pg8::f32x2){cv.x, cv.y}), g1 = pg8::gelu_pk((pg8::f32x2){cv.z, cv.w});
        v2u o; o.x = pk2(g0.x * vl.x, g0.y * vl.y); o.y = pk2(g1.x * vl.z, g1.y * vl.w);
        *(v2u*)(ACT + (size_t)row * LDF + c4) = o;
    }
}

namespace gla {
typedef short bf16x8 __attribute__((ext_vector_type(8)));
typedef float f32x16 __attribute__((ext_vector_type(16)));
typedef unsigned u32x4 __attribute__((ext_vector_type(4)));
constexpr int NRC = MR / 64;
constexpr int PITCH = 72;
__device__ __forceinline__ int crow(int r, int hi) { return (r & 3) + 8 * (r >> 2) + 4 * hi; }
__device__ __forceinline__ unsigned cvtpk(float lo, float hi) { unsigned r; asm volatile("v_cvt_pk_bf16_f32 %0, %1, %2" : "=v"(r) : "v"(lo), "v"(hi)); return r; }
__device__ __forceinline__ int chain_slot_rc(int b, int dir, int s) { return s < 4 ? 256 + 4 * b + (dir ? 3 - s : s) : 64 * b + (dir ? 63 - (s - 4) : s - 4); }
__device__ __forceinline__ int rc_slot(int rc, int dir) { return rc < 256 ? 4 + (dir ? 63 - (rc & 63) : (rc & 63)) : (dir ? 3 - (rc & 3) : (rc & 3)); }
__device__ __forceinline__ int rc_batch(int rc) { return rc < 256 ? rc >> 6 : (rc - 256) >> 2; }
__device__ __forceinline__ float logsig16(float z2) { return (fminf(z2, 0.f) - __builtin_amdgcn_logf(1.0f + __builtin_amdgcn_exp2f(-fabsf(z2)))) * (1.0f / 16.0f); }

__device__ __forceinline__ void ph_prep(Frame& F, int e) {
    const bf16* P = (const bf16*)(F.ws + WS_P);
    bf16* QF = (bf16*)(F.ws + WS_QF); bf16* KF = (bf16*)(F.ws + WS_KF); bf16* QB = (bf16*)(F.ws + WS_QB); bf16* KB = (bf16*)(F.ws + WS_KB);
    float* AL = (float*)(F.ws + WS_AL);
    const float* ropec = (const float*)(F.ws + WS_ROPE); const float* ropes = ropec + 64 * 16;
    const float* w2 = (F.ka->in[I_WG2]) + (size_t)e * 2 * 16 * 512; const float* bg = (F.ka->in[I_BG]) + (size_t)e * 2 * 512;
    LAS float* ABf = (LAS float*)(F.lds + RING_OFF);
    LAS float* RTc = (LAS float*)(F.lds + RING_OFF + 8192); LAS float* RTs = RTc + 64 * 16;
    for (int i = F.tid; i < 2 * 64 * 16; i += NWAVES * 64) RTc[i] = ropec[i];
    const int dk = F.lane;
    pg8::f32x2 wfb[16], bfb; int col;
    const int hf = dk >> 5, f = dk & 15; const float sgn = ((dk >> 4) & 1) ? 1.0f : -1.0f;
#define GLA_Z(t, zf, zb) do { const LAS f32x4* ap = (const LAS f32x4*)(ABf + (t) * 32); pg8::f32x2 z2 = bfb; \
        _Pragma("unroll") for (int i = 0; i < 8; ++i) { const f32x4 a = ap[i]; z2 = (pg8::f32x2){a.x, a.y} * wfb[2 * i] + z2; z2 = (pg8::f32x2){a.z, a.w} * wfb[2 * i + 1] + z2; } \
        zf = z2.x; zb = z2.y; } while (0)
    const int NT = 256 + (NRC - 256) * 8;
    for (int task = blockIdx.x; task < NT; task += F.G) {
        const int rc = task < 256 ? task : 256 + ((task - 256) >> 3), h = task < 256 ? F.wave : ((task - 256) & 7);
        const bool active = task < 256 || F.wave == 0;
        const bool lat = rc < 256;
        const bf16* Prow0 = P + (size_t)rc * 64 * DINP;
        col = 64 * h + dk;
#pragma unroll
        for (int i = 0; i < 16; ++i) wfb[i] = (pg8::f32x2){w2[i * 512 + col], w2[(16 + i) * 512 + col]} * 1.4426950408889634f;
        bfb = (pg8::f32x2){bg[col], bg[512 + col]} * 1.4426950408889634f;
        __syncthreads();
        if (F.tid < 256) { const int row = F.tid >> 2, part = F.tid & 3; const v4u w = *(const v4u*)(Prow0 + (size_t)row * DINP + C_AB + 8 * part);
            LAS float* d = ABf + row * 32 + 16 * (part & 1) + (part >> 1);
            d[0] = bflo(w.x); d[2] = bfhi(w.x); d[4] = bflo(w.y); d[6] = bfhi(w.y); d[8] = bflo(w.z); d[10] = bfhi(w.z); d[12] = bflo(w.w); d[14] = bfhi(w.w); }
        __syncthreads();
        if (!active) continue;
        const int prw = rc & 63;
        float pf = 0.f, pbx = 0.f;
        for (int t8 = 0; t8 < 64; t8 += 8) {
            float qv[8], kv[8];
#pragma unroll
            for (int tt = 0; tt < 8; ++tt) { const bf16* prow = Prow0 + (size_t)(t8 + tt) * DINP; qv[tt] = bf2f(prow[C_QB + col]); kv[tt] = bf2f(prow[C_KB + col]); }
#pragma unroll
            for (int tt = 0; tt < 8; ++tt) {
                const int t = t8 + tt;
                float zf, zb; GLA_Z(t, zf, zb);
                const float gf = logsig16(zf), gb = logsig16(zb);
                pf += gf; const float cumf = pf, pbe = pbx; pbx += gb;
                float q = qv[tt], k = kv[tt];
                const float qp = __shfl_xor(q, 16), kp = __shfl_xor(k, 16);
                if (lat) { const int ri = (hf ? t : prw) * 16 + f; const float c = RTc[ri], s = RTs[ri];
                    const float ss = s * sgn; q = fmaf(qp, ss, q * c); k = fmaf(kp, ss, k * c); }
                q *= 0.125f;
                const unsigned o = (unsigned)((rc * 64 + t) * 512 + col);
                const unsigned wq = pg8::cvt_pk_bf16(q * __builtin_amdgcn_exp2f(cumf), q * __builtin_amdgcn_exp2f(fminf(-pbe, 115.f))), wk = pg8::cvt_pk_bf16(k * __builtin_amdgcn_exp2f(fminf(-cumf, 115.f)), k * __builtin_amdgcn_exp2f(pbe));
                QF[o] = (bf16)(wq & 0xffffu); QB[o] = (bf16)(wq >> 16); KF[o] = (bf16)(wk & 0xffffu); KB[o] = (bf16)(wk >> 16);
            }
        }
        AL[(size_t)(0 * NRC + rc) * 512 + col] = __builtin_amdgcn_exp2f(pf); AL[(size_t)(1 * NRC + rc) * 512 + col] = __builtin_amdgcn_exp2f(pbx);
    }
#undef GLA_Z
    __syncthreads();
}

__device__ __forceinline__ void stage_vt(Frame& F, const bf16* P, int rc, int h, LAS bf16* VT) {
    const int tp = (F.tid & 31) * 2, d8 = (F.tid >> 5) * 8;
    const bf16* src = P + (size_t)(rc * 64 + tp) * DINP + C_VB + 128 * h + d8;
    const v4u w0 = *(const v4u*)src, w1 = *(const v4u*)(src + DINP);
    LAS unsigned* dst = (LAS unsigned*)(VT + d8 * PITCH + tp);
    dst[0 * (PITCH / 2)] = (w0.x & 0xffffu) | (w1.x << 16); dst[1 * (PITCH / 2)] = (w0.x >> 16) | (w1.x & 0xffff0000u);
    dst[2 * (PITCH / 2)] = (w0.y & 0xffffu) | (w1.y << 16); dst[3 * (PITCH / 2)] = (w0.y >> 16) | (w1.y & 0xffff0000u);
    dst[4 * (PITCH / 2)] = (w0.z & 0xffffu) | (w1.z << 16); dst[5 * (PITCH / 2)] = (w0.z >> 16) | (w1.z & 0xffff0000u);
    dst[6 * (PITCH / 2)] = (w0.w & 0xffffu) | (w1.w << 16); dst[7 * (PITCH / 2)] = (w0.w >> 16) | (w1.w & 0xffff0000u);
}
#define GLA_BAR() do { asm volatile("s_waitcnt lgkmcnt(0)" ::: "memory"); __builtin_amdgcn_s_barrier(); asm volatile("" ::: "memory"); } while (0)
#define GLA_FRAG(base, row, col) (*(const LAS bf16x8*)((base) + (row) * PITCH + (col)))

__device__ __forceinline__ void ph_g1(Frame& F) {
    const bf16* P = (const bf16*)(F.ws + WS_P); const bf16* KFg = (const bf16*)(F.ws + WS_KF); const bf16* KBg = (const bf16*)(F.ws + WS_KB); bf16* UT = (bf16*)(F.ws + WS_UT); const float* AL = (const float*)(F.ws + WS_AL);
    LAS bf16* VT = (LAS bf16*)(F.lds + RING_OFF); LAS bf16* KH0 = VT + 128 * PITCH; LAS bf16* KH1 = KH0 + 64 * PITCH;
    const int r32 = F.lane & 31, hi = F.lane >> 5, dir = F.wave >> 2, db = F.wave & 3;
    for (int u = blockIdx.x; u < NRC * 8; u += F.G) {
        const int rc = u >> 3, h = u & 7;
        __syncthreads();
        stage_vt(F, P, rc, h, VT);
        {
            const int half = F.tid >> 8, tl = F.tid & 255, tp = (tl & 31) * 2, d8 = (tl >> 5) * 8;
            const bf16* src = (half ? KBg : KFg) + (size_t)(rc * 64 + tp) * 512 + 64 * h + d8;
            const v4u w0 = *(const v4u*)src, w1 = *(const v4u*)(src + 512);
            LAS unsigned* dst = (LAS unsigned*)((half ? KH1 : KH0) + d8 * PITCH + tp);
            dst[0 * (PITCH / 2)] = (w0.x & 0xffffu) | (w1.x << 16); dst[1 * (PITCH / 2)] = (w0.x >> 16) | (w1.x & 0xffff0000u);
            dst[2 * (PITCH / 2)] = (w0.y & 0xffffu) | (w1.y << 16); dst[3 * (PITCH / 2)] = (w0.y >> 16) | (w1.y & 0xffff0000u);
            dst[4 * (PITCH / 2)] = (w0.z & 0xffffu) | (w1.z << 16); dst[5 * (PITCH / 2)] = (w0.z >> 16) | (w1.z & 0xffff0000u);
            dst[6 * (PITCH / 2)] = (w0.w & 0xffffu) | (w1.w << 16); dst[7 * (PITCH / 2)] = (w0.w >> 16) | (w1.w & 0xffff0000u); }
        __syncthreads();
        const LAS bf16* KH = dir ? KH1 : KH0;
        f32x16 acc0 = {}, acc1 = {};
#pragma unroll
        for (int ks = 0; ks < 4; ++ks) { const bf16x8 a = GLA_FRAG(VT, 32 * db + r32, 16 * ks + 8 * hi);
            acc0 = __builtin_amdgcn_mfma_f32_32x32x16_bf16(a, GLA_FRAG(KH, r32, 16 * ks + 8 * hi), acc0, 0, 0, 0);
            acc1 = __builtin_amdgcn_mfma_f32_32x32x16_bf16(a, GLA_FRAG(KH, 32 + r32, 16 * ks + 8 * hi), acc1, 0, 0, 0); }
        const int b = rc_batch(rc), chain = (b * 8 + h) * 2 + dir, slot = rc_slot(rc, dir);
        if (dir == 0) { const float a0 = AL[(size_t)rc * 512 + 64 * h + r32], a1 = AL[(size_t)rc * 512 + 64 * h + 32 + r32];
#pragma unroll
            for (int r = 0; r < 16; ++r) { acc0[r] *= a0; acc1[r] *= a1; } }
        bf16* dst = UT + ((size_t)chain * 68 + slot) * 8192;
#pragma unroll
        for (int r = 0; r < 16; ++r) { const int dv = 32 * db + crow(r, hi); dst[dv * 64 + r32] = (bf16)f2bf(acc0[r]); dst[dv * 64 + 32 + r32] = (bf16)f2bf(acc1[r]); }
    }
    __syncthreads();
}

__device__ __forceinline__ void ph_g2(Frame& F) {
    const int gt = F.vcu * NWAVES * 64 + F.tid, NGT = F.G * NWAVES * 64;
    const bf16* UT = (const bf16*)(F.ws + WS_UT); bf16* ST = (bf16*)(F.ws + WS_ST); const float* AL = (const float*)(F.ws + WS_AL);
    for (int it = gt; it < 64 * 128 * 16; it += NGT) {
        const int chain = it >> 11, rem = it & 2047, dv = rem >> 4, dk4 = (rem & 15) * 4;
        const int dir = chain & 1, h = (chain >> 1) & 7, b = chain >> 4;
        float S0 = 0.f, S1 = 0.f, S2 = 0.f, S3 = 0.f;
        const size_t base = (size_t)chain * 68 * 8192 + dv * 64 + dk4;
#pragma unroll 17
        for (int s = 0; s < 68; ++s) {
            const v2u uw = *(const v2u*)(UT + base + (size_t)s * 8192);
            const int rc = chain_slot_rc(b, dir, s);
            const f32x4 a = *(const f32x4*)(AL + (size_t)(dir * NRC + rc) * 512 + 64 * h + dk4);
            v2u o; if (dir) { o.x = pk2(S0 * a.x, S1 * a.y); o.y = pk2(S2 * a.z, S3 * a.w); } else { o.x = pk2(S0, S1); o.y = pk2(S2, S3); }
            *(v2u*)(ST + base + (size_t)s * 8192) = o;
            S0 = fmaf(a.x, S0, bflo(uw.x)); S1 = fmaf(a.y, S1, bfhi(uw.x)); S2 = fmaf(a.z, S2, bflo(uw.y)); S3 = fmaf(a.w, S3, bfhi(uw.y));
        }
    }
}

#define GLA_PK4(P, BASE, OUT) do { unsigned a0 = pk2(P[BASE + 0], P[BASE + 1]), a1 = pk2(P[BASE + 2], P[BASE + 3]);   \
    unsigned b0 = pk2(P[BASE + 4], P[BASE + 5]), b1 = pk2(P[BASE + 6], P[BASE + 7]);                              \
    auto r0 = __builtin_amdgcn_permlane32_swap(a0, b0, false, false); auto r1 = __builtin_amdgcn_permlane32_swap(a1, b1, false, false); \
    u32x4 w = {r0[0], r1[0], r0[1], r1[1]}; OUT = *reinterpret_cast<bf16x8*>(&w); } while (0)
template <int DIR>
__device__ __forceinline__ void g3_intra(f32x16& o, const LAS bf16* Kt, const LAS bf16* Qt, const LAS bf16* VT, int jb, int tb, int db, int r32, int hi) {
    f32x16 X = {};
#pragma unroll
    for (int ks = 0; ks < 4; ++ks) X = __builtin_amdgcn_mfma_f32_32x32x16_bf16(GLA_FRAG(Kt, 32 * jb + r32, 16 * ks + 8 * hi), GLA_FRAG(Qt, 32 * tb + r32, 16 * ks + 8 * hi), X, 0, 0, 0);
    if (jb == tb) {
#pragma unroll
        for (int r = 0; r < 16; ++r) { const int tj = crow(r, hi); const bool keep = DIR ? (tj >= r32) : (tj <= r32); X[r] = keep ? X[r] : 0.f; }
    }
    bf16x8 x0, x1; GLA_PK4(X, 0, x0); GLA_PK4(X, 8, x1);
    o = __builtin_amdgcn_mfma_f32_32x32x16_bf16(GLA_FRAG(VT, 32 * db + r32, 32 * jb + 8 * hi), x0, o, 0, 0, 0);
    o = __builtin_amdgcn_mfma_f32_32x32x16_bf16(GLA_FRAG(VT, 32 * db + r32, 32 * jb + 16 + 8 * hi), x1, o, 0, 0, 0);
}
__device__ __forceinline__ void ph_g3(Frame& F, int e, int nrc) {
    const bf16* P = (const bf16*)(F.ws + WS_P); const bf16* ST = (const bf16*)(F.ws + WS_ST); bf16* MIX = (bf16*)(F.ws + WS_MIX);
    const bf16* QFg = (const bf16*)(F.ws + WS_QF); const bf16* KFg = (const bf16*)(F.ws + WS_KF); const bf16* QBg = (const bf16*)(F.ws + WS_QB); const bf16* KBg = (const bf16*)(F.ws + WS_KB);
    const float* gg = (F.ka->in[I_GLAG]) + (size_t)e * 8 * 128;
    LAS bf16* VT = (LAS bf16*)(F.lds + RING_OFF); LAS bf16* QFl = VT + 128 * PITCH; LAS bf16* KFl = QFl + 64 * PITCH; LAS bf16* QBl = KFl + 64 * PITCH; LAS bf16* KBl = QBl + 64 * PITCH;
    LAS float* SS = (LAS float*)(KBl + 64 * PITCH);
    const int r32 = F.lane & 31, hi = F.lane >> 5, tb = F.wave & 1, db = F.wave >> 1;
    const int s_tp = (F.tid & 31) * 2, s_d8 = (F.tid >> 5) * 8, s_t = F.tid >> 3, s_c8 = (F.tid & 7) * 8;
    v4u pv0, pv1, pqf, pkf, pqb, pkb; bf16x8 nsf[4], nsb[4];
#define G3_LOAD(uu) do { const int _rc = (uu) >> 3, _h = (uu) & 7, _b = rc_batch(_rc); \
        const bf16* _vs = P + (size_t)(_rc * 64 + s_tp) * DINP + C_VB + 128 * _h + s_d8; pv0 = *(const v4u*)_vs; pv1 = *(const v4u*)(_vs + DINP); \
        const size_t _go = (size_t)(_rc * 64 + s_t) * 512 + 64 * _h + s_c8; pqf = *(const v4u*)(QFg + _go); pkf = *(const v4u*)(KFg + _go); pqb = *(const v4u*)(QBg + _go); pkb = *(const v4u*)(KBg + _go); \
        const bf16* _sf = ST + ((size_t)((_b * 8 + _h) * 2 + 0) * 68 + rc_slot(_rc, 0)) * 8192 + (size_t)(32 * db + r32) * 64 + 8 * hi; \
        const bf16* _sb = ST + ((size_t)((_b * 8 + _h) * 2 + 1) * 68 + rc_slot(_rc, 1)) * 8192 + (size_t)(32 * db + r32) * 64 + 8 * hi; \
        _Pragma("unroll") for (int ks = 0; ks < 4; ++ks) { nsf[ks] = *(const bf16x8*)(_sf + 16 * ks); nsb[ks] = *(const bf16x8*)(_sb + 16 * ks); } } while (0)
    int u = blockIdx.x;
    if (u < nrc * 8) G3_LOAD(u);
    for (; u < nrc * 8; u += F.G) {
        const int rc = u >> 3, h = u & 7;
        GLA_BAR();
        { LAS unsigned* dst = (LAS unsigned*)(VT + s_d8 * PITCH + s_tp);
            dst[0 * (PITCH / 2)] = (pv0.x & 0xffffu) | (pv1.x << 16); dst[1 * (PITCH / 2)] = (pv0.x >> 16) | (pv1.x & 0xffff0000u);
            dst[2 * (PITCH / 2)] = (pv0.y & 0xffffu) | (pv1.y << 16); dst[3 * (PITCH / 2)] = (pv0.y >> 16) | (pv1.y & 0xffff0000u);
            dst[4 * (PITCH / 2)] = (pv0.z & 0xffffu) | (pv1.z << 16); dst[5 * (PITCH / 2)] = (pv0.z >> 16) | (pv1.z & 0xffff0000u);
            dst[6 * (PITCH / 2)] = (pv0.w & 0xffffu) | (pv1.w << 16); dst[7 * (PITCH / 2)] = (pv0.w >> 16) | (pv1.w & 0xffff0000u);
            const int lo = s_t * PITCH + s_c8;
            *(LAS v4u*)(QFl + lo) = pqf; *(LAS v4u*)(KFl + lo) = pkf; *(LAS v4u*)(QBl + lo) = pqb; *(LAS v4u*)(KBl + lo) = pkb; }
        bf16x8 sf[4], sb[4];
#pragma unroll
        for (int ks = 0; ks < 4; ++ks) { sf[ks] = nsf[ks]; sb[ks] = nsb[ks]; }
        GLA_BAR();
        if (u + F.G < nrc * 8) G3_LOAD(u + F.G);
        f32x16 o = {};
#pragma unroll
        for (int ks = 0; ks < 4; ++ks) { o = __builtin_amdgcn_mfma_f32_32x32x16_bf16(sf[ks], GLA_FRAG(QFl, 32 * tb + r32, 16 * ks + 8 * hi), o, 0, 0, 0);
            o = __builtin_amdgcn_mfma_f32_32x32x16_bf16(sb[ks], GLA_FRAG(QBl, 32 * tb + r32, 16 * ks + 8 * hi), o, 0, 0, 0); }
        if (tb == 0) { g3_intra<0>(o, KFl, QFl, VT, 0, 0, db, r32, hi); g3_intra<1>(o, KBl, QBl, VT, 0, 0, db, r32, hi); g3_intra<1>(o, KBl, QBl, VT, 1, 0, db, r32, hi); }
        else         { g3_intra<0>(o, KFl, QFl, VT, 0, 1, db, r32, hi); g3_intra<0>(o, KFl, QFl, VT, 1, 1, db, r32, hi); g3_intra<1>(o, KBl, QBl, VT, 1, 1, db, r32, hi); }
        float ss = 0.f;
#pragma unroll
        for (int r = 0; r < 16; ++r) ss = fmaf(o[r], o[r], ss);
        { auto rr = __builtin_amdgcn_permlane32_swap(__float_as_uint(ss), __float_as_uint(ss), false, false); ss = __uint_as_float(rr[0]) + __uint_as_float(rr[1]); }
        if (hi == 0) SS[db * 64 + 32 * tb + r32] = ss;
        GLA_BAR();
        const int t = 32 * tb + r32;
        const float tot = (SS[t] + SS[64 + t]) + (SS[128 + t] + SS[192 + t]);
        const float rn = 1.0f / sqrtf(tot * (1.0f / 128.0f) + EPS);
        const size_t row = (size_t)rc * 64 + t;
#pragma unroll
        for (int g4 = 0; g4 < 4; ++g4) { const int dv0 = 32 * db + 8 * g4 + 4 * hi;
            const v2u gw = *(const v2u*)(P + row * DINP + C_GB + 128 * h + dv0); const f32x4 gn = *(const f32x4*)(gg + 128 * h + dv0);
            const float g0 = bflo(gw.x), g1 = bfhi(gw.x), g2 = bflo(gw.y), g3 = bfhi(gw.y);
            const float y0 = o[4 * g4 + 0] * rn * gn.x * (g0 / (1.0f + __expf(-g0))), y1 = o[4 * g4 + 1] * rn * gn.y * (g1 / (1.0f + __expf(-g1)));
            const float y2 = o[4 * g4 + 2] * rn * gn.z * (g2 / (1.0f + __expf(-g2))), y3 = o[4 * g4 + 3] * rn * gn.w * (g3 / (1.0f + __expf(-g3)));
            v2u w; w.x = pk2(y0, y1); w.y = pk2(y2, y3);
            *(v2u*)(MIX + row * D + 1024 + 128 * h + dv0) = w; }
    }
#undef G3_LOAD
    __syncthreads();
}
#undef GLA_PK4
#undef GLA_FRAG
#undef GLA_BAR
}

constexpr int N_PHASES = 54;
__host__ __device__ constexpr bool phase_active(int id) {
    if (id == 0 || id == N_PHASES - 1) return true;
    const int L = (id - 1) / 13, k = (id - 1) % 13; const bool even = (L & 1) == 0;
    if (k == 1 || k == 8) return !even;
    if (k >= 2 && k <= 7) return even;
    return true;
}

__global__ void __launch_bounds__(NWAVES * 64, 2) fwd_kernel(Args args) {
    extern __shared__ __attribute__((aligned(16))) unsigned char lds[];
    Frame F;
    F.lds = (LAS unsigned char*)lds; F.ldsg = lds;
    F.MISC = (volatile LAS unsigned*)(F.lds + MISC_OFF);
    F.tid = threadIdx.x; F.lane = F.tid & 63; F.wave = __builtin_amdgcn_readfirstlane(F.tid >> 6);
    F.G = gridDim.x; { const int bx = blockIdx.x; F.vcu = (F.G % 8 == 0) ? (bx % 8) * (F.G / 8) + bx / 8 : bx; }
    F.ka = (KArgs)__builtin_amdgcn_kernarg_segment_ptr(); F.ws = F.ka->ws;
    for (int u = F.tid; u < (LDS_BYTES - LDSCTL_OFF) / 4; u += NWAVES * 64) ((LAS unsigned*)(F.lds + LDSCTL_OFF))[u] = 0u;
    __syncthreads();
    unsigned* barw = (unsigned*)(F.ws + WS_CTL) + CW_BAR;
    XcdBarrier bar = xcd_barrier_post(barw, F.MISC + 8);
    const int lo = args.ph_lo, hi = args.ph_hi;
    bool started = false;
#ifndef PH_MASK
#define PH_MASK 0xFFFFFFFFu
#endif
#ifndef PH_REP
#define PH_REP 0u
#endif
#define PHASE_BEGIN(id, kind) if (((PH_MASK >> (kind)) & 1u) && lo <= (id) && (id) < hi) { if (started) xcd_barrier(bar); started = true; for (int _rep = 0; _rep < (((PH_REP >> (kind)) & 1u) ? 2 : 1); ++_rep) { \
    { int _t = threadIdx.x; asm volatile("" : "+v"(_t)); F.tid = _t; F.lane = _t & 63; F.wave = __builtin_amdgcn_readfirstlane(_t >> 6); KArgs _k = (KArgs)__builtin_amdgcn_kernarg_segment_ptr(); asm volatile("" : "+s"(_k)); F.ka = _k; F.ws = _k->ws; }
#define PHASE_END } }

    PHASE_BEGIN(0, 0) ph_prologue(F); PHASE_END

    const float* MOD = (const float*)(F.ws + WS_MOD);
    for (int L = 0; L < DEPTH; ++L) {
        const int base = 1 + 13 * L; const bool even = (L & 1) == 0; const int e = L >> 1;
        const float* modl = MOD + (size_t)L * 5 * MODW;
#define XRc ((const float*)(F.ws + WS_XR) + (size_t)MLAT * D)
        const int rows_mix_in = (L <= 2) ? MR : MLAT;
        const int rows_upd = (L <= 1) ? MR : MLAT;

        PHASE_BEGIN(base + 0, 1) {
            ph_norm(F, rows_mix_in, L == 0 ? (F.ka->in[I_X]) : (const float*)nullptr, L == 0 ? (F.ka->in[I_CTX]) : XRc, (F.ka->in[I_N1G]) + (size_t)L * D, modl, 0, D, 4);
            if (L == 0) {
                const f32x4* cs = (const f32x4*)(F.ka->in[I_CTX]); f32x4* xd = (f32x4*)(F.ws + WS_XR) + (size_t)MLAT * D / 4;
                for (int i = F.vcu * NWAVES * 64 + F.tid; i < MCTX * D / 4; i += F.G * NWAVES * 64) xd[i] = cs[i];
            }
        } PHASE_END
        if (!even) {
            PHASE_BEGIN(base + 1, 2) ph_pool(F, rows_upd); PHASE_END
        }
        if (even) {
            PHASE_BEGIN(base + 2, 3) {
                pg8::Gemm g{(const pg8::bf16_t*)(F.ws + WS_H), (const pg8::bf16_t*)(F.ws + WS_WIN) + (size_t)e * DINP * D, MR, DINP, D, D, D, 1, 0, 0};
                pg8::StaticOrder S; S.init(MR, DINP, D, 1, F.G, (int)blockIdx.x);
                pg8::EpiBf16 E{(pg8::bf16_t*)(F.ws + WS_P), DINP};
                pg8::gemm_phase<pg8::EpiBf16, pg8::StaticOrder, false>(F.lds + RING_OFF, g, S, E, F.tid);
            } PHASE_END
            PHASE_BEGIN(base + 3, 4) {
                gla::ph_prep(F, e);
                if (L == 0) {
                    const na::bf16* P = (const na::bf16*)(F.ws + WS_P); na::bf16* MIX = (na::bf16*)(F.ws + WS_MIX);
                    for (int q = blockIdx.x; q < 48; q += F.G) { const int uc = q - 16; if (uc < 0) continue; const int b = uc >> 3, h = uc & 7;
                        na::na_unit<DINP, D>(P, C_QA + 128 * h, C_KA + 128 * h, C_VA + 128 * h, (long)MLAT + b * CTXL, (long)MLAT + b * CTXL, 0, 0, 0, 0,
                                             MIX, 128 * h, (F.ka->in[I_RPB]), (char*)lds + RING_OFF, F.tid); }
                }
            } PHASE_END
            PHASE_BEGIN(base + 4, 5) {
                gla::ph_g1(F);
                const na::bf16* P = (const na::bf16*)(F.ws + WS_P); na::bf16* MIX = (na::bf16*)(F.ws + WS_MIX);
                for (int u = F.vcu; u < 512; u += F.G) { const int b = u >> 7, h = (u >> 4) & 7, i = u & 15;
                    const int klo = i == 0 ? 0 : (i == 15 ? 56 : 4 * i - 4), nband = (i == 0 || i == 15) ? 8 : 12;
                    na::na_unit<DINP, D>(P, C_QA + 128 * h, C_KA + 128 * h, C_VA + 128 * h, (long)b * SEQ + 256 * i, (long)MLAT + b * CTXL, (long)b * SEQ + 64 * klo, nband, klo, 4 * i,
                                         MIX, 128 * h, (F.ka->in[I_RPB]) + ((size_t)e * 8 + h) * 15 * 31, (char*)lds + RING_OFF, F.tid); }
            } PHASE_END
            PHASE_BEGIN(base + 5, 6) {
                gla::ph_g2(F);
            } PHASE_END
            PHASE_BEGIN(base + 6, 7) gla::ph_g3(F, e, L == 0 ? MR / 64 : MLAT / 64); PHASE_END
            PHASE_BEGIN(base + 7, 8) {
                const int M = rows_upd;
                pg8::Gemm g{(const pg8::bf16_t*)(F.ws + WS_MIX), (const pg8::bf16_t*)(F.ws + WS_WOUT) + (size_t)e * D * D, M, D, D, D, D, 1, 0, 0};
                pg8::SplitTailOrder S; S.init(MLAT, M - MLAT, D, D, 4, F.G, (int)blockIdx.x);
                pg8::EpiResid E{(float*)(F.ws + WS_PART), (pg8::bf16_t*)(F.ws + WS_X16), D, modl + 2 * D, MODW, nullptr, 0, MLAT, MCTX};
                pg8::gemm_phase<pg8::EpiResid, pg8::SplitTailOrder, true>(F.lds + RING_OFF, g, S, E, F.tid);
            } PHASE_END
        } else {
            PHASE_BEGIN(base + 8, 9) {
                const int M = rows_upd;
                pg8::Gemm g{(const pg8::bf16_t*)(F.ws + WS_MIX), (const pg8::bf16_t*)(F.ws + WS_WPOOL) + (size_t)e * 4 * 512 * 512, M, 512, 512, D, 512, 4, (size_t)512 * 2, (size_t)512 * 512 * 2};
                pg8::StaticOrder S; S.init(M, 512, 512, 4, F.G, (int)blockIdx.x);
                pg8::EpiResid E{(float*)(F.ws + WS_PART), (pg8::bf16_t*)(F.ws + WS_X16), D, modl + 2 * D, MODW, (F.ka->in[I_POOLS]) + (size_t)e * D, 512, MLAT, MCTX};
                pg8::gemm_phase<pg8::EpiResid, pg8::StaticOrder, true>(F.lds + RING_OFF, g, S, E, F.tid);
            } PHASE_END
        }
        PHASE_BEGIN(base + 9, 10) ph_norm(F, rows_upd, (const float*)nullptr, XRc, (F.ka->in[I_N2G]) + (size_t)L * D, modl, 3 * D, 4 * D, even ? 4 : 1); PHASE_END
        PHASE_BEGIN(base + 10, 11) {
            const int M = rows_upd;
            pg8::Gemm g{(const pg8::bf16_t*)(F.ws + WS_H), (const pg8::bf16_t*)(F.ws + WS_WUP) + (size_t)L * DUP * D, M, DUP, D, D, D, 1, 0, 0};
            pg8::StaticOrder S; S.init(M, DUP, D, 1, F.G, (int)blockIdx.x);
            pg8::EpiGlu E{(pg8::bf16_t*)(F.ws + WS_ACT), LDF, (F.ka->in[I_CONVW]) + (size_t)L * 3 * DFF, (F.ka->in[I_CONVB]) + (size_t)L * DFF, (float*)(F.ws + WS_SB), DFF, (PG8_LAS float*)(F.lds + RING_OFF + 131072)};
            pg8::gemm_phase<pg8::EpiGlu, pg8::StaticOrder, true>(F.lds + RING_OFF, g, S, E, F.tid);
        } PHASE_END
        PHASE_BEGIN(base + 11, 12) ph_glufix(F, rows_upd, (F.ka->in[I_CONVW]) + (size_t)L * 3 * DFF, (F.ka->in[I_CONVB]) + (size_t)L * DFF); PHASE_END
        PHASE_BEGIN(base + 12, 13) {
            const int M = rows_upd;
            pg8::Gemm g{(const pg8::bf16_t*)(F.ws + WS_ACT), (const pg8::bf16_t*)(F.ws + WS_WDOWN) + (size_t)L * D * LDF, M, D, DFF, LDF, LDF, 1, 0, 0};
            pg8::SplitTailOrder S; S.init(MLAT, M - MLAT, D, DFF, 4, F.G, (int)blockIdx.x);
            pg8::EpiResid E{(float*)(F.ws + WS_PART), (pg8::bf16_t*)(F.ws + WS_X16), D, modl + 5 * D, MODW, nullptr, 0, MLAT, MCTX};
            pg8::gemm_phase<pg8::EpiResid, pg8::SplitTailOrder, true>(F.lds + RING_OFF, g, S, E, F.tid);
        } PHASE_END
    }
#ifdef XTRA_BARRIERS
    for (int xb = 0; xb < XTRA_BARRIERS; ++xb) xcd_barrier(bar);
#endif
    PHASE_BEGIN(N_PHASES - 1, 14) ph_final(F); PHASE_END
#undef PHASE_BEGIN
#undef PHASE_END
#undef XRc
}

#ifndef MK_PER_PHASE
#define MK_PER_PHASE 0
#endif
extern "C" void kernel_launch(void* const* d_in, const int* in_sizes, int n_in, void* d_out, int out_size, void* d_ws, size_t ws_size, hipStream_t stream) {
    static int grid = 0;
    if (grid == 0) {
        if (n_in != 21 || in_sizes[0] != MLAT * D || out_size != MLAT * D || ws_size < WS_END) {
            fprintf(stderr, "kernel_launch: shape mismatch: n_in %d in0 %d out %d ws %zu (need %zu); nothing launched\n", n_in, n_in > 0 ? in_sizes[0] : -1, out_size, ws_size, (size_t)WS_END); grid = -1; return; }
        int dev = 0, cus = 0, per_cu = 0;
        if (hipGetDevice(&dev) != hipSuccess || hipDeviceGetAttribute(&cus, hipDeviceAttributeMultiprocessorCount, dev) != hipSuccess) { fprintf(stderr, "kernel_launch: device query failed\n"); grid = -1; return; }
        if (hipFuncSetAttribute((const void*)fwd_kernel, hipFuncAttributeMaxDynamicSharedMemorySize, LDS_BYTES) != hipSuccess) { fprintf(stderr, "kernel_launch: hipFuncSetAttribute failed\n"); grid = -1; return; }
        if (hipOccupancyMaxActiveBlocksPerMultiprocessor(&per_cu, (const void*)fwd_kernel, NWAVES * 64, LDS_BYTES) != hipSuccess || per_cu < 1) {
            fprintf(stderr, "kernel_launch: occupancy query reports %d workgroups per CU\n", per_cu); }
        (void)hipGetLastError();
        grid = cus;
    }
    if (grid < 0) return;
    if (hipMemsetAsync((char*)d_ws + WS_CTL, 0, CTL_ZERO_BYTES, stream) != hipSuccess) { fprintf(stderr, "kernel_launch: memset failed\n"); return; }
    Args a{};
    for (int i = 0; i < 21; ++i) a.in[i] = (const float*)d_in[i];
    a.out = (float*)d_out; a.ws = (unsigned char*)d_ws;
#if MK_PER_PHASE
    for (int p = 0; p < N_PHASES; ++p) { if (!phase_active(p)) continue; a.ph_lo = p; a.ph_hi = p + 1;
        hipLaunchKernelGGL(fwd_kernel, dim3(grid), dim3(NWAVES * 64), LDS_BYTES, stream, a); }
#else
    a.ph_lo = 0; a.ph_hi = N_PHASES;
    hipLaunchKernelGGL(fwd_kernel, dim3(grid), dim3(NWAVES * 64), LDS_BYTES, stream, a);
#endif
    const hipError_t le = hipPeekAtLastError();
    if (le != hipSuccess) fprintf(stderr, "kernel_launch: launch failed: %s\n", hipGetErrorName(le));
}
```

```cpp
#include <hip/hip_runtime.h>
#include <cstdio>
#include <cstdint>

namespace pg8 {
#define PG8_LAS __attribute__((address_space(3)))
typedef unsigned short bf16_t;
typedef short bf16x8 __attribute__((ext_vector_type(8)));
typedef float f32x4 __attribute__((ext_vector_type(4)));
typedef float f32x2 __attribute__((ext_vector_type(2)));
typedef unsigned u32x4 __attribute__((ext_vector_type(4)));
constexpr int BM = 256, BK = 64, HALF = 128, HTB = HALF * BK * 2  , STAGE_BYTES = 8 * HTB, NXCD = 8;

__host__ __device__ __forceinline__ int lds_byte(int r, int c) { const int st = (r >> 4) * 2 + (c >> 5), rr = r & 15, cc = c & 31, ob = rr * 64 + cc * 2; return st * 1024 + (ob ^ (((ob >> 9) & 1) << 5)); }
__host__ __device__ __forceinline__ void stage_rc(int b, int& R, int& C) { const int st = b / 1024, sb = b % 1024, swz = sb ^ (((sb >> 9) & 1) << 5); R = (st >> 1) * 16 + swz / 64; C = (st & 1) * 32 + (swz % 64) / 2; }
__host__ __device__ __forceinline__ int perm32(int rho) { const int n = rho >> 4, i = rho & 15; return 8 * (i >> 2) + 4 * n + (i & 3); }

struct Unit { int pm, pn, grp, kt0, nkt, atomic; };
struct Gemm { const bf16_t* A; const bf16_t* Bt; int M, N, K, lda, ldb, ngrp; size_t gsA, gsB; };

struct StaticOrder {
    int nM, nN, nNr, nwg, G, c, nktK, WGM = 4;
    __host__ __device__ void init(int M, int N, int K, int ngrp, int G_, int c_) { nM = M / BM; nNr = N / BM; nN = nNr * ngrp; nwg = nM * nN; G = G_; c = c_; nktK = K / BK; }
    __host__ __device__ bool next(int i, Unit& u) const {
        const long L = (long)i * G + c; if (L >= nwg) return false;
        int wgid = (int)L; { const int q = nwg / NXCD, r = nwg % NXCD, xcd = wgid % NXCD, off = wgid / NXCD; wgid = (xcd < r ? xcd * (q + 1) : r * (q + 1) + (xcd - r) * q) + off; }
        int nig = WGM * nN, nr = nNr;
#if defined(__HIP_DEVICE_COMPILE__)
        asm volatile("" : "+s"(nig), "+s"(nr));
#endif
        const int gid = wgid / nig, fm = gid * WGM, gsz = (nM - fm) < WGM ? (nM - fm) : WGM;
        u.pm = fm + ((wgid % nig) % gsz); const int vn = (wgid % nig) / gsz; u.pn = vn % nr; u.grp = vn / nr; u.kt0 = 0; u.nkt = nktK; u.atomic = 0; return true;
    }
    __device__ __forceinline__ void a_ready(const Unit&) const {}
    __device__ __forceinline__ void done(const Unit&) const {}
};
struct SplitTailOrder {
    StaticOrder main; int nA, nB, nNr, SK, nks, pmB, G, c;
    __host__ __device__ void init(int MA, int MB, int N, int K, int SK_, int G_, int c_) { main.init(MA, N, K, 1, G_, c_); nA = main.nwg; nNr = N / BM; SK = SK_; nks = (K / BK) / SK_; pmB = MA / BM; nB = (MB / BM) * nNr * SK_; G = G_; c = c_; }
    __host__ __device__ bool next(int i, Unit& u) const {
        const long L = (long)i * G + c;
        if (L < nA) return main.next(i, u);
        const int Lb = (int)(L - nA); if (Lb >= nB) return false;
        const int ks = Lb % SK, tile = Lb / SK; u.pn = tile % nNr; u.pm = pmB + tile / nNr; u.grp = 0; u.kt0 = ks * nks; u.nkt = nks; u.atomic = 1 + ks; return true;
    }
    __device__ __forceinline__ void a_ready(const Unit&) const {}
    __device__ __forceinline__ void done(const Unit&) const {}
};

__device__ __forceinline__ unsigned cvt_pk_bf16(float lo, float hi) { unsigned r; asm volatile("v_cvt_pk_bf16_f32 %0, %1, %2" : "=v"(r) : "v"(lo), "v"(hi)); return r; }
typedef _Float16 f16x2 __attribute__((ext_vector_type(2)));
__device__ __forceinline__ unsigned pk_h2(float lo, float hi) { f16x2 p; p.x = (_Float16)__builtin_amdgcn_fmed3f(lo, -65504.0f, 65504.0f); p.y = (_Float16)__builtin_amdgcn_fmed3f(hi, -65504.0f, 65504.0f); return __builtin_bit_cast(unsigned, p); }
__device__ __forceinline__ float h_lo(unsigned w) { return (float)__builtin_bit_cast(f16x2, w).x; }
__device__ __forceinline__ float h_hi(unsigned w) { return (float)__builtin_bit_cast(f16x2, w).y; }
template <unsigned BITS> __device__ __forceinline__ float kc() { float r; asm volatile("s_mov_b32 %0, %1" : "=s"(r) : "n"(BITS)); return r; }
__device__ __forceinline__ void gelu4(const f32x2 (&v)[4], f32x2 (&o)[4]) {
    f32x2 c[4], w[4], q[4];
#pragma unroll
    for (int p = 0; p < 4; ++p) { c[p].x = __builtin_amdgcn_fmed3f(v[p].x, -5.0f, 5.0f); c[p].y = __builtin_amdgcn_fmed3f(v[p].y, -5.0f, 5.0f); w[p] = (c[p] * c[p]) * 0.08f + (-1.0f); }
    { const float ka = kc<0x3a40c646u>(), kb = kc<0xbadbc5c1u>();
#pragma unroll
      for (int p = 0; p < 4; ++p) q[p] = w[p] * ka + kb; }
    { const float kk = kc<0x3ab42bcbu>();
#pragma unroll
      for (int p = 0; p < 4; ++p) q[p] = q[p] * w[p] + kk; }
    { const float kk = kc<0xbb259aa1u>();
#pragma unroll
      for (int p = 0; p < 4; ++p) q[p] = q[p] * w[p] + kk; }
    { const float kk = kc<0x3bddb9bfu>();
#pragma unroll
      for (int p = 0; p < 4; ++p) q[p] = q[p] * w[p] + kk; }
    { const float kk = kc<0xbc394185u>();
#pragma unroll
      for (int p = 0; p < 4; ++p) q[p] = q[p] * w[p] + kk; }
    { const float kk = kc<0x3c85018cu>();
#pragma unroll
      for (int p = 0; p < 4; ++p) q[p] = q[p] * w[p] + kk; }
    { const float kk = kc<0xbcbe2975u>();
#pragma unroll
      for (int p = 0; p < 4; ++p) q[p] = q[p] * w[p] + kk; }
    { const float kk = kc<0x3d00edc6u>();
#pragma unroll
      for (int p = 0; p < 4; ++p) q[p] = q[p] * w[p] + kk; }
    { const float kk = kc<0xbd25b03eu>();
#pragma unroll
      for (int p = 0; p < 4; ++p) q[p] = q[p] * w[p] + kk; }
    { const float kk = kc<0x3d530477u>();
#pragma unroll
      for (int p = 0; p < 4; ++p) q[p] = q[p] * w[p] + kk; }
    { const float kk = kc<0xbd8ff74du>();
#pragma unroll
      for (int p = 0; p < 4; ++p) q[p] = q[p] * w[p] + kk; }
    { const float kk = kc<0x3e10c1adu>();
#pragma unroll
      for (int p = 0; p < 4; ++p) q[p] = q[p] * w[p] + kk; }
#pragma unroll
    for (int p = 0; p < 4; ++p) o[p] = v[p] * (q[p] * c[p] + 0.5f);
}

__device__ __forceinline__ f32x2 gelu_pk(f32x2 v) {
    f32x2 c; c.x = __builtin_amdgcn_fmed3f(v.x, -5.0f, 5.0f); c.y = __builtin_amdgcn_fmed3f(v.y, -5.0f, 5.0f);
    const f32x2 w = (c * c) * 0.08f + (-1.0f);
    f32x2 q = w * 7.353763795e-04f + (-1.676730928e-03f);
    q = q * w + 1.374596148e-03f; q = q * w + (-2.526916796e-03f); q = q * w + 6.766527425e-03f; q = q * w + (-1.130712498e-02f); q = q * w + 1.623608917e-02f;
    q = q * w + (-2.321312763e-02f); q = q * w + 3.147675842e-02f; q = q * w + (-4.045128077e-02f); q = q * w + 5.151792988e-02f; q = q * w + (-7.029590756e-02f); q = q * w + 1.413638145e-01f;
    return v * (q * c + 0.5f);
}

struct EpiBf16 {
    static constexpr bool PERM = true;
    bf16_t* O; int ldc;
    __device__ __forceinline__ void operator()(const f32x4 (&acc)[2][2][4][2], const Unit& u, int wr, int wc, int fr, int fq) const {
        const int row0 = u.pm * BM + wr * 64 + fr; const int col0 = u.pn * BM + wc * 32 + 8 * fq;
#pragma unroll
        for (int ai = 0; ai < 2; ++ai)
#pragma unroll
            for (int m = 0; m < 4; ++m) { bf16_t* rowp = O + (size_t)(row0 + ai * HALF + m * 16) * ldc + col0;
#pragma unroll
                for (int bj = 0; bj < 2; ++bj) { const f32x4 v0 = acc[ai][bj][m][0], v1 = acc[ai][bj][m][1];
                    u32x4 w; w.x = cvt_pk_bf16(v0[0], v0[1]); w.y = cvt_pk_bf16(v0[2], v0[3]); w.z = cvt_pk_bf16(v1[0], v1[1]); w.w = cvt_pk_bf16(v1[2], v1[3]);
                    *(u32x4*)(rowp + bj * HALF) = w; } }
    }
};
struct EpiGlu {
    static constexpr bool PERM = true;
    bf16_t* ACT; int ldc; const float* cw; const float* cb; float* SB; int dff; PG8_LAS float* XB;
    static __device__ __forceinline__ float ror1(float v)  { return __builtin_bit_cast(float, __builtin_amdgcn_update_dpp(0, __builtin_bit_cast(int, v), 0x121, 0xf, 0xf, true)); }
    static __device__ __forceinline__ float ror15(float v) { return __builtin_bit_cast(float, __builtin_amdgcn_update_dpp(0, __builtin_bit_cast(int, v), 0x12f, 0xf, 0xf, true)); }
    __device__ __forceinline__ void operator()(const f32x4 (&acc)[2][2][4][2], const Unit& u, int wr, int wc, int fr, int fq) const {
        const int ch0 = u.pn * HALF + wc * 32 + 8 * fq; const bool l0 = (fr == 0), l15 = (fr == 15);
        PG8_LAS float* xme = XB + ((wr * 4 + wc) * 4) * 32 + fq * 8;
#pragma unroll
        for (int ai = 0; ai < 2; ++ai) {
            if (fr == 0)  { *(PG8_LAS f32x4*)(xme + (ai * 2 + 0) * 32) = acc[ai][1][0][0]; *(PG8_LAS f32x4*)(xme + (ai * 2 + 0) * 32 + 4) = acc[ai][1][0][1]; }
            if (fr == 15) { *(PG8_LAS f32x4*)(xme + (ai * 2 + 1) * 32) = acc[ai][1][3][0]; *(PG8_LAS f32x4*)(xme + (ai * 2 + 1) * 32 + 4) = acc[ai][1][3][1]; }
        }
        asm volatile("s_waitcnt lgkmcnt(0)" ::: "memory"); __builtin_amdgcn_s_barrier(); asm volatile("" ::: "memory");
        f32x4 w0[2], w1[2], w2[2], bb[2];
#pragma unroll
        for (int n = 0; n < 2; ++n) { w0[n] = *(const f32x4*)(cw + ch0 + 4 * n); w1[n] = *(const f32x4*)(cw + dff + ch0 + 4 * n); w2[n] = *(const f32x4*)(cw + 2 * dff + ch0 + 4 * n); bb[n] = *(const f32x4*)(cb + ch0 + 4 * n); }
#pragma unroll
        for (int ai = 0; ai < 2; ++ai) {
            const int rp = 128 * ai + 64 * wr - 1, rn = 128 * ai + 64 * wr + 64;
            f32x4 xp[2], xn[2];
#pragma unroll
            for (int n = 0; n < 2; ++n) { xp[n] = (f32x4){0.f, 0.f, 0.f, 0.f}; xn[n] = (f32x4){0.f, 0.f, 0.f, 0.f}; }
            if (rp >= 0)  { const PG8_LAS float* s = XB + ((((rp >> 6) & 1) * 4 + wc) * 4 + (rp >> 7) * 2 + 1) * 32 + fq * 8; xp[0] = *(const PG8_LAS f32x4*)s; xp[1] = *(const PG8_LAS f32x4*)(s + 4); }
            if (rn < 256) { const PG8_LAS float* s = XB + ((((rn >> 6) & 1) * 4 + wc) * 4 + (rn >> 7) * 2 + 0) * 32 + fq * 8; xn[0] = *(const PG8_LAS f32x4*)s; xn[1] = *(const PG8_LAS f32x4*)(s + 4); }
#pragma unroll
            for (int m = 0; m < 4; ++m) {
                const int row = u.pm * BM + ai * HALF + wr * 64 + m * 16 + fr;
                u32x4 ow; float cv[8];
#pragma unroll
                for (int n = 0; n < 2; ++n)
#pragma unroll
                    for (int j = 0; j < 4; ++j) {
                        const float g = acc[ai][1][m][n][j];
                        const float tp = l15 ? ((m > 0) ? acc[ai][1][m > 0 ? m - 1 : 0][n][j] : xp[n][j]) : g;
                        const float tn = l0  ? ((m < 3) ? acc[ai][1][m < 3 ? m + 1 : 3][n][j] : xn[n][j]) : g;
                        const float gp = ror1(tp), gn = ror15(tn);
                        cv[4 * n + j] = fmaf(w0[n][j], gp, fmaf(w1[n][j], g, fmaf(w2[n][j], gn, bb[n][j])));
                    }
                const int tr = ai * HALF + wr * 64 + m * 16 + fr;
                if (tr == 0 || tr == 255) { float* sb = SB + ((size_t)(u.pm * 2 + (tr ? 1 : 0)) * 3) * dff + ch0;
#pragma unroll
                    for (int n = 0; n < 2; ++n) { *(f32x4*)(sb + 4 * n) = (f32x4){cv[4 * n], cv[4 * n + 1], cv[4 * n + 2], cv[4 * n + 3]}; *(f32x4*)(sb + dff + 4 * n) = acc[ai][0][m][n]; *(f32x4*)(sb + 2 * dff + 4 * n) = acc[ai][1][m][n]; } }
                f32x2 gv[4], go[4]; float a[8];
#pragma unroll
                for (int p = 0; p < 4; ++p) gv[p] = (f32x2){cv[2 * p], cv[2 * p + 1]};
                gelu4(gv, go);
#pragma unroll
                for (int e = 0; e < 8; e += 2) { a[e] = go[e >> 1].x * acc[ai][0][m][e >> 2][e & 3]; a[e + 1] = go[e >> 1].y * acc[ai][0][m][(e + 1) >> 2][(e + 1) & 3]; }
                ow.x = cvt_pk_bf16(a[0], a[1]); ow.y = cvt_pk_bf16(a[2], a[3]); ow.z = cvt_pk_bf16(a[4], a[5]); ow.w = cvt_pk_bf16(a[6], a[7]);
                *(u32x4*)(ACT + (size_t)row * ldc + ch0) = ow;
            }
        }
    }
};
struct EpiResid {
    static constexpr bool PERM = true;
    float* PART; bf16_t* X16; int ldx; const float* gate; int gstride; const float* cscale; int gcols; int mlat; int mctx;
    __device__ __forceinline__ void operator()(const f32x4 (&acc)[2][2][4][2], const Unit& u, int wr, int wc, int fr_, int fq_) const {
        int fr = fr_, fq = fq_; asm volatile("" : "+v"(fr), "+v"(fq));
        const int row0 = u.pm * BM + wr * 64 + fr, col0 = u.grp * gcols + u.pn * BM + wc * 32 + 8 * fq;
        const int rowt = u.pm * BM; const int bidx = rowt < mlat ? (rowt >> 12) : 4;
        const float* gp = gate + (size_t)bidx * gstride + col0;
        f32x4 gv[2][2];
#pragma unroll
        for (int bj = 0; bj < 2; ++bj)
#pragma unroll
            for (int n = 0; n < 2; ++n) { gv[bj][n] = *(const f32x4*)(gp + bj * HALF + n * 4); if (cscale) gv[bj][n] = gv[bj][n] * *(const f32x4*)(cscale + col0 + bj * HALF + n * 4); }
        if (rowt >= mlat) {
            float* base = PART + ((size_t)(u.atomic ? u.atomic - 1 : 0) * mctx + (size_t)(row0 - mlat)) * ldx + col0;
            f32x4 gc[2][2] = {{gv[0][0], gv[0][1]}, {gv[1][0], gv[1][1]}}; asm volatile("" : "+v"(gc[0][0]), "+v"(gc[0][1]), "+v"(gc[1][0]), "+v"(gc[1][1]));
#pragma unroll
            for (int ai = 0; ai < 2; ++ai)
#pragma unroll
                for (int m = 0; m < 4; ++m) { float* rowp = base + (size_t)(ai * HALF + m * 16) * ldx;
#pragma unroll
                    for (int bj = 0; bj < 2; ++bj)
#pragma unroll
                        for (int n = 0; n < 2; ++n) *(f32x4*)(rowp + bj * HALF + n * 4) = acc[ai][bj][m][n] * gc[bj][n]; }
        } else {
            u32x4 xin[2][4][2];
#pragma unroll
            for (int ai = 0; ai < 2; ++ai)
#pragma unroll
                for (int m = 0; m < 4; ++m)
#pragma unroll
                    for (int bj = 0; bj < 2; ++bj) xin[ai][m][bj] = *(const u32x4*)(X16 + (size_t)(row0 + ai * HALF + m * 16) * ldx + col0 + bj * HALF);
            asm volatile("" ::: "memory");
#pragma unroll
            for (int ai = 0; ai < 2; ++ai)
#pragma unroll
                for (int m = 0; m < 4; ++m)
#pragma unroll
                    for (int bj = 0; bj < 2; ++bj) { const u32x4 h = xin[ai][m][bj]; const f32x4 a0 = acc[ai][bj][m][0] * gv[bj][0], a1 = acc[ai][bj][m][1] * gv[bj][1];
                        u32x4 w;
                        w.x = pk_h2(h_lo(h.x) + a0[0], h_hi(h.x) + a0[1]); w.y = pk_h2(h_lo(h.y) + a0[2], h_hi(h.y) + a0[3]);
                        w.z = pk_h2(h_lo(h.z) + a1[0], h_hi(h.z) + a1[1]); w.w = pk_h2(h_lo(h.w) + a1[2], h_hi(h.w) + a1[3]);
                        *(u32x4*)(X16 + (size_t)(row0 + ai * HALF + m * 16) * ldx + col0 + bj * HALF) = w; }
        }
    }
};

template <class Epi, class Sched, bool ALIGN_EPI = true>
__device__ __forceinline__ void gemm_phase(PG8_LAS unsigned char* lds, const Gemm g, const Sched& S, const Epi& E, const int tid) {
    const int wid = __builtin_amdgcn_readfirstlane(tid >> 6), lane = tid & 63, wr = wid >> 2, wc = wid & 3, fr = lane & 15, fq = lane >> 4;
    unsigned voffA[2], voffB[2];
#pragma unroll
    for (int i = 0; i < 2; ++i) { int R, C; stage_rc(tid * 16 + i * 8192, R, C); const int Rb = Epi::PERM ? ((R & ~31) + perm32(R & 31)) : R;
        voffA[i] = (unsigned)(R * g.lda + C) * 2u; voffB[i] = (unsigned)(Rb * g.ldb + C) * 2u; }
    const size_t kstep = (size_t)(BK * 2);
    const size_t hstepA = (size_t)HALF * g.lda * 2, hstepB = (size_t)HALF * g.ldb * 2;
    const size_t tstepA = 2 * hstepA, tstepB = 2 * hstepB;
    const unsigned ldsw = (unsigned)wid * 1024u;
    const int aoff = lds_byte(wr * 64 + fr, fq * 8), boff = lds_byte(wc * 32 + fr, fq * 8);
#define PG8_SA(b, h) (((b) * 2 + (h)) * HTB)
#define PG8_SB(b, h) ((4 + (b) * 2 + (h)) * HTB)
#define PG8_STAGE(bufoff, gbase, voff) do { _Pragma("unroll") for (int _i = 0; _i < 2; ++_i) \
        __builtin_amdgcn_global_load_lds((const unsigned*)((const char*)(gbase) + (voff)[_i]), (PG8_LAS unsigned*)(lds + (bufoff) + ldsw + _i * 8192), 16, 0, 0); } while (0)
#define PG8_LDA(dst, b, h) do { _Pragma("unroll") for (int m = 0; m < 4; ++m) _Pragma("unroll") for (int k = 0; k < 2; ++k) dst[m][k] = *(const PG8_LAS bf16x8*)(lds + PG8_SA(b, h) + aoff + m * 2048 + k * 1024); } while (0)
#define PG8_LDB(dst, b, h) do { _Pragma("unroll") for (int n = 0; n < 2; ++n) _Pragma("unroll") for (int k = 0; k < 2; ++k) dst[n][k] = *(const PG8_LAS bf16x8*)(lds + PG8_SB(b, h) + boff + n * 2048 + k * 1024); } while (0)
#define PG8_MMA(ai, bj, At, Bt) do { __builtin_amdgcn_s_setprio(1); _Pragma("unroll") for (int m = 0; m < 4; ++m) _Pragma("unroll") for (int n = 0; n < 2; ++n) _Pragma("unroll") for (int k = 0; k < 2; ++k) \
        acc[ai][bj][m][n] = __builtin_amdgcn_mfma_f32_16x16x32_bf16(Bt[n][k], At[m][k], acc[ai][bj][m][n], 0, 0, 0); __builtin_amdgcn_s_setprio(0); } while (0)
#define PG8_WAIT_V(n) asm volatile("s_waitcnt vmcnt(" #n ")" ::: "memory")
#define PG8_WAIT_L(n) asm volatile("s_waitcnt lgkmcnt(" #n ")" ::: "memory")
#define PG8_BAR __builtin_amdgcn_s_barrier()
#define PG8_SCHED __builtin_amdgcn_sched_barrier(0)
    Unit cur, nxt; int ui = 0;
    if (!S.next(0, cur)) return;
    f32x4 acc[2][2][4][2];
#pragma unroll
    for (int a = 0; a < 2; ++a)
#pragma unroll
        for (int b = 0; b < 2; ++b)
#pragma unroll
            for (int m = 0; m < 4; ++m)
#pragma unroll
                for (int n = 0; n < 2; ++n) acc[a][b][m][n] = (f32x4){0.f, 0.f, 0.f, 0.f};
    bf16x8 At[4][2], B0[2][2], B1[2][2];
    const char* cA = (const char*)g.A + (size_t)cur.pm * tstepA + (size_t)cur.grp * g.gsA + (size_t)cur.kt0 * kstep; const char* cB = (const char*)g.Bt + (size_t)cur.pn * tstepB + (size_t)cur.grp * g.gsB + (size_t)cur.kt0 * kstep;
    S.a_ready(cur);
    PG8_STAGE(PG8_SB(0, 0), cB, voffB); PG8_STAGE(PG8_SB(0, 1), cB + hstepB, voffB); PG8_STAGE(PG8_SA(0, 0), cA, voffA); PG8_STAGE(PG8_SA(0, 1), cA + hstepA, voffA);
    if (wr == 1) PG8_BAR;
    PG8_WAIT_V(2); PG8_BAR;
    PG8_STAGE(PG8_SB(1, 0), cB + kstep, voffB); PG8_STAGE(PG8_SA(1, 0), cA + kstep, voffA); PG8_STAGE(PG8_SB(1, 1), cB + hstepB + kstep, voffB);
    PG8_WAIT_V(6); PG8_BAR;
    for (;;) {
        const bool has_next = S.next(ui + 1, nxt);
        const char* nA = has_next ? (const char*)g.A + (size_t)nxt.pm * tstepA + (size_t)nxt.grp * g.gsA + (size_t)nxt.kt0 * kstep : cA;
        const char* nB = has_next ? (const char*)g.Bt + (size_t)nxt.pn * tstepB + (size_t)nxt.grp * g.gsB + (size_t)nxt.kt0 * kstep : cB;
        const int nt = cur.nkt;
        for (int t = 0; t < nt; t += 2) {
            const bool last = (t == nt - 2);
            const char* a1 = cA + (size_t)(t + 1) * kstep;
            const char* a2 = last ? nA : cA + (size_t)(t + 2) * kstep; const char* b2 = last ? nB : cB + (size_t)(t + 2) * kstep;
            const char* a3 = a2 + kstep; const char* b3 = b2 + kstep;
            if (last && has_next) S.a_ready(nxt);
            PG8_LDB(B0, 0, 0); PG8_LDB(B1, 0, 1); PG8_SCHED; PG8_LDA(At, 0, 0); PG8_STAGE(PG8_SA(1, 1), a1 + hstepA, voffA);
            PG8_WAIT_V(8); PG8_WAIT_L(0); PG8_BAR; PG8_MMA(0, 0, At, B0); PG8_MMA(0, 1, At, B1); PG8_BAR; PG8_SCHED;
            PG8_LDA(At, 0, 1); PG8_STAGE(PG8_SB(0, 0), b2, voffB); PG8_STAGE(PG8_SB(0, 1), b2 + hstepB, voffB); PG8_STAGE(PG8_SA(0, 0), a2, voffA);
            PG8_WAIT_V(8); PG8_WAIT_L(0); PG8_BAR; PG8_MMA(1, 0, At, B0); PG8_MMA(1, 1, At, B1); PG8_BAR; PG8_SCHED;
            PG8_LDB(B0, 1, 0); PG8_LDB(B1, 1, 1); PG8_SCHED; PG8_LDA(At, 1, 0); PG8_STAGE(PG8_SA(0, 1), a2 + hstepA, voffA);
            PG8_WAIT_V(8); PG8_WAIT_L(0); PG8_BAR; PG8_MMA(0, 0, At, B0); PG8_MMA(0, 1, At, B1); PG8_BAR; PG8_SCHED;
            PG8_LDA(At, 1, 1); PG8_STAGE(PG8_SB(1, 0), b3, voffB); PG8_STAGE(PG8_SB(1, 1), b3 + hstepB, voffB); PG8_STAGE(PG8_SA(1, 0), a3, voffA);
            PG8_WAIT_V(8); PG8_WAIT_L(0); PG8_BAR; PG8_MMA(1, 0, At, B0); PG8_MMA(1, 1, At, B1); PG8_BAR; PG8_SCHED;
        }
        if constexpr (ALIGN_EPI) { if (wr == 0) PG8_BAR; }
        E(acc, cur, wr, wc, fr, fq); S.done(cur);
        if (!has_next) break;
#pragma unroll
        for (int a = 0; a < 2; ++a)
#pragma unroll
            for (int b = 0; b < 2; ++b)
#pragma unroll
                for (int m = 0; m < 4; ++m)
#pragma unroll
                    for (int n = 0; n < 2; ++n) acc[a][b][m][n] = (f32x4){0.f, 0.f, 0.f, 0.f};
        cur = nxt; cA = nA; cB = nB; ++ui;
        if constexpr (ALIGN_EPI) { if (wr == 1) PG8_BAR; }
    }
    PG8_WAIT_V(0);
    if constexpr (!ALIGN_EPI) { if (wr == 0) PG8_BAR; }
    PG8_BAR;
#undef PG8_SA
#undef PG8_SB
#undef PG8_STAGE
#undef PG8_LDA
#undef PG8_LDB
#undef PG8_MMA
#undef PG8_WAIT_V
#undef PG8_WAIT_L
#undef PG8_BAR
#undef PG8_SCHED
}
}

namespace na {
typedef unsigned short bf16;
using bf16x8 = __attribute__((ext_vector_type(8))) short;
using s16x4  = __attribute__((ext_vector_type(4))) short;
using f32x16 = __attribute__((ext_vector_type(16))) float;
using u32x4  = __attribute__((ext_vector_type(4))) unsigned;
constexpr int   D = 128, NW = 8, QBLK = 32, KVBLK = 64;
constexpr float SCALE = 0.088388347648318440f;
constexpr float THR = 8.f;
constexpr float NEG = -1.0e30f;
constexpr size_t SHM_V = KVBLK * D * 2, SHM_K = KVBLK * D * 2, SHM_ATTN = 2 * SHM_V + 2 * SHM_K + NW * 64 * 4;
constexpr size_t BIAS_OFF = 69632;
constexpr size_t PEN_OFF = BIAS_OFF + 640 * 4;
constexpr size_t QS_OFF = 73728;
constexpr size_t LDS_END = QS_OFF + NW * 8192;
#define NA_KSWZ(row, colB) ((row) * 256 + ((colB) ^ (((row) & 7) << 4)))
#define NA_SBAR() __builtin_amdgcn_sched_barrier(0)
__device__ __forceinline__ int crow(int r, int hi) { return (r & 3) + 8 * (r >> 2) + 4 * hi; }
__device__ __forceinline__ unsigned cvtpk(float lo, float hi) { unsigned r; asm volatile("v_cvt_pk_bf16_f32 %0, %1, %2" : "=v"(r) : "v"(lo), "v"(hi)); return r; }

__device__ __forceinline__ void partialSM(f32x16& p0, f32x16& p1, float& m_reg, float& mn, float& alpha) {
  constexpr float C = SCALE * 1.4426950408889634f;
  float pmax = p0[0];
#pragma unroll
  for (int r = 1; r < 16; ++r) pmax = fmaxf(pmax, p0[r]);
#pragma unroll
  for (int r = 0; r < 16; ++r) pmax = fmaxf(pmax, p1[r]);
  { auto rr = __builtin_amdgcn_permlane32_swap(__float_as_uint(pmax), __float_as_uint(pmax), false, false);
    pmax = fmaxf(__uint_as_float(rr[0]), __uint_as_float(rr[1])); }
  if (__builtin_expect(__all(pmax - m_reg <= THR / SCALE), 1)) { mn = m_reg; alpha = 1.f; }
  else { mn = fmaxf(m_reg, pmax); alpha = __builtin_amdgcn_exp2f((m_reg - mn) * C); m_reg = mn; }
  float mnC = -mn * C;
#pragma unroll
  for (int r = 0; r < 16; ++r) p0[r] = fmaf(p0[r], C, mnC);
#pragma unroll
  for (int r = 0; r < 16; ++r) p1[r] = fmaf(p1[r], C, mnC);
#pragma unroll
  for (int r = 0; r < 16; ++r) p0[r] = __builtin_amdgcn_exp2f(p0[r]);
}
__device__ __forceinline__ void finishSM(f32x16& p0, f32x16& p1, float alpha, float& l_reg, bf16x8& pa0, bf16x8& pa1, bf16x8& pa2, bf16x8& pa3) {
#pragma unroll
  for (int r = 0; r < 16; ++r) p1[r] = __builtin_amdgcn_exp2f(p1[r]);
  float ps = 0;
#pragma unroll
  for (int r = 0; r < 16; ++r) ps += p0[r];
#pragma unroll
  for (int r = 0; r < 16; ++r) ps += p1[r];
  { auto rr = __builtin_amdgcn_permlane32_swap(__float_as_uint(ps), __float_as_uint(ps), false, false);
    ps = __uint_as_float(rr[0]) + __uint_as_float(rr[1]); }
  l_reg = l_reg * alpha + ps;
#define NA_PK4(P, BASE, OUT) do { unsigned a0 = cvtpk(P[BASE + 0], P[BASE + 1]), a1 = cvtpk(P[BASE + 2], P[BASE + 3]);   \
    unsigned b0 = cvtpk(P[BASE + 4], P[BASE + 5]), b1 = cvtpk(P[BASE + 6], P[BASE + 7]);                              \
    auto r0 = __builtin_amdgcn_permlane32_swap(a0, b0, false, false); auto r1 = __builtin_amdgcn_permlane32_swap(a1, b1, false, false); \
    u32x4 w = {r0[0], r1[0], r0[1], r1[1]}; OUT = *reinterpret_cast<bf16x8*>(&w); } while (0)
  NA_PK4(p0, 0, pa0); NA_PK4(p0, 8, pa1); NA_PK4(p1, 0, pa2); NA_PK4(p1, 8, pa3);
#undef NA_PK4
}
__device__ __forceinline__ void qkt(f32x16& p0, f32x16& p1, const bf16* Ks, const bf16x8* qs, int r32, int hi) {
#pragma unroll
  for (int d0 = 0; d0 < 8; ++d0) { int cb = (d0 * 16 + hi * 8) * 2; const bf16x8 q = qs[d0 * 64];
    bf16x8 b0 = *reinterpret_cast<const bf16x8*>((const char*)Ks + NA_KSWZ(r32, cb));
    bf16x8 b1 = *reinterpret_cast<const bf16x8*>((const char*)Ks + NA_KSWZ(32 + r32, cb));
    p0 = __builtin_amdgcn_mfma_f32_32x32x16_bf16(b0, q, p0, 0, 0, 0);
    p1 = __builtin_amdgcn_mfma_f32_32x32x16_bf16(b1, q, p1, 0, 0, 0); }
}
__device__ __forceinline__ int v_st(int k, int c) { const int kk = (k & ~0xC) | ((k & 4) << 1) | ((k & 8) >> 1); return ((kk >> 3) * 4 + (c >> 5)) * 512 + ((kk & 7) * 32 + (c & 31)) * 2; }
__device__ __forceinline__ int v_rd_base(int lane) { return ((lane & 3) << 3) | (((lane >> 2) & 3) << 6) | (((lane >> 4) & 1) << 5) | (((lane >> 5) & 1) << 8); }
constexpr int v_rd_off(int d0, int ks, int half) { return d0 * 512 + ks * 4096 + half * 2048; }
template <int OFF> __device__ __forceinline__ s16x4 tr_read(int vb) {
  s16x4 r; asm volatile("ds_read_b64_tr_b16 %0, %1 offset:%2" : "=&v"(r) : "v"(vb), "i"(OFF) : "memory"); return r;
}
template <int D0> __device__ __forceinline__ void pv_one(f32x16& od, int vb, bf16x8 pa0, bf16x8 pa1, bf16x8 pa2, bf16x8 pa3) {
  const s16x4 l0 = tr_read<v_rd_off(D0, 0, 0)>(vb), h0 = tr_read<v_rd_off(D0, 0, 1)>(vb), l1 = tr_read<v_rd_off(D0, 1, 0)>(vb), h1 = tr_read<v_rd_off(D0, 1, 1)>(vb);
  const s16x4 l2 = tr_read<v_rd_off(D0, 2, 0)>(vb), h2 = tr_read<v_rd_off(D0, 2, 1)>(vb), l3 = tr_read<v_rd_off(D0, 3, 0)>(vb), h3 = tr_read<v_rd_off(D0, 3, 1)>(vb);
  asm volatile("s_waitcnt lgkmcnt(0)" ::: "memory"); NA_SBAR();
#define NA_PK(L, H) (bf16x8){L[0], L[1], L[2], L[3], H[0], H[1], H[2], H[3]}
  od = __builtin_amdgcn_mfma_f32_32x32x16_bf16(pa0, NA_PK(l0, h0), od, 0, 0, 0);
  od = __builtin_amdgcn_mfma_f32_32x32x16_bf16(pa1, NA_PK(l1, h1), od, 0, 0, 0);
  od = __builtin_amdgcn_mfma_f32_32x32x16_bf16(pa2, NA_PK(l2, h2), od, 0, 0, 0);
  od = __builtin_amdgcn_mfma_f32_32x32x16_bf16(pa3, NA_PK(l3, h3), od, 0, 0, 0);
#undef NA_PK
}
__device__ __forceinline__ void pv_d0(f32x16* o, int vb, bf16x8 pa0, bf16x8 pa1, bf16x8 pa2, bf16x8 pa3) {
  pv_one<0>(o[0], vb, pa0, pa1, pa2, pa3); pv_one<1>(o[1], vb, pa0, pa1, pa2, pa3); pv_one<2>(o[2], vb, pa0, pa1, pa2, pa3); pv_one<3>(o[3], vb, pa0, pa1, pa2, pa3);
}

__device__ __forceinline__ void init_scores(f32x16& p0, f32x16& p1, int j, int klo, int qrow, const float* bt_l, const float* pen_l) {
  if (j < 4) { p0 = f32x16{}; p1 = f32x16{}; return; }
  const int kr = klo + j - 4, rs = min(max(qrow - 4, 0), 56);
  if (kr < rs || kr >= rs + 8) {
#pragma unroll
    for (int r = 0; r < 16; ++r) { p0[r] = NEG; p1[r] = NEG; }
    return;
  }
  int zo; asm volatile("v_mov_b32 %0, 0" : "=v"(zo));
  const float* bl = bt_l + (kr - qrow + 7) * 32; pen_l += zo;
#pragma unroll
  for (int r = 0; r < 16; ++r) { const int c = (r & 3) + 8 * (r >> 2); p0[r] = bl[c] + pen_l[c]; p1[r] = bl[32 + c] + pen_l[32 + c]; }
}

template <int LDP, int LDO>
__device__ __forceinline__ void na_unit(const bf16* __restrict__ P, int qcol, int kcol, int vcol, long qrow0, long crow0, long brow0, int nband, int klo, int qg0,
                                        bf16* __restrict__ O, int ocol, const float* __restrict__ rpbh, char* lds, const int tid) {
  const int wid = tid >> 6, lane = tid & 63, r32 = lane & 31, hi = lane >> 5;
  bf16* V_lds = (bf16*)lds; bf16* K_lds = (bf16*)(lds + 2 * SHM_V);
  float* ws = (float*)(lds + 2 * SHM_V + 2 * SHM_K) + wid * 64; float* li_l = ws; float* al_l = ws + 32;
  float* blds = (float*)(lds + BIAS_OFF); float* pens = (float*)(lds + PEN_OFF);
  __syncthreads();
  if (nband > 0) {
    for (int i = tid; i < 640; i += 512) { const int t2 = i - 64, dri = t2 >> 5, dci = t2 & 31; blds[i] = (t2 >= 0 && t2 < 480 && dci < 31) ? rpbh[dri * 31 + dci] * (1.0f / SCALE) : 0.f; }
    if (tid < 128) pens[tid] = (tid >= 48 && tid < 64) ? 0.f : NEG;
  }
  float m_reg = -1e30f, l_reg = 0; f32x16 o[4] = {};
  bf16x8* qs = (bf16x8*)(lds + QS_OFF + wid * 8192) + lane;
  { const bf16* Qw = P + (qrow0 + wid * QBLK + r32) * LDP + qcol + hi * 8;
#pragma unroll
    for (int d0 = 0; d0 < 8; ++d0) qs[d0 * 64] = *reinterpret_cast<const bf16x8*>(Qw + d0 * 16); }
  const int sr = tid >> 4, sc = (tid & 15) * 8, vst0 = v_st(sr, sc), vst1 = v_st(32 + sr, sc);
  const int vb0 = (int)(uintptr_t)V_lds + v_rd_base(lane);
  const int qrow = qg0 + (wid >> 1), qc = (wid & 1) * 32 + r32;
  const float* bt_l = blds + 64 + 15 - qc + 4 * hi; const float* pen_l = pens + 48 - min(max(qc - 8, 0), 48) + 4 * hi;
  const bf16* Kh = P + kcol; const bf16* Vh = P + vcol;
  bf16x8 vs0, vs1, ks0, ks1;
#define NA_TROW(j) ((j) < 4 ? crow0 + (long)(j) * 64 : brow0 + (long)((j) - 4) * 64)
#define NA_SLOAD(j) do { const long _k0 = NA_TROW(j); vs0 = *reinterpret_cast<const bf16x8*>(&Vh[(_k0 + sr) * LDP + sc]); vs1 = *reinterpret_cast<const bf16x8*>(&Vh[(_k0 + 32 + sr) * LDP + sc]); \
    ks0 = *reinterpret_cast<const bf16x8*>(&Kh[(_k0 + sr) * LDP + sc]); ks1 = *reinterpret_cast<const bf16x8*>(&Kh[(_k0 + 32 + sr) * LDP + sc]); } while (0)
#define NA_SWRITE(b) do { *(bf16x8*)((char*)V_lds + (b) * SHM_V + vst0) = vs0; *(bf16x8*)((char*)V_lds + (b) * SHM_V + vst1) = vs1; const int kc = sc * 2; \
    *(bf16x8*)((char*)K_lds + (b) * SHM_K + NA_KSWZ(sr, kc)) = ks0; *(bf16x8*)((char*)K_lds + (b) * SHM_K + NA_KSWZ(32 + sr, kc)) = ks1; } while (0)
#define NA_RESC(a) do { if (__any((a) < 1.f)) { if (hi == 0) al_l[r32] = (a); asm volatile("s_waitcnt lgkmcnt(0)" ::: "memory"); \
    _Pragma("unroll") for (int d = 0; d < 4; ++d) _Pragma("unroll") for (int r = 0; r < 16; ++r) o[d][r] *= al_l[crow(r, hi)]; } } while (0)
  f32x16 p0, p1; float mn, al; bf16x8 pa0, pa1, pa2, pa3; const int NT = 4 + nband; const int rs_ = min(max(qrow - 4, 0), 56);
  NA_SLOAD(0);
  for (int j = 0; j < NT; ++j) {
    const int b = j & 1;
    NA_SWRITE(b);
    if (j + 1 < NT) NA_SLOAD(j + 1);
    __syncthreads();
    const int kr_ = klo + j - 4;
    if (j < 4 || (kr_ >= rs_ && kr_ < rs_ + 8)) {
      init_scores(p0, p1, j, klo, qrow, bt_l, pen_l);
      qkt(p0, p1, (const bf16*)((const char*)K_lds + b * SHM_K), qs, r32, hi);
      partialSM(p0, p1, m_reg, mn, al);
      NA_RESC(al);
      finishSM(p0, p1, al, l_reg, pa0, pa1, pa2, pa3); NA_SBAR();
      pv_d0(o, vb0 + b * (int)SHM_V, pa0, pa1, pa2, pa3);
    }
  }
  if (hi == 0) li_l[r32] = l_reg; asm volatile("s_waitcnt lgkmcnt(0)" ::: "memory");
  float rli[16];
#pragma unroll
  for (int r = 0; r < 16; ++r) rli[r] = __builtin_amdgcn_rcpf(li_l[crow(r, hi)]);
  bf16* Ow = O + (qrow0 + wid * QBLK) * LDO + ocol;
#pragma unroll
  for (int r = 0; r < 16; ++r) { const int orow = crow(r, hi);
#pragma unroll
    for (int d0 = 0; d0 < 4; ++d0) { const float v = o[d0][r] * rli[r]; unsigned u = __float_as_uint(v); u = (u + 0x7fffu + ((u >> 16) & 1u)) >> 16; Ow[(long)orow * LDO + d0 * 32 + r32] = (bf16)u; } }
#undef NA_TROW
#undef NA_SLOAD
#undef NA_SWRITE
#undef NA_RESC
}
}

constexpr int NWAVES = 8;
constexpr int D = 2048, NBATCH = 4, SEQ = 4096, MLAT = NBATCH * SEQ, CTXL = 256, MCTX = NBATCH * CTXL, MR = MLAT + MCTX;
#ifndef PADF
#define PADF 128
#endif
constexpr int DFF = 5632, DUP = 2 * DFF, DIN = 6176, DINP = 6400, DEPTH = 4, LDF = DFF + PADF;
constexpr int MODW = 6 * D;
constexpr float EPS = 1e-6f;
constexpr int C_QA = 0, C_KA = 1024, C_VA = 2048, C_QB = 3072, C_KB = 3584, C_VB = 4096, C_GB = 5120, C_AB = 6144;

constexpr size_t MiB = 1u << 20;
constexpr size_t WS_CTL = 0, CTL_ZERO_BYTES = 32768;
constexpr size_t WS_MOD = 1 * MiB;
constexpr size_t WS_ROPE = WS_MOD + (size_t)DEPTH * 5 * MODW * 4;
constexpr size_t WS_WIN = 2 * MiB;
constexpr size_t WS_WOUT = WS_WIN + (size_t)2 * DINP * D * 2;
constexpr size_t WS_WPOOL = WS_WOUT + (size_t)2 * D * D * 2;
constexpr size_t WS_WUP = WS_WPOOL + (size_t)2 * 4 * 512 * 512 * 2;
constexpr size_t WS_WDOWN = WS_WUP + (size_t)DEPTH * DUP * D * 2;
constexpr size_t WS_XR = WS_WDOWN + (size_t)DEPTH * D * LDF * 2;
constexpr size_t WS_X16 = WS_XR;
constexpr size_t WS_PART = WS_XR + (size_t)MLAT * D * 2;
constexpr size_t WS_H = WS_XR + (size_t)MR * D * 4;
constexpr size_t WS_MIX = WS_H + (size_t)MR * D * 2;
constexpr size_t WS_BIG = WS_MIX + (size_t)MR * D * 2;
constexpr size_t WS_U = WS_BIG;
constexpr size_t WS_ACT = WS_U + (size_t)MR * DUP * 2;
constexpr size_t WS_P = WS_BIG;
constexpr size_t WS_QF = WS_P + (size_t)MR * DINP * 2;
constexpr size_t WS_KF = WS_QF + (size_t)MR * 512 * 2;
constexpr size_t WS_QB = WS_KF + (size_t)MR * 512 * 2;
constexpr size_t WS_KB = WS_QB + (size_t)MR * 512 * 2;
constexpr size_t WS_KHT = WS_KB + (size_t)MR * 512 * 2;
constexpr size_t WS_AL = WS_KHT + (size_t)2 * MR * 512 * 2;
constexpr size_t WS_UT = WS_AL + (size_t)2 * (MR / 64) * 512 * 4;
constexpr size_t WS_ST = WS_UT + (size_t)64 * 68 * 8192 * 2;
constexpr size_t WS_MIXEND = WS_ST + (size_t)64 * 68 * 8192 * 2;
constexpr size_t WS_SB = WS_ACT + (size_t)MR * LDF * 2;
constexpr size_t WS_END = WS_SB + (size_t)(MR / 256) * 2 * 3 * DFF * 4;
static_assert(WS_MIXEND <= WS_END, "even-mixer view fits inside the FFN view");
static_assert(WS_ROPE + 2 * 64 * 16 * 4 <= WS_WIN, "small tables fit below the weights");
constexpr int CW_BAR = 4096;

constexpr int RING_OFF = 0, RING_BYTES = 143360;
constexpr int LDSCTL_OFF = RING_BYTES, MISC_OFF = LDSCTL_OFF + 320;
constexpr int LDS_BYTES = 147456;
static_assert(na::LDS_END <= RING_BYTES, "attention LDS fits the ring");

#define GAS __attribute__((address_space(1)))
#define LAS __attribute__((address_space(3)))
typedef unsigned short bf16;
typedef unsigned v4u __attribute__((ext_vector_type(4)));
typedef unsigned v2u __attribute__((ext_vector_type(2)));
typedef float f32x4 __attribute__((ext_vector_type(4)));
#define LDS_WAIT() asm volatile("s_waitcnt lgkmcnt(0)" ::: "memory")
__device__ __forceinline__ unsigned f2bf(float f) { unsigned u = __builtin_bit_cast(unsigned, f); return (u + 0x7fffu + ((u >> 16) & 1u)) >> 16; }
__device__ __forceinline__ unsigned pk2(float lo, float hi) { return f2bf(lo) | (f2bf(hi) << 16); }
__device__ __forceinline__ unsigned pk2h(float lo, float hi) { return pg8::cvt_pk_bf16(lo, hi); }
__device__ __forceinline__ float bflo(unsigned w) { return __builtin_bit_cast(float, w << 16); }
__device__ __forceinline__ float bfhi(unsigned w) { return __builtin_bit_cast(float, w & 0xffff0000u); }
__device__ __forceinline__ float bf2f(bf16 b) { return __builtin_bit_cast(float, (unsigned)b << 16); }

#define XB_TMO      128
#define XB_XCNT(j)  (256  + 64 * (j))
#define XB_XSUB(j)  (1280 + 64 * (j))
#define XB_XGEN(j)  (2304 + 64 * (j))
#define XB_TOP      3328
#define XB_TOPGEN   3392
#define XCD_BAR_WORDS 3456
#define XB_SPIN_CAP (1u << 18)
__device__ __forceinline__ unsigned xb_ld(unsigned* p)              { return __hip_atomic_load(p, __ATOMIC_RELAXED, __HIP_MEMORY_SCOPE_AGENT); }
__device__ __forceinline__ unsigned xb_add(unsigned* p, unsigned v) { return __hip_atomic_fetch_add(p, v, __ATOMIC_RELAXED, __HIP_MEMORY_SCOPE_AGENT); }
__device__ __forceinline__ unsigned xb_xcc_id() { return (unsigned)__builtin_amdgcn_s_getreg((3 << 11) | 20) & 0xFu; }
#define XB_SPIN(cond, bar) do { unsigned _sp = 0; while (cond) { __builtin_amdgcn_s_sleep(1); \
    if ((++_sp & 255u) == 0u) { if (xb_ld(&(bar)[XB_TMO])) break; if (_sp > XB_SPIN_CAP) { atomicAdd(&(bar)[XB_TMO], 1u); break; } } } } while (0)
struct XcdBarrier { unsigned* bar; unsigned x; volatile LAS unsigned* st; };
__device__ __forceinline__ XcdBarrier xcd_barrier_post(unsigned* bar, volatile LAS unsigned* st) {
    XcdBarrier b; b.bar = bar; b.x = xb_xcc_id(); b.st = st;
    if (threadIdx.x == 0) (void)xb_add(&bar[XB_XCNT(b.x)], 1u);
    return b;
}
__device__ __forceinline__ void xcd_barrier_complete(unsigned* bar, unsigned x, unsigned& nloc, unsigned& nx) {
    const unsigned G = gridDim.x * gridDim.y * gridDim.z;
    unsigned sum, cnt, mine, sp = 0u;
    for (;;) {
        sum = 0u; cnt = 0u; mine = 0u;
#pragma unroll
        for (unsigned j = 0; j < 16; ++j) { const unsigned c = xb_ld(&bar[XB_XCNT(j)]); sum += c; cnt += (c > 0u) ? 1u : 0u; mine = (j == x) ? c : mine; }
        if (sum == G) break;
        __builtin_amdgcn_s_sleep(1);
        if ((++sp & 255u) == 0u) { if (xb_ld(&bar[XB_TMO])) break; if (sp > XB_SPIN_CAP) { atomicAdd(&bar[XB_TMO], 1u); break; } }
    }
    nloc = mine > 0u ? mine : 1u; nx = cnt > 0u ? cnt : 1u;
}
__device__ __forceinline__ void xcd_barrier(const XcdBarrier& b) {
    asm volatile("s_waitcnt vmcnt(0)" ::: "memory");
    __syncthreads();
    if (threadIdx.x == 0) {
        unsigned* bar = b.bar;
        __builtin_amdgcn_s_waitcnt(0);
        unsigned nloc = b.st[0], nx = b.st[1];
        if (nloc == 0u) { xcd_barrier_complete(bar, b.x, nloc, nx); b.st[0] = nloc; b.st[1] = nx; }
        const unsigned old = xb_add(&bar[XB_XSUB(b.x)], 1u);
        const unsigned gen = old / nloc;
        if (old + 1u == (gen + 1u) * nloc) {
            __builtin_amdgcn_fence(__ATOMIC_RELEASE, "agent");
            asm volatile("s_waitcnt vmcnt(0)" ::: "memory");
            const unsigned og = xb_add(&bar[XB_TOP], 1u);
            const unsigned tg = og / nx;
            if (og + 1u == (tg + 1u) * nx) xb_add(&bar[XB_TOPGEN], 1u);
            else XB_SPIN(xb_ld(&bar[XB_TOPGEN]) == tg, bar);
            __builtin_amdgcn_fence(__ATOMIC_ACQUIRE, "agent");
            xb_add(&bar[XB_XGEN(b.x)], 1u);
            asm volatile("s_waitcnt vmcnt(0)" ::: "memory");
        } else {
            XB_SPIN(xb_ld(&bar[XB_XGEN(b.x)]) == gen, bar);
            __builtin_amdgcn_fence(__ATOMIC_ACQUIRE, "agent");
            asm volatile("s_waitcnt vmcnt(0)" ::: "memory");
        }
    }
    __syncthreads();
}

struct Args { const float* in[21]; float* out; unsigned char* ws; int ph_lo, ph_hi; };
static_assert(sizeof(Args) == 23 * 8 + 8, "Args has no padding bytes");
typedef const __attribute__((address_space(4))) Args* KArgs;
enum { I_X = 0, I_C, I_CTX, I_CCTX, I_WMOD, I_BMOD, I_N1G, I_N2G, I_WIN, I_WG2, I_BG, I_RPB, I_GLAG, I_WOUT, I_POOLW, I_POOLS, I_WUP, I_CONVW, I_CONVB, I_WDOWN, I_FING };
struct Frame {
    LAS unsigned char* lds; unsigned char* ldsg;
    volatile LAS unsigned* MISC;
    int tid, lane, wave, vcu, G;
    KArgs ka; unsigned char* ws;
};
__device__ __forceinline__ float wave_sum(float v) {
#pragma unroll
    for (int o = 1; o < 64; o <<= 1) v += __shfl_xor(v, o);
    return v;
}

__device__ __forceinline__ void p0_transpose_item(const float* W, int K, int N, bf16* WT, LAS float* scr, int item, int lane, int ldt = 0) {
    if (ldt == 0) ldt = K;
    const int nblk = N / 32, kb = item / nblk, nb = item % nblk, k0 = 64 * kb, n0 = 32 * nb;
#pragma unroll 8
    for (int i = 0; i < 32; ++i) { const int kk = 2 * i + (lane >> 5); scr[kk * 33 + (lane & 31)] = W[(size_t)(k0 + kk) * N + n0 + (lane & 31)]; }
    LDS_WAIT(); asm volatile("" ::: "memory");
    const int c = lane & 7;
#pragma unroll
    for (int j = 0; j < 4; ++j) { const int n = (lane >> 3) + 8 * j; const LAS float* s = scr + (8 * c) * 33 + n;
        v4u o; o.x = pk2(s[0 * 33], s[1 * 33]); o.y = pk2(s[2 * 33], s[3 * 33]); o.z = pk2(s[4 * 33], s[5 * 33]); o.w = pk2(s[6 * 33], s[7 * 33]);
        *(GAS v4u*)(WT + (size_t)(n0 + n) * ldt + k0 + 8 * c) = o; }
    LDS_WAIT(); asm volatile("" ::: "memory");
}
__device__ __forceinline__ void p0_transpose_item_up(const float* W, bf16* WT, LAS float* scr, int item, int lane) {
    constexpr int K = D, N = DUP;
    const int nblk = N / 32, kb = item / nblk, nb = item % nblk, k0 = 64 * kb, n0 = 32 * nb;
    const int isg = n0 >= DFF, c0 = isg ? n0 - DFF : n0, d0 = 256 * (c0 >> 7) + (isg ? 128 : 0) + (c0 & 127);
#pragma unroll 8
    for (int i = 0; i < 32; ++i) { const int kk = 2 * i + (lane >> 5); scr[kk * 33 + (lane & 31)] = W[(size_t)(k0 + kk) * N + n0 + (lane & 31)]; }
    LDS_WAIT(); asm volatile("" ::: "memory");
    const int c = lane & 7;
#pragma unroll
    for (int j = 0; j < 4; ++j) { const int n = (lane >> 3) + 8 * j; const LAS float* s = scr + (8 * c) * 33 + n;
        v4u o; o.x = pk2(s[0 * 33], s[1 * 33]); o.y = pk2(s[2 * 33], s[3 * 33]); o.z = pk2(s[4 * 33], s[5 * 33]); o.w = pk2(s[6 * 33], s[7 * 33]);
        *(GAS v4u*)(WT + (size_t)(d0 + n) * K + k0 + 8 * c) = o; }
    LDS_WAIT(); asm volatile("" ::: "memory");
}
__device__ __forceinline__ void ph_prologue(Frame& F) {
    const int gw = F.vcu * NWAVES + F.wave, NGW = F.G * NWAVES;
    const int gt = F.vcu * NWAVES * 64 + F.tid, NGT = F.G * NWAVES * 64;
    {
        LAS float* scr = (LAS float*)(F.lds + RING_OFF + F.wave * 16384);
        constexpr int I_IN = (D / 64) * (DIN / 32), I_OUT = (D / 64) * (D / 32), I_POOL = (512 / 64) * (512 / 32), I_UP = (D / 64) * (DUP / 32), I_DOWN = (DFF / 64) * (D / 32);
        constexpr int NITEMS = 2 * I_IN + 2 * I_OUT + 8 * I_POOL + 4 * I_UP + 4 * I_DOWN;
        bf16* WIN = (bf16*)(F.ws + WS_WIN); bf16* WOUT = (bf16*)(F.ws + WS_WOUT); bf16* WPOOL = (bf16*)(F.ws + WS_WPOOL); bf16* WUP = (bf16*)(F.ws + WS_WUP); bf16* WDOWN = (bf16*)(F.ws + WS_WDOWN);
        for (int it = gw; it < NITEMS; it += NGW) {
            int r = it;
            if (r < 4 * I_UP) { const int l = r / I_UP; p0_transpose_item_up((F.ka->in[I_WUP]) + (size_t)l * D * DUP, WUP + (size_t)l * DUP * D, scr, r % I_UP, F.lane); continue; } r -= 4 * I_UP;
            if (r < 4 * I_DOWN) { const int l = r / I_DOWN; p0_transpose_item((F.ka->in[I_WDOWN]) + (size_t)l * DFF * D, DFF, D, WDOWN + (size_t)l * D * LDF, scr, r % I_DOWN, F.lane, LDF); continue; } r -= 4 * I_DOWN;
            if (r < 2 * I_IN) { const int l = r / I_IN; p0_transpose_item((F.ka->in[I_WIN]) + (size_t)l * D * DIN, D, DIN, WIN + (size_t)l * DINP * D, scr, r % I_IN, F.lane); continue; } r -= 2 * I_IN;
            if (r < 2 * I_OUT) { const int l = r / I_OUT; p0_transpose_item((F.ka->in[I_WOUT]) + (size_t)l * D * D, D, D, WOUT + (size_t)l * D * D, scr, r % I_OUT, F.lane); continue; } r -= 2 * I_OUT;
            { const int l = r / I_POOL; p0_transpose_item((F.ka->in[I_POOLW]) + (size_t)l * 512 * 512, 512, 512, WPOOL + (size_t)l * 512 * 512, scr, r % I_POOL, F.lane); }
        }
        constexpr int ZV = (DINP - DIN) * D / 8;
        for (int i = gt; i < 2 * ZV; i += NGT) { const int l = i / ZV, j = i % ZV; *(GAS v4u*)(WIN + (size_t)l * DINP * D + (size_t)DIN * D + (size_t)j * 8) = (v4u){0u, 0u, 0u, 0u}; }
    }
    if (blockIdx.x == 0) {
        float* rc = (float*)(F.ws + WS_ROPE); float* rs = rc + 64 * 16;
        for (int i = F.tid; i < 64 * 16; i += NWAVES * 64) { const int pos = i >> 4, f = i & 15; const float inv = powf(10000.0f, -(float)f / 16.0f); const float ang = (float)pos * inv; rc[i] = cosf(ang); rs[i] = sinf(ang); }
    }
    __syncthreads();
    {
        LAS float* S = (LAS float*)(F.lds + RING_OFF);
        LAS float* RED = (LAS float*)(F.lds + RING_OFF + 40960);
        float* MOD = (float*)(F.ws + WS_MOD);
        constexpr int NTASK = DEPTH * (MODW / 256);
        if ((int)blockIdx.x < NTASK) {
            for (int i = F.tid; i < 5 * D; i += NWAVES * 64) { const int r = i / D, k = i % D; const float v = r < 4 ? (F.ka->in[I_C])[r * D + k] : (F.ka->in[I_CCTX])[k]; S[i] = v / (1.0f + __expf(-v)); }
            __syncthreads();
            for (int t = blockIdx.x; t < NTASK; t += F.G) {
                const int l = t / (MODW / 256), n0 = (t % (MODW / 256)) * 256, k0 = F.wave * 256;
                float acc[5][4];
#pragma unroll
                for (int r = 0; r < 5; ++r)
#pragma unroll
                    for (int cc = 0; cc < 4; ++cc) acc[r][cc] = 0.f;
                const float* Wp = (F.ka->in[I_WMOD]) + ((size_t)l * D + k0) * MODW + n0 + 4 * F.lane;
                for (int kk = 0; kk < 256; kk += 8) {
                    f32x4 wv[8];
#pragma unroll
                    for (int u = 0; u < 8; ++u) wv[u] = *(const f32x4*)(Wp + (size_t)(kk + u) * MODW);
#pragma unroll
                    for (int u = 0; u < 8; ++u)
#pragma unroll
                        for (int r = 0; r < 5; ++r) { const float s = S[r * D + k0 + kk + u];
#pragma unroll
                            for (int cc = 0; cc < 4; ++cc) acc[r][cc] = fmaf(s, wv[u][cc], acc[r][cc]); }
                }
#pragma unroll
                for (int r = 0; r < 5; ++r)
#pragma unroll
                    for (int cc = 0; cc < 4; ++cc) RED[(F.wave * 5 + r) * 256 + 4 * F.lane + cc] = acc[r][cc];
                __syncthreads();
                for (int o = F.tid; o < 5 * 256; o += NWAVES * 64) { const int r = o >> 8, ci = o & 255; float s = (F.ka->in[I_BMOD])[l * MODW + n0 + ci];
#pragma unroll
                    for (int w = 0; w < 8; ++w) s += RED[(w * 5 + r) * 256 + ci];
                    MOD[((size_t)l * 5 + r) * MODW + n0 + ci] = s; }
                __syncthreads();
            }
        }
    }
}

__device__ __forceinline__ f32x4 bf4_unpack(v2u h) { f32x4 r; r.x = pg8::h_lo(h.x); r.y = pg8::h_hi(h.x); r.z = pg8::h_lo(h.y); r.w = pg8::h_hi(h.y); return r; }
template <bool L16, bool CPY, bool CI>
__device__ __forceinline__ void norm_rows(Frame& F, const int ra, const int rb, const void* src, const int rbase, const float* g, const float* modl, const int off_sh, const int off_sc, const int nparts) {
    if (ra >= rb) return;
    bf16* H = (bf16*)(F.ws + WS_H);
    f32x4 gm[8], sh[8]; int cb = -1;
    f32x4 v[8], w[8]; v2u hv[8], hw[8];
#define NORM_P32(m) ((const f32x4*)((const float*)src + (size_t)((m) - rbase) * D) + F.lane)
#define NORM_P16(m) ((const v2u*)((const bf16*)src + (size_t)((m) - rbase) * D) + F.lane)
    if constexpr (L16) { const v2u* xr = NORM_P16(ra);
#pragma unroll
        for (int j = 0; j < 8; ++j) hv[j] = xr[64 * j];
    } else { const f32x4* xr = NORM_P32(ra);
#pragma unroll
        for (int j = 0; j < 8; ++j) v[j] = xr[64 * j]; }
    for (int m = ra; m < rb; ++m) {
        if (m + 1 < rb) {
            if constexpr (L16) { const v2u* xn = NORM_P16(m + 1);
#pragma unroll
                for (int j = 0; j < 8; ++j) hw[j] = xn[64 * j];
            } else { const f32x4* xn = NORM_P32(m + 1);
#pragma unroll
                for (int j = 0; j < 8; ++j) w[j] = xn[64 * j]; } }
        const int bidx = m < MLAT ? (m >> 12) : 4;
        if (bidx != cb) { cb = bidx;
            const f32x4* gp = (const f32x4*)g + F.lane; const f32x4* shp = (const f32x4*)(modl + (size_t)bidx * MODW + off_sh) + F.lane; const f32x4* scp = (const f32x4*)(modl + (size_t)bidx * MODW + off_sc) + F.lane;
#pragma unroll
            for (int j = 0; j < 8; ++j) { gm[j] = gp[64 * j] * (scp[64 * j] + 1.0f); sh[j] = shp[64 * j]; } }
        if constexpr (L16) {
#pragma unroll
            for (int j = 0; j < 8; ++j) v[j] = bf4_unpack(hv[j]); }
        if constexpr (CI) {
            for (int k = 0; k < nparts; ++k) { const f32x4* pp = (const f32x4*)((const float*)(F.ws + WS_PART) + ((size_t)k * MCTX + (size_t)(m - rbase)) * D) + F.lane;
#pragma unroll
                for (int j = 0; j < 8; ++j) v[j] = v[j] + pp[64 * j]; }
            f32x4* xw = (f32x4*)((float*)(F.ws + WS_XR) + (size_t)m * D) + F.lane;
#pragma unroll
            for (int j = 0; j < 8; ++j) xw[64 * j] = v[j]; }
        float s = 0.f;
#pragma unroll
        for (int j = 0; j < 8; ++j) s += (v[j].x * v[j].x + v[j].y * v[j].y) + (v[j].z * v[j].z + v[j].w * v[j].w);
        const float r = 1.0f / sqrtf(wave_sum(s) * (1.0f / D) + EPS);
        v2u* o8 = (v2u*)(H + (size_t)m * D) + F.lane;
#pragma unroll
        for (int j = 0; j < 8; ++j) { const f32x4 y = v[j] * r * gm[j] + sh[j]; v2u ww; ww.x = pk2h(y.x, y.y); ww.y = pk2h(y.z, y.w); o8[64 * j] = ww; }
        if constexpr (CPY) { v2u* c8 = (v2u*)((bf16*)(F.ws + WS_X16) + (size_t)m * D) + F.lane;
#pragma unroll
            for (int j = 0; j < 8; ++j) { v2u ww; ww.x = pg8::pk_h2(v[j].x, v[j].y); ww.y = pg8::pk_h2(v[j].z, v[j].w); c8[64 * j] = ww; } }
        if constexpr (L16) {
#pragma unroll
            for (int j = 0; j < 8; ++j) hv[j] = hw[j];
        } else {
#pragma unroll
            for (int j = 0; j < 8; ++j) v[j] = w[j]; }
    }
#undef NORM_P32
#undef NORM_P16
}
__device__ __forceinline__ void ph_norm(Frame& F, int nrows, const float* xl32, const float* xc, const float* g, const float* modl, int off_sh, int off_sc, int nparts) {
    const int gw = F.vcu * NWAVES + F.wave; int NGW = F.G * NWAVES; asm volatile("" : "+s"(NGW));
    const int nctx = nrows - MLAT;
    const int r0 = (int)((unsigned)gw * (unsigned)MLAT / (unsigned)NGW), r1 = (int)((unsigned)(gw + 1) * (unsigned)MLAT / (unsigned)NGW);
    const int c0 = MLAT + (int)((unsigned)gw * (unsigned)nctx / (unsigned)NGW), c1 = MLAT + (int)((unsigned)(gw + 1) * (unsigned)nctx / (unsigned)NGW);
    if (xl32) { norm_rows<false, true, false>(F, r0, r1, xl32, 0, g, modl, off_sh, off_sc, 0); norm_rows<false, false, false>(F, c0, c1, xc, MLAT, g, modl, off_sh, off_sc, 0); }
    else      { norm_rows<true, false, false>(F, r0, r1, F.ws + WS_X16, 0, g, modl, off_sh, off_sc, 0); norm_rows<false, false, true>(F, c0, c1, xc, MLAT, g, modl, off_sh, off_sc, nparts); }
}
__device__ __forceinline__ void ph_final(Frame& F) {
    const int gw = F.vcu * NWAVES + F.wave, NGW = F.G * NWAVES;
    const bf16* X16 = (const bf16*)(F.ws + WS_X16);
    const int r0 = (int)((long)gw * MLAT / NGW), r1 = (int)((long)(gw + 1) * MLAT / NGW);
    if (r0 >= r1) return;
    f32x4 gf[8], v[8]; v2u hv[8], hw[8];
    { const f32x4* gp = (const f32x4*)(F.ka->in[I_FING]) + F.lane; const v2u* xr = (const v2u*)(X16 + (size_t)r0 * D) + F.lane;
#pragma unroll
      for (int j = 0; j < 8; ++j) { gf[j] = gp[64 * j]; hv[j] = xr[64 * j]; } }
    for (int m = r0; m < r1; ++m) {
        if (m + 1 < r1) { const v2u* xn = (const v2u*)(X16 + (size_t)(m + 1) * D) + F.lane;
#pragma unroll
            for (int j = 0; j < 8; ++j) hw[j] = xn[64 * j]; }
#pragma unroll
        for (int j = 0; j < 8; ++j) v[j] = bf4_unpack(hv[j]);
        float s = 0.f;
#pragma unroll
        for (int j = 0; j < 8; ++j) s += (v[j].x * v[j].x + v[j].y * v[j].y) + (v[j].z * v[j].z + v[j].w * v[j].w);
        const float r = 1.0f / sqrtf(wave_sum(s) * (1.0f / D) + EPS);
        f32x4* op = (f32x4*)((F.ka->out) + (size_t)m * D) + F.lane;
#pragma unroll
        for (int j = 0; j < 8; ++j) __builtin_nontemporal_store(v[j] * r * gf[j], op + 64 * j);
#pragma unroll
        for (int j = 0; j < 8; ++j) hv[j] = hw[j];
    }
}
template <int HW>
__device__ __forceinline__ void pool_strip(const bf16* H, bf16* HP, int m0, int t0, int L, int c8) {
    constexpr int NR = 8 + 2 * HW - 1;
    v4u R[NR];
#pragma unroll
    for (int j = 0; j < NR; ++j) { const int tr = t0 - HW + j; R[j] = (v4u){0u, 0u, 0u, 0u}; if (tr >= 0 && tr < L) R[j] = *(const v4u*)(H + (size_t)(m0 - HW + j) * D + c8); }
    float s[8];
#pragma unroll
    for (int e = 0; e < 8; ++e) s[e] = 0.f;
#pragma unroll
    for (int j = 0; j < 2 * HW; ++j) { s[0] += bflo(R[j].x); s[1] += bfhi(R[j].x); s[2] += bflo(R[j].y); s[3] += bfhi(R[j].y); s[4] += bflo(R[j].z); s[5] += bfhi(R[j].z); s[6] += bflo(R[j].w); s[7] += bfhi(R[j].w); }
#pragma unroll
    for (int r = 0; r < 8; ++r) {
        const int t = t0 + r; const float inv = 1.0f / (float)(min(t + HW, L) - max(t - HW, 0));
        const v4u w = R[r + HW];
        v4u o; o.x = pk2h(s[0] * inv - bflo(w.x), s[1] * inv - bfhi(w.x)); o.y = pk2h(s[2] * inv - bflo(w.y), s[3] * inv - bfhi(w.y));
        o.z = pk2h(s[4] * inv - bflo(w.z), s[5] * inv - bfhi(w.z)); o.w = pk2h(s[6] * inv - bflo(w.w), s[7] * inv - bfhi(w.w));
        *(v4u*)(HP + (size_t)(m0 + r) * D + c8) = o;
        if (r < 7) { const v4u a = R[r + 2 * HW], b = R[r];
            s[0] += bflo(a.x) - bflo(b.x); s[1] += bfhi(a.x) - bfhi(b.x); s[2] += bflo(a.y) - bflo(b.y); s[3] += bfhi(a.y) - bfhi(b.y);
            s[4] += bflo(a.z) - bflo(b.z); s[5] += bfhi(a.z) - bfhi(b.z); s[6] += bflo(a.w) - bflo(b.w); s[7] += bfhi(a.w) - bfhi(b.w); }
    }
}
__device__ __forceinline__ void ph_pool(Frame& F, int nrows) {
    const int gt = F.vcu * NWAVES * 64 + F.tid, NGT = F.G * NWAVES * 64;
    const bf16* H = (const bf16*)(F.ws + WS_H); bf16* HP = (bf16*)(F.ws + WS_MIX);
    const int nitems = (nrows / 8) * (D / 8);
    for (int it = gt; it < nitems; it += NGT) {
        const int strip = it >> 8, c8 = (it & 255) * 8, gi = __builtin_amdgcn_readfirstlane(c8 >> 9), m0 = strip * 8;
        int t0, L;
        if (m0 < MLAT) { t0 = m0 & (SEQ - 1); L = SEQ; } else { t0 = (m0 - MLAT) & (CTXL - 1); L = CTXL; }
        if (gi == 0) pool_strip<1>(H, HP, m0, t0, L, c8); else if (gi == 1) pool_strip<2>(H, HP, m0, t0, L, c8); else if (gi == 2) pool_strip<4>(H, HP, m0, t0, L, c8); else pool_strip<8>(H, HP, m0, t0, L, c8);
    }
}
__device__ __forceinline__ void ph_glufix(Frame& F, int nrows, const float* cw, const float* cb) {
    const int gt = F.vcu * NWAVES * 64 + F.tid, NGT = F.G * NWAVES * 64;
    const float* SB = (const float*)(F.ws + WS_SB); bf16* ACT = (bf16*)(F.ws + WS_ACT);
    constexpr int C4 = DFF / 4;
    const int nitems = (nrows / 256) * 2 * C4;
    for (int it = gt; it < nitems; it += NGT) {
        const int c4 = (it % C4) * 4, pw = it / C4, which = pw & 1, pm = pw >> 1, row = 256 * pm + (which ? 255 : 0);
        int t, L;
        if (row < MLAT) { t = row & (SEQ - 1); L = SEQ; } else { t = (row - MLAT) & (CTXL - 1); L = CTXL; }
        const float* sb = SB + ((size_t)(pm * 2 + which) * 3) * DFF + c4;
        f32x4 cv = *(const f32x4*)sb; const f32x4 vl = *(const f32x4*)(sb + DFF);
        if (which == 0 && t > 0)     cv = cv + *(const f32x4*)(cw + c4) * *(const f32x4*)(SB + ((size_t)((pm - 1) * 2 + 1) * 3 + 2) * DFF + c4);
        if (which == 1 && t < L - 1) cv = cv + *(const f32x4*)(cw + 2 * DFF + c4) * *(const f32x4*)(SB + ((size_t)((pm + 1) * 2 + 0) * 3 + 2) * DFF + c4);
        const pg8::f32x2 g0 = pg8::gelu_pk((pg8::f32x2){cv.x, cv.y}), g1 = pg8::gelu_pk((pg8::f32x2){cv.z, cv.w});
        v2u o; o.x = pk2h(g0.x * vl.x, g0.y * vl.y); o.y = pk2h(g1.x * vl.z, g1.y * vl.w);
        *(v2u*)(ACT + (size_t)row * LDF + c4) = o;
    }
}

namespace gla {
typedef short bf16x8 __attribute__((ext_vector_type(8)));
typedef float f32x16 __attribute__((ext_vector_type(16)));
typedef unsigned u32x4 __attribute__((ext_vector_type(4)));
constexpr int NRC = MR / 64;
constexpr int PITCH = 72;
__device__ __forceinline__ int crow(int r, int hi) { return (r & 3) + 8 * (r >> 2) + 4 * hi; }
__device__ __forceinline__ unsigned cvtpk(float lo, float hi) { unsigned r; asm volatile("v_cvt_pk_bf16_f32 %0, %1, %2" : "=v"(r) : "v"(lo), "v"(hi)); return r; }
__device__ __forceinline__ int chain_slot_rc(int b, int dir, int s) { return s < 4 ? 256 + 4 * b + (dir ? 3 - s : s) : 64 * b + (dir ? 63 - (s - 4) : s - 4); }
__device__ __forceinline__ int rc_slot(int rc, int dir) { return rc < 256 ? 4 + (dir ? 63 - (rc & 63) : (rc & 63)) : (dir ? 3 - (rc & 3) : (rc & 3)); }
__device__ __forceinline__ int rc_batch(int rc) { return rc < 256 ? rc >> 6 : (rc - 256) >> 2; }
__device__ __forceinline__ float logsig16(float z2) { return (fminf(z2, 0.f) - __builtin_amdgcn_logf(1.0f + __builtin_amdgcn_exp2f(-fabsf(z2)))) * (1.0f / 16.0f); }

__device__ __forceinline__ void ph_prep(Frame& F, int e) {
    const bf16* P = (const bf16*)(F.ws + WS_P);
    bf16* QF = (bf16*)(F.ws + WS_QF); bf16* KF = (bf16*)(F.ws + WS_KF); bf16* QB = (bf16*)(F.ws + WS_QB); bf16* KB = (bf16*)(F.ws + WS_KB);
    float* AL = (float*)(F.ws + WS_AL);
    const float* ropec = (const float*)(F.ws + WS_ROPE); const float* ropes = ropec + 64 * 16;
    const float* w2 = (F.ka->in[I_WG2]) + (size_t)e * 2 * 16 * 512; const float* bg = (F.ka->in[I_BG]) + (size_t)e * 2 * 512;
    LAS float* ABf = (LAS float*)(F.lds + RING_OFF);
    LAS float* RTc = (LAS float*)(F.lds + RING_OFF + 8192); LAS float* RTs = RTc + 64 * 16;
    for (int i = F.tid; i < 2 * 64 * 16; i += NWAVES * 64) RTc[i] = ropec[i];
    const int dk = F.lane;
    pg8::f32x2 wfb[16], bfb; int col;
    const int hf = dk >> 5, f = dk & 15; const float sgn = ((dk >> 4) & 1) ? 1.0f : -1.0f;
#define GLA_Z(t, zf, zb) do { const LAS f32x4* ap = (const LAS f32x4*)(ABf + (t) * 32); pg8::f32x2 z2 = bfb; \
        _Pragma("unroll") for (int i = 0; i < 8; ++i) { const f32x4 a = ap[i]; z2 = (pg8::f32x2){a.x, a.y} * wfb[2 * i] + z2; z2 = (pg8::f32x2){a.z, a.w} * wfb[2 * i + 1] + z2; } \
        zf = z2.x; zb = z2.y; } while (0)
    const int NT = 256 + (NRC - 256) * 8;
    for (int task = blockIdx.x; task < NT; task += F.G) {
        const int rc = task < 256 ? task : 256 + ((task - 256) >> 3), h = task < 256 ? F.wave : ((task - 256) & 7);
        const bool active = task < 256 || F.wave == 0;
        const bool lat = rc < 256;
        const bf16* Prow0 = P + (size_t)rc * 64 * DINP;
        col = 64 * h + dk;
#pragma unroll
        for (int i = 0; i < 16; ++i) wfb[i] = (pg8::f32x2){w2[i * 512 + col], w2[(16 + i) * 512 + col]} * 1.4426950408889634f;
        bfb = (pg8::f32x2){bg[col], bg[512 + col]} * 1.4426950408889634f;
        __syncthreads();
        if (F.tid < 256) { const int row = F.tid >> 2, part = F.tid & 3; const v4u w = *(const v4u*)(Prow0 + (size_t)row * DINP + C_AB + 8 * part);
            LAS float* d = ABf + row * 32 + 16 * (part & 1) + (part >> 1);
            d[0] = bflo(w.x); d[2] = bfhi(w.x); d[4] = bflo(w.y); d[6] = bfhi(w.y); d[8] = bflo(w.z); d[10] = bfhi(w.z); d[12] = bflo(w.w); d[14] = bfhi(w.w); }
        __syncthreads();
        if (!active) continue;
        const int prw = rc & 63;
        float pf = 0.f, pbx = 0.f;
        for (int t8 = 0; t8 < 64; t8 += 8) {
            float qv[8], kv[8];
#pragma unroll
            for (int tt = 0; tt < 8; ++tt) { const bf16* prow = Prow0 + (size_t)(t8 + tt) * DINP; qv[tt] = bf2f(prow[C_QB + col]); kv[tt] = bf2f(prow[C_KB + col]); }
#pragma unroll
            for (int tt = 0; tt < 8; ++tt) {
                const int t = t8 + tt;
                float zf, zb; GLA_Z(t, zf, zb);
                const float gf = logsig16(zf), gb = logsig16(zb);
                pf += gf; const float cumf = pf, pbe = pbx; pbx += gb;
                float q = qv[tt], k = kv[tt];
                const float qp = __shfl_xor(q, 16), kp = __shfl_xor(k, 16);
                if (lat) { const int ri = (hf ? t : prw) * 16 + f; const float c = RTc[ri], s = RTs[ri];
                    const float ss = s * sgn; q = fmaf(qp, ss, q * c); k = fmaf(kp, ss, k * c); }
                q *= 0.125f;
                const unsigned o = (unsigned)((rc * 64 + t) * 512 + col);
                const unsigned wq = pg8::cvt_pk_bf16(q * __builtin_amdgcn_exp2f(cumf), q * __builtin_amdgcn_exp2f(fminf(-pbe, 115.f))), wk = pg8::cvt_pk_bf16(k * __builtin_amdgcn_exp2f(fminf(-cumf, 115.f)), k * __builtin_amdgcn_exp2f(pbe));
                QF[o] = (bf16)(wq & 0xffffu); QB[o] = (bf16)(wq >> 16); KF[o] = (bf16)(wk & 0xffffu); KB[o] = (bf16)(wk >> 16);
            }
        }
        AL[(size_t)(0 * NRC + rc) * 512 + col] = __builtin_amdgcn_exp2f(pf); AL[(size_t)(1 * NRC + rc) * 512 + col] = __builtin_amdgcn_exp2f(pbx);
    }
#undef GLA_Z
    __syncthreads();
}

__device__ __forceinline__ void stage_vt(Frame& F, const bf16* P, int rc, int h, LAS bf16* VT) {
    const int tp = (F.tid & 31) * 2, d8 = (F.tid >> 5) * 8;
    const bf16* src = P + (size_t)(rc * 64 + tp) * DINP + C_VB + 128 * h + d8;
    const v4u w0 = *(const v4u*)src, w1 = *(const v4u*)(src + DINP);
    LAS unsigned* dst = (LAS unsigned*)(VT + d8 * PITCH + tp);
    dst[0 * (PITCH / 2)] = (w0.x & 0xffffu) | (w1.x << 16); dst[1 * (PITCH / 2)] = (w0.x >> 16) | (w1.x & 0xffff0000u);
    dst[2 * (PITCH / 2)] = (w0.y & 0xffffu) | (w1.y << 16); dst[3 * (PITCH / 2)] = (w0.y >> 16) | (w1.y & 0xffff0000u);
    dst[4 * (PITCH / 2)] = (w0.z & 0xffffu) | (w1.z << 16); dst[5 * (PITCH / 2)] = (w0.z >> 16) | (w1.z & 0xffff0000u);
    dst[6 * (PITCH / 2)] = (w0.w & 0xffffu) | (w1.w << 16); dst[7 * (PITCH / 2)] = (w0.w >> 16) | (w1.w & 0xffff0000u);
}
#define GLA_BAR() do { asm volatile("s_waitcnt lgkmcnt(0)" ::: "memory"); __builtin_amdgcn_s_barrier(); asm volatile("" ::: "memory"); } while (0)
#define GLA_FRAG(base, row, col) (*(const LAS bf16x8*)((base) + (row) * PITCH + (col)))

__device__ __forceinline__ void ph_g1(Frame& F) {
    const bf16* P = (const bf16*)(F.ws + WS_P); const bf16* KFg = (const bf16*)(F.ws + WS_KF); const bf16* KBg = (const bf16*)(F.ws + WS_KB); bf16* UT = (bf16*)(F.ws + WS_UT); const float* AL = (const float*)(F.ws + WS_AL);
    LAS bf16* VT = (LAS bf16*)(F.lds + RING_OFF); LAS bf16* KH0 = VT + 128 * PITCH; LAS bf16* KH1 = KH0 + 64 * PITCH;
    const int r32 = F.lane & 31, hi = F.lane >> 5, dir = F.wave >> 2, db = F.wave & 3;
    for (int u = blockIdx.x; u < NRC * 8; u += F.G) {
        const int rc = u >> 3, h = u & 7;
        __syncthreads();
        stage_vt(F, P, rc, h, VT);
        {
            const int half = F.tid >> 8, tl = F.tid & 255, tp = (tl & 31) * 2, d8 = (tl >> 5) * 8;
            const bf16* src = (half ? KBg : KFg) + (size_t)(rc * 64 + tp) * 512 + 64 * h + d8;
            const v4u w0 = *(const v4u*)src, w1 = *(const v4u*)(src + 512);
            LAS unsigned* dst = (LAS unsigned*)((half ? KH1 : KH0) + d8 * PITCH + tp);
            dst[0 * (PITCH / 2)] = (w0.x & 0xffffu) | (w1.x << 16); dst[1 * (PITCH / 2)] = (w0.x >> 16) | (w1.x & 0xffff0000u);
            dst[2 * (PITCH / 2)] = (w0.y & 0xffffu) | (w1.y << 16); dst[3 * (PITCH / 2)] = (w0.y >> 16) | (w1.y & 0xffff0000u);
            dst[4 * (PITCH / 2)] = (w0.z & 0xffffu) | (w1.z << 16); dst[5 * (PITCH / 2)] = (w0.z >> 16) | (w1.z & 0xffff0000u);
            dst[6 * (PITCH / 2)] = (w0.w & 0xffffu) | (w1.w << 16); dst[7 * (PITCH / 2)] = (w0.w >> 16) | (w1.w & 0xffff0000u); }
        __syncthreads();
        const LAS bf16* KH = dir ? KH1 : KH0;
        f32x16 acc0 = {}, acc1 = {};
#pragma unroll
        for (int ks = 0; ks < 4; ++ks) { const bf16x8 a = GLA_FRAG(VT, 32 * db + r32, 16 * ks + 8 * hi);
            acc0 = __builtin_amdgcn_mfma_f32_32x32x16_bf16(a, GLA_FRAG(KH, r32, 16 * ks + 8 * hi), acc0, 0, 0, 0);
            acc1 = __builtin_amdgcn_mfma_f32_32x32x16_bf16(a, GLA_FRAG(KH, 32 + r32, 16 * ks + 8 * hi), acc1, 0, 0, 0); }
        const int b = rc_batch(rc), chain = (b * 8 + h) * 2 + dir, slot = rc_slot(rc, dir);
        if (dir == 0) { const float a0 = AL[(size_t)rc * 512 + 64 * h + r32], a1 = AL[(size_t)rc * 512 + 64 * h + 32 + r32];
#pragma unroll
            for (int r = 0; r < 16; ++r) { acc0[r] *= a0; acc1[r] *= a1; } }
        bf16* dst = UT + ((size_t)chain * 68 + slot) * 8192;
#pragma unroll
        for (int r = 0; r < 16; ++r) { const int dv = 32 * db + crow(r, hi); dst[dv * 64 + r32] = (bf16)f2bf(acc0[r]); dst[dv * 64 + 32 + r32] = (bf16)f2bf(acc1[r]); }
    }
    __syncthreads();
}

__device__ __forceinline__ void ph_g2(Frame& F) {
    const int gt = F.vcu * NWAVES * 64 + F.tid, NGT = F.G * NWAVES * 64;
    const bf16* UT = (const bf16*)(F.ws + WS_UT); bf16* ST = (bf16*)(F.ws + WS_ST); const float* AL = (const float*)(F.ws + WS_AL);
    for (int it = gt; it < 64 * 128 * 16; it += NGT) {
        const int chain = it >> 11, rem = it & 2047, dv = rem >> 4, dk4 = (rem & 15) * 4;
        const int dir = chain & 1, h = (chain >> 1) & 7, b = chain >> 4;
        float S0 = 0.f, S1 = 0.f, S2 = 0.f, S3 = 0.f;
        const size_t base = (size_t)chain * 68 * 8192 + dv * 64 + dk4;
#pragma unroll 17
        for (int s = 0; s < 68; ++s) {
            const v2u uw = *(const v2u*)(UT + base + (size_t)s * 8192);
            const int rc = chain_slot_rc(b, dir, s);
            const f32x4 a = *(const f32x4*)(AL + (size_t)(dir * NRC + rc) * 512 + 64 * h + dk4);
            v2u o; if (dir) { o.x = pk2(S0 * a.x, S1 * a.y); o.y = pk2(S2 * a.z, S3 * a.w); } else { o.x = pk2(S0, S1); o.y = pk2(S2, S3); }
            *(v2u*)(ST + base + (size_t)s * 8192) = o;
            S0 = fmaf(a.x, S0, bflo(uw.x)); S1 = fmaf(a.y, S1, bfhi(uw.x)); S2 = fmaf(a.z, S2, bflo(uw.y)); S3 = fmaf(a.w, S3, bfhi(uw.y));
        }
    }
}

#define GLA_PK4(P, BASE, OUT) do { unsigned a0 = pk2(P[BASE + 0], P[BASE + 1]), a1 = pk2(P[BASE + 2], P[BASE + 3]);   \
    unsigned b0 = pk2(P[BASE + 4], P[BASE + 5]), b1 = pk2(P[BASE + 6], P[BASE + 7]);                              \
    auto r0 = __builtin_amdgcn_permlane32_swap(a0, b0, false, false); auto r1 = __builtin_amdgcn_permlane32_swap(a1, b1, false, false); \
    u32x4 w = {r0[0], r1[0], r0[1], r1[1]}; OUT = *reinterpret_cast<bf16x8*>(&w); } while (0)
template <int DIR>
__device__ __forceinline__ void g3_intra(f32x16& o, const LAS bf16* Kt, const LAS bf16* Qt, const LAS bf16* VT, int jb, int tb, int db, int r32, int hi) {
    f32x16 X = {};
#pragma unroll
    for (int ks = 0; ks < 4; ++ks) X = __builtin_amdgcn_mfma_f32_32x32x16_bf16(GLA_FRAG(Kt, 32 * jb + r32, 16 * ks + 8 * hi), GLA_FRAG(Qt, 32 * tb + r32, 16 * ks + 8 * hi), X, 0, 0, 0);
    if (jb == tb) {
#pragma unroll
        for (int r = 0; r < 16; ++r) { const int tj = crow(r, hi); const bool keep = DIR ? (tj >= r32) : (tj <= r32); X[r] = keep ? X[r] : 0.f; }
    }
    bf16x8 x0, x1; GLA_PK4(X, 0, x0); GLA_PK4(X, 8, x1);
    o = __builtin_amdgcn_mfma_f32_32x32x16_bf16(GLA_FRAG(VT, 32 * db + r32, 32 * jb + 8 * hi), x0, o, 0, 0, 0);
    o = __builtin_amdgcn_mfma_f32_32x32x16_bf16(GLA_FRAG(VT, 32 * db + r32, 32 * jb + 16 + 8 * hi), x1, o, 0, 0, 0);
}
__device__ __forceinline__ void ph_g3(Frame& F, int e, int nrc) {
    const bf16* P = (const bf16*)(F.ws + WS_P); const bf16* ST = (const bf16*)(F.ws + WS_ST); bf16* MIX = (bf16*)(F.ws + WS_MIX);
    const bf16* QFg = (const bf16*)(F.ws + WS_QF); const bf16* KFg = (const bf16*)(F.ws + WS_KF); const bf16* QBg = (const bf16*)(F.ws + WS_QB); const bf16* KBg = (const bf16*)(F.ws + WS_KB);
    const float* gg = (F.ka->in[I_GLAG]) + (size_t)e * 8 * 128;
    LAS bf16* VT = (LAS bf16*)(F.lds + RING_OFF); LAS bf16* QFl = VT + 128 * PITCH; LAS bf16* KFl = QFl + 64 * PITCH; LAS bf16* QBl = KFl + 64 * PITCH; LAS bf16* KBl = QBl + 64 * PITCH;
    LAS float* SS = (LAS float*)(KBl + 64 * PITCH);
    const int r32 = F.lane & 31, hi = F.lane >> 5, tb = F.wave & 1, db = F.wave >> 1;
    const int s_tp = (F.tid & 31) * 2, s_d8 = (F.tid >> 5) * 8, s_t = F.tid >> 3, s_c8 = (F.tid & 7) * 8;
    v4u pv0, pv1, pqf, pkf, pqb, pkb; bf16x8 nsf[4], nsb[4];
#define G3_LOAD(uu) do { const int _rc = (uu) >> 3, _h = (uu) & 7, _b = rc_batch(_rc); \
        const bf16* _vs = P + (size_t)(_rc * 64 + s_tp) * DINP + C_VB + 128 * _h + s_d8; pv0 = *(const v4u*)_vs; pv1 = *(const v4u*)(_vs + DINP); \
        const size_t _go = (size_t)(_rc * 64 + s_t) * 512 + 64 * _h + s_c8; pqf = *(const v4u*)(QFg + _go); pkf = *(const v4u*)(KFg + _go); pqb = *(const v4u*)(QBg + _go); pkb = *(const v4u*)(KBg + _go); \
        const bf16* _sf = ST + ((size_t)((_b * 8 + _h) * 2 + 0) * 68 + rc_slot(_rc, 0)) * 8192 + (size_t)(32 * db + r32) * 64 + 8 * hi; \
        const bf16* _sb = ST + ((size_t)((_b * 8 + _h) * 2 + 1) * 68 + rc_slot(_rc, 1)) * 8192 + (size_t)(32 * db + r32) * 64 + 8 * hi; \
        _Pragma("unroll") for (int ks = 0; ks < 4; ++ks) { nsf[ks] = *(const bf16x8*)(_sf + 16 * ks); nsb[ks] = *(const bf16x8*)(_sb + 16 * ks); } } while (0)
    int u = blockIdx.x;
    if (u < nrc * 8) G3_LOAD(u);
    for (; u < nrc * 8; u += F.G) {
        const int rc = u >> 3, h = u & 7;
        GLA_BAR();
        { LAS unsigned* dst = (LAS unsigned*)(VT + s_d8 * PITCH + s_tp);
            dst[0 * (PITCH / 2)] = (pv0.x & 0xffffu) | (pv1.x << 16); dst[1 * (PITCH / 2)] = (pv0.x >> 16) | (pv1.x & 0xffff0000u);
            dst[2 * (PITCH / 2)] = (pv0.y & 0xffffu) | (pv1.y << 16); dst[3 * (PITCH / 2)] = (pv0.y >> 16) | (pv1.y & 0xffff0000u);
            dst[4 * (PITCH / 2)] = (pv0.z & 0xffffu) | (pv1.z << 16); dst[5 * (PITCH / 2)] = (pv0.z >> 16) | (pv1.z & 0xffff0000u);
            dst[6 * (PITCH / 2)] = (pv0.w & 0xffffu) | (pv1.w << 16); dst[7 * (PITCH / 2)] = (pv0.w >> 16) | (pv1.w & 0xffff0000u);
            const int lo = s_t * PITCH + s_c8;
            *(LAS v4u*)(QFl + lo) = pqf; *(LAS v4u*)(KFl + lo) = pkf; *(LAS v4u*)(QBl + lo) = pqb; *(LAS v4u*)(KBl + lo) = pkb; }
        bf16x8 sf[4], sb[4];
#pragma unroll
        for (int ks = 0; ks < 4; ++ks) { sf[ks] = nsf[ks]; sb[ks] = nsb[ks]; }
        GLA_BAR();
        if (u + F.G < nrc * 8) G3_LOAD(u + F.G);
        f32x16 o = {};
#pragma unroll
        for (int ks = 0; ks < 4; ++ks) { o = __builtin_amdgcn_mfma_f32_32x32x16_bf16(sf[ks], GLA_FRAG(QFl, 32 * tb + r32, 16 * ks + 8 * hi), o, 0, 0, 0);
            o = __builtin_amdgcn_mfma_f32_32x32x16_bf16(sb[ks], GLA_FRAG(QBl, 32 * tb + r32, 16 * ks + 8 * hi), o, 0, 0, 0); }
        if (tb == 0) { g3_intra<0>(o, KFl, QFl, VT, 0, 0, db, r32, hi); g3_intra<1>(o, KBl, QBl, VT, 0, 0, db, r32, hi); g3_intra<1>(o, KBl, QBl, VT, 1, 0, db, r32, hi); }
        else         { g3_intra<0>(o, KFl, QFl, VT, 0, 1, db, r32, hi); g3_intra<0>(o, KFl, QFl, VT, 1, 1, db, r32, hi); g3_intra<1>(o, KBl, QBl, VT, 1, 1, db, r32, hi); }
        float ss = 0.f;
#pragma unroll
        for (int r = 0; r < 16; ++r) ss = fmaf(o[r], o[r], ss);
        { auto rr = __builtin_amdgcn_permlane32_swap(__float_as_uint(ss), __float_as_uint(ss), false, false); ss = __uint_as_float(rr[0]) + __uint_as_float(rr[1]); }
        if (hi == 0) SS[db * 64 + 32 * tb + r32] = ss;
        GLA_BAR();
        const int t = 32 * tb + r32;
        const float tot = (SS[t] + SS[64 + t]) + (SS[128 + t] + SS[192 + t]);
        const float rn = 1.0f / sqrtf(tot * (1.0f / 128.0f) + EPS);
        const size_t row = (size_t)rc * 64 + t;
#pragma unroll
        for (int g4 = 0; g4 < 4; ++g4) { const int dv0 = 32 * db + 8 * g4 + 4 * hi;
            const v2u gw = *(const v2u*)(P + row * DINP + C_GB + 128 * h + dv0); const f32x4 gn = *(const f32x4*)(gg + 128 * h + dv0);
            const float g0 = bflo(gw.x), g1 = bfhi(gw.x), g2 = bflo(gw.y), g3 = bfhi(gw.y);
            const float y0 = o[4 * g4 + 0] * rn * gn.x * (g0 / (1.0f + __expf(-g0))), y1 = o[4 * g4 + 1] * rn * gn.y * (g1 / (1.0f + __expf(-g1)));
            const float y2 = o[4 * g4 + 2] * rn * gn.z * (g2 / (1.0f + __expf(-g2))), y3 = o[4 * g4 + 3] * rn * gn.w * (g3 / (1.0f + __expf(-g3)));
            v2u w; w.x = pk2(y0, y1); w.y = pk2(y2, y3);
            *(v2u*)(MIX + row * D + 1024 + 128 * h + dv0) = w; }
    }
#undef G3_LOAD
    __syncthreads();
}
#undef GLA_PK4
#undef GLA_FRAG
#undef GLA_BAR
}

constexpr int N_PHASES = 54;
__host__ __device__ constexpr bool phase_active(int id) {
    if (id == 0 || id == N_PHASES - 1) return true;
    const int L = (id - 1) / 13, k = (id - 1) % 13; const bool even = (L & 1) == 0;
    if (k == 1 || k == 8) return !even;
    if (k >= 2 && k <= 7) return even;
    return true;
}

__global__ void __launch_bounds__(NWAVES * 64, 2) fwd_kernel(Args args) {
    extern __shared__ __attribute__((aligned(16))) unsigned char lds[];
    Frame F;
    F.lds = (LAS unsigned char*)lds; F.ldsg = lds;
    F.MISC = (volatile LAS unsigned*)(F.lds + MISC_OFF);
    F.tid = threadIdx.x; F.lane = F.tid & 63; F.wave = __builtin_amdgcn_readfirstlane(F.tid >> 6);
    F.G = gridDim.x; { const int bx = blockIdx.x; F.vcu = (F.G % 8 == 0) ? (bx % 8) * (F.G / 8) + bx / 8 : bx; }
    F.ka = (KArgs)__builtin_amdgcn_kernarg_segment_ptr(); F.ws = F.ka->ws;
    for (int u = F.tid; u < (LDS_BYTES - LDSCTL_OFF) / 4; u += NWAVES * 64) ((LAS unsigned*)(F.lds + LDSCTL_OFF))[u] = 0u;
    __syncthreads();
    unsigned* barw = (unsigned*)(F.ws + WS_CTL) + CW_BAR;
    XcdBarrier bar = xcd_barrier_post(barw, F.MISC + 8);
    const int lo = args.ph_lo, hi = args.ph_hi;
    bool started = false;
#ifndef PH_MASK
#define PH_MASK 0xFFFFFFFFu
#endif
#ifndef PH_REP
#define PH_REP 0u
#endif
#define PHASE_BEGIN(id, kind) if (((PH_MASK >> (kind)) & 1u) && lo <= (id) && (id) < hi) { if (started) xcd_barrier(bar); started = true; for (int _rep = 0; _rep < (((PH_REP >> (kind)) & 1u) ? 2 : 1); ++_rep) { \
    { int _t = threadIdx.x; asm volatile("" : "+v"(_t)); F.tid = _t; F.lane = _t & 63; F.wave = __builtin_amdgcn_readfirstlane(_t >> 6); KArgs _k = (KArgs)__builtin_amdgcn_kernarg_segment_ptr(); asm volatile("" : "+s"(_k)); F.ka = _k; F.ws = _k->ws; }
#define PHASE_END } }

    PHASE_BEGIN(0, 0) ph_prologue(F); PHASE_END

    const float* MOD = (const float*)(F.ws + WS_MOD);
    for (int L = 0; L < DEPTH; ++L) {
        const int base = 1 + 13 * L; const bool even = (L & 1) == 0; const int e = L >> 1;
        const float* modl = MOD + (size_t)L * 5 * MODW;
#define XRc ((const float*)(F.ws + WS_XR) + (size_t)MLAT * D)
        const int rows_mix_in = (L <= 2) ? MR : MLAT;
        const int rows_upd = (L <= 1) ? MR : MLAT;

        PHASE_BEGIN(base + 0, 1) {
            ph_norm(F, rows_mix_in, L == 0 ? (F.ka->in[I_X]) : (const float*)nullptr, L == 0 ? (F.ka->in[I_CTX]) : XRc, (F.ka->in[I_N1G]) + (size_t)L * D, modl, 0, D, 4);
            if (L == 0) {
                const f32x4* cs = (const f32x4*)(F.ka->in[I_CTX]); f32x4* xd = (f32x4*)(F.ws + WS_XR) + (size_t)MLAT * D / 4;
                for (int i = F.vcu * NWAVES * 64 + F.tid; i < MCTX * D / 4; i += F.G * NWAVES * 64) xd[i] = cs[i];
            }
        } PHASE_END
        if (!even) {
            PHASE_BEGIN(base + 1, 2) ph_pool(F, rows_upd); PHASE_END
        }
        if (even) {
            PHASE_BEGIN(base + 2, 3) {
                pg8::Gemm g{(const pg8::bf16_t*)(F.ws + WS_H), (const pg8::bf16_t*)(F.ws + WS_WIN) + (size_t)e * DINP * D, MR, DINP, D, D, D, 1, 0, 0};
                pg8::StaticOrder S; S.init(MR, DINP, D, 1, F.G, (int)blockIdx.x);
                pg8::EpiBf16 E{(pg8::bf16_t*)(F.ws + WS_P), DINP};
                pg8::gemm_phase<pg8::EpiBf16, pg8::StaticOrder, false>(F.lds + RING_OFF, g, S, E, F.tid);
            } PHASE_END
            PHASE_BEGIN(base + 3, 4) {
                gla::ph_prep(F, e);
                if (L == 0) {
                    const na::bf16* P = (const na::bf16*)(F.ws + WS_P); na::bf16* MIX = (na::bf16*)(F.ws + WS_MIX);
                    for (int q = blockIdx.x; q < 48; q += F.G) { const int uc = q - 16; if (uc < 0) continue; const int b = uc >> 3, h = uc & 7;
                        na::na_unit<DINP, D>(P, C_QA + 128 * h, C_KA + 128 * h, C_VA + 128 * h, (long)MLAT + b * CTXL, (long)MLAT + b * CTXL, 0, 0, 0, 0,
                                             MIX, 128 * h, (F.ka->in[I_RPB]), (char*)lds + RING_OFF, F.tid); }
                }
            } PHASE_END
            PHASE_BEGIN(base + 4, 5) {
                gla::ph_g1(F);
                const na::bf16* P = (const na::bf16*)(F.ws + WS_P); na::bf16* MIX = (na::bf16*)(F.ws + WS_MIX);
                for (int u = F.vcu; u < 512; u += F.G) { const int b = u >> 7, h = (u >> 4) & 7, i = u & 15;
                    const int klo = i == 0 ? 0 : (i == 15 ? 56 : 4 * i - 4), nband = (i == 0 || i == 15) ? 8 : 12;
                    na::na_unit<DINP, D>(P, C_QA + 128 * h, C_KA + 128 * h, C_VA + 128 * h, (long)b * SEQ + 256 * i, (long)MLAT + b * CTXL, (long)b * SEQ + 64 * klo, nband, klo, 4 * i,
                                         MIX, 128 * h, (F.ka->in[I_RPB]) + ((size_t)e * 8 + h) * 15 * 31, (char*)lds + RING_OFF, F.tid); }
            } PHASE_END
            PHASE_BEGIN(base + 5, 6) {
                gla::ph_g2(F);
            } PHASE_END
            PHASE_BEGIN(base + 6, 7) gla::ph_g3(F, e, L == 0 ? MR / 64 : MLAT / 64); PHASE_END
            PHASE_BEGIN(base + 7, 8) {
                const int M = rows_upd;
                pg8::Gemm g{(const pg8::bf16_t*)(F.ws + WS_MIX), (const pg8::bf16_t*)(F.ws + WS_WOUT) + (size_t)e * D * D, M, D, D, D, D, 1, 0, 0};
                pg8::SplitTailOrder S; S.init(MLAT, M - MLAT, D, D, 4, F.G, (int)blockIdx.x);
                pg8::EpiResid E{(float*)(F.ws + WS_PART), (pg8::bf16_t*)(F.ws + WS_X16), D, modl + 2 * D, MODW, nullptr, 0, MLAT, MCTX};
                pg8::gemm_phase<pg8::EpiResid, pg8::SplitTailOrder, true>(F.lds + RING_OFF, g, S, E, F.tid);
            } PHASE_END
        } else {
            PHASE_BEGIN(base + 8, 9) {
                const int M = rows_upd;
                pg8::Gemm g{(const pg8::bf16_t*)(F.ws + WS_MIX), (const pg8::bf16_t*)(F.ws + WS_WPOOL) + (size_t)e * 4 * 512 * 512, M, 512, 512, D, 512, 4, (size_t)512 * 2, (size_t)512 * 512 * 2};
                pg8::StaticOrder S; S.init(M, 512, 512, 4, F.G, (int)blockIdx.x);
                pg8::EpiResid E{(float*)(F.ws + WS_PART), (pg8::bf16_t*)(F.ws + WS_X16), D, modl + 2 * D, MODW, (F.ka->in[I_POOLS]) + (size_t)e * D, 512, MLAT, MCTX};
                pg8::gemm_phase<pg8::EpiResid, pg8::StaticOrder, true>(F.lds + RING_OFF, g, S, E, F.tid);
            } PHASE_END
        }
        PHASE_BEGIN(base + 9, 10) ph_norm(F, rows_upd, (const float*)nullptr, XRc, (F.ka->in[I_N2G]) + (size_t)L * D, modl, 3 * D, 4 * D, even ? 4 : 1); PHASE_END
        PHASE_BEGIN(base + 10, 11) {
            const int M = rows_upd;
            pg8::Gemm g{(const pg8::bf16_t*)(F.ws + WS_H), (const pg8::bf16_t*)(F.ws + WS_WUP) + (size_t)L * DUP * D, M, DUP, D, D, D, 1, 0, 0};
            pg8::StaticOrder S; S.init(M, DUP, D, 1, F.G, (int)blockIdx.x);
            pg8::EpiGlu E{(pg8::bf16_t*)(F.ws + WS_ACT), LDF, (F.ka->in[I_CONVW]) + (size_t)L * 3 * DFF, (F.ka->in[I_CONVB]) + (size_t)L * DFF, (float*)(F.ws + WS_SB), DFF, (PG8_LAS float*)(F.lds + RING_OFF + 131072)};
            pg8::gemm_phase<pg8::EpiGlu, pg8::StaticOrder, true>(F.lds + RING_OFF, g, S, E, F.tid);
        } PHASE_END
        PHASE_BEGIN(base + 11, 12) ph_glufix(F, rows_upd, (F.ka->in[I_CONVW]) + (size_t)L * 3 * DFF, (F.ka->in[I_CONVB]) + (size_t)L * DFF); PHASE_END
        PHASE_BEGIN(base + 12, 13) {
            const int M = rows_upd;
            pg8::Gemm g{(const pg8::bf16_t*)(F.ws + WS_ACT), (const pg8::bf16_t*)(F.ws + WS_WDOWN) + (size_t)L * D * LDF, M, D, DFF, LDF, LDF, 1, 0, 0};
            pg8::SplitTailOrder S; S.init(MLAT, M - MLAT, D, DFF, 4, F.G, (int)blockIdx.x);
            pg8::EpiResid E{(float*)(F.ws + WS_PART), (pg8::bf16_t*)(F.ws + WS_X16), D, modl + 5 * D, MODW, nullptr, 0, MLAT, MCTX};
            pg8::gemm_phase<pg8::EpiResid, pg8::SplitTailOrder, true>(F.lds + RING_OFF, g, S, E, F.tid);
        } PHASE_END
    }
#ifdef XTRA_BARRIERS
    for (int xb = 0; xb < XTRA_BARRIERS; ++xb) xcd_barrier(bar);
#endif
    PHASE_BEGIN(N_PHASES - 1, 14) ph_final(F); PHASE_END
#undef PHASE_BEGIN
#undef PHASE_END
#undef XRc
}

#ifndef MK_PER_PHASE
#define MK_PER_PHASE 0
#endif
extern "C" void kernel_launch(void* const* d_in, const int* in_sizes, int n_in, void* d_out, int out_size, void* d_ws, size_t ws_size, hipStream_t stream) {
    static int grid = 0;
    if (grid == 0) {
        if (n_in != 21 || in_sizes[0] != MLAT * D || out_size != MLAT * D || ws_size < WS_END) {
            fprintf(stderr, "kernel_launch: shape mismatch: n_in %d in0 %d out %d ws %zu (need %zu); nothing launched\n", n_in, n_in > 0 ? in_sizes[0] : -1, out_size, ws_size, (size_t)WS_END); grid = -1; return; }
        int dev = 0, cus = 0, per_cu = 0;
        if (hipGetDevice(&dev) != hipSuccess || hipDeviceGetAttribute(&cus, hipDeviceAttributeMultiprocessorCount, dev) != hipSuccess) { fprintf(stderr, "kernel_launch: device query failed\n"); grid = -1; return; }
        if (hipFuncSetAttribute((const void*)fwd_kernel, hipFuncAttributeMaxDynamicSharedMemorySize, LDS_BYTES) != hipSuccess) { fprintf(stderr, "kernel_launch: hipFuncSetAttribute failed\n"); grid = -1; return; }
        if (hipOccupancyMaxActiveBlocksPerMultiprocessor(&per_cu, (const void*)fwd_kernel, NWAVES * 64, LDS_BYTES) != hipSuccess || per_cu < 1) {
            fprintf(stderr, "kernel_launch: occupancy query reports %d workgroups per CU\n", per_cu); }
        (void)hipGetLastError();
        grid = cus;
    }
    if (grid < 0) return;
    if (hipMemsetAsync((char*)d_ws + WS_CTL, 0, CTL_ZERO_BYTES, stream) != hipSuccess) { fprintf(stderr, "kernel_launch: memset failed\n"); return; }
    Args a{};
    for (int i = 0; i < 21; ++i) a.in[i] = (const float*)d_in[i];
    a.out = (float*)d_out; a.ws = (unsigned char*)d_ws;
#if MK_PER_PHASE
    for (int p = 0; p < N_PHASES; ++p) { if (!phase_active(p)) continue; a.ph_lo = p; a.ph_hi = p + 1;
        hipLaunchKernelGGL(fwd_kernel, dim3(grid), dim3(NWAVES * 64), LDS_BYTES, stream, a); }
#else
    a.ph_lo = 0; a.ph_hi = N_PHASES;
    hipLaunchKernelGGL(fwd_kernel, dim3(grid), dim3(NWAVES * 64), LDS_BYTES, stream, a);
#endif
    const hipError_t le = hipPeekAtLastError();
    if (le != hipSuccess) fprintf(stderr, "kernel_launch: launch failed: %s\n", hipGetErrorName(le));
}
```

```cpp
#include <hip/hip_runtime.h>
#include <cstdio>
#include <cstdint>

namespace pg8 {
#define PG8_LAS __attribute__((address_space(3)))
typedef unsigned short bf16_t;
typedef short bf16x8 __attribute__((ext_vector_type(8)));
typedef float f32x4 __attribute__((ext_vector_type(4)));
typedef float f32x2 __attribute__((ext_vector_type(2)));
typedef unsigned u32x4 __attribute__((ext_vector_type(4)));
constexpr int BM = 256, BK = 64, HALF = 128, HTB = HALF * BK * 2  , STAGE_BYTES = 8 * HTB, NXCD = 8;

__host__ __device__ __forceinline__ int lds_byte(int r, int c) { const int st = (r >> 4) * 2 + (c >> 5), rr = r & 15, cc = c & 31, ob = rr * 64 + cc * 2; return st * 1024 + (ob ^ (((ob >> 9) & 1) << 5)); }
__host__ __device__ __forceinline__ void stage_rc(int b, int& R, int& C) { const int st = b / 1024, sb = b % 1024, swz = sb ^ (((sb >> 9) & 1) << 5); R = (st >> 1) * 16 + swz / 64; C = (st & 1) * 32 + (swz % 64) / 2; }
__host__ __device__ __forceinline__ int perm32(int rho) { const int n = rho >> 4, i = rho & 15; return 8 * (i >> 2) + 4 * n + (i & 3); }

struct Unit { int pm, pn, grp, kt0, nkt, atomic; };
struct Gemm { const bf16_t* A; const bf16_t* Bt; int M, N, K, lda, ldb, ngrp; size_t gsA, gsB; };

struct StaticOrder {
    int nM, nN, nNr, nwg, G, c, nktK, WGM = 4;
    __host__ __device__ void init(int M, int N, int K, int ngrp, int G_, int c_) { nM = M / BM; nNr = N / BM; nN = nNr * ngrp; nwg = nM * nN; G = G_; c = c_; nktK = K / BK; }
    __host__ __device__ bool next(int i, Unit& u) const {
        const long L = (long)i * G + c; if (L >= nwg) return false;
        int wgid = (int)L; { const int q = nwg / NXCD, r = nwg % NXCD, xcd = wgid % NXCD, off = wgid / NXCD; wgid = (xcd < r ? xcd * (q + 1) : r * (q + 1) + (xcd - r) * q) + off; }
        int nig = WGM * nN, nr = nNr;
#if defined(__HIP_DEVICE_COMPILE__)
        asm volatile("" : "+s"(nig), "+s"(nr));
#endif
        const int gid = wgid / nig, fm = gid * WGM, gsz = (nM - fm) < WGM ? (nM - fm) : WGM;
        u.pm = fm + ((wgid % nig) % gsz); const int vn = (wgid % nig) / gsz; u.pn = vn % nr; u.grp = vn / nr; u.kt0 = 0; u.nkt = nktK; u.atomic = 0; return true;
    }
    __device__ __forceinline__ void a_ready(const Unit&) const {}
    __device__ __forceinline__ void done(const Unit&) const {}
};
struct SplitTailOrder {
    StaticOrder main; int nA, nB, nNr, SK, nks, pmB, G, c;
    __host__ __device__ void init(int MA, int MB, int N, int K, int SK_, int G_, int c_) { main.init(MA, N, K, 1, G_, c_); nA = main.nwg; nNr = N / BM; SK = SK_; nks = (K / BK) / SK_; pmB = MA / BM; nB = (MB / BM) * nNr * SK_; G = G_; c = c_; }
    __host__ __device__ bool next(int i, Unit& u) const {
        const long L = (long)i * G + c;
        if (L < nA) return main.next(i, u);
        const int Lb = (int)(L - nA); if (Lb >= nB) return false;
        const int ks = Lb % SK, tile = Lb / SK; u.pn = tile % nNr; u.pm = pmB + tile / nNr; u.grp = 0; u.kt0 = ks * nks; u.nkt = nks; u.atomic = 1 + ks; return true;
    }
    __device__ __forceinline__ void a_ready(const Unit&) const {}
    __device__ __forceinline__ void done(const Unit&) const {}
};

__device__ __forceinline__ unsigned cvt_pk_bf16(float lo, float hi) { unsigned r; asm volatile("v_cvt_pk_bf16_f32 %0, %1, %2" : "=v"(r) : "v"(lo), "v"(hi)); return r; }
typedef float cf32x2 __attribute__((ext_vector_type(2)));
typedef __bf16 cbf16x2 __attribute__((ext_vector_type(2)));
__device__ __forceinline__ unsigned pkc(float lo, float hi) { return __builtin_bit_cast(unsigned, __builtin_convertvector((cf32x2){lo, hi}, cbf16x2)); }
__device__ __forceinline__ unsigned f2bfc(float f) { return pkc(f, f) & 0xffffu; }
typedef _Float16 f16x2 __attribute__((ext_vector_type(2)));
__device__ __forceinline__ unsigned pk_h2(float lo, float hi) { f16x2 p; p.x = (_Float16)__builtin_amdgcn_fmed3f(lo, -65504.0f, 65504.0f); p.y = (_Float16)__builtin_amdgcn_fmed3f(hi, -65504.0f, 65504.0f); return __builtin_bit_cast(unsigned, p); }
__device__ __forceinline__ float h_lo(unsigned w) { return (float)__builtin_bit_cast(f16x2, w).x; }
__device__ __forceinline__ float h_hi(unsigned w) { return (float)__builtin_bit_cast(f16x2, w).y; }
template <unsigned BITS> __device__ __forceinline__ float kc() { float r; asm volatile("s_mov_b32 %0, %1" : "=s"(r) : "n"(BITS)); return r; }
__device__ __forceinline__ void gelu4(const f32x2 (&v)[4], f32x2 (&o)[4]) {
    f32x2 c[4], w[4], q[4];
#pragma unroll
    for (int p = 0; p < 4; ++p) { c[p].x = __builtin_amdgcn_fmed3f(v[p].x, -5.0f, 5.0f); c[p].y = __builtin_amdgcn_fmed3f(v[p].y, -5.0f, 5.0f); w[p] = (c[p] * c[p]) * 0.08f + (-1.0f); }
    { const float ka = kc<0x3a40c646u>(), kb = kc<0xbadbc5c1u>();
#pragma unroll
      for (int p = 0; p < 4; ++p) q[p] = w[p] * ka + kb; }
    { const float kk = kc<0x3ab42bcbu>();
#pragma unroll
      for (int p = 0; p < 4; ++p) q[p] = q[p] * w[p] + kk; }
    { const float kk = kc<0xbb259aa1u>();
#pragma unroll
      for (int p = 0; p < 4; ++p) q[p] = q[p] * w[p] + kk; }
    { const float kk = kc<0x3bddb9bfu>();
#pragma unroll
      for (int p = 0; p < 4; ++p) q[p] = q[p] * w[p] + kk; }
    { const float kk = kc<0xbc394185u>();
#pragma unroll
      for (int p = 0; p < 4; ++p) q[p] = q[p] * w[p] + kk; }
    { const float kk = kc<0x3c85018cu>();
#pragma unroll
      for (int p = 0; p < 4; ++p) q[p] = q[p] * w[p] + kk; }
    { const float kk = kc<0xbcbe2975u>();
#pragma unroll
      for (int p = 0; p < 4; ++p) q[p] = q[p] * w[p] + kk; }
    { const float kk = kc<0x3d00edc6u>();
#pragma unroll
      for (int p = 0; p < 4; ++p) q[p] = q[p] * w[p] + kk; }
    { const float kk = kc<0xbd25b03eu>();
#pragma unroll
      for (int p = 0; p < 4; ++p) q[p] = q[p] * w[p] + kk; }
    { const float kk = kc<0x3d530477u>();
#pragma unroll
      for (int p = 0; p < 4; ++p) q[p] = q[p] * w[p] + kk; }
    { const float kk = kc<0xbd8ff74du>();
#pragma unroll
      for (int p = 0; p < 4; ++p) q[p] = q[p] * w[p] + kk; }
    { const float kk = kc<0x3e10c1adu>();
#pragma unroll
      for (int p = 0; p < 4; ++p) q[p] = q[p] * w[p] + kk; }
#pragma unroll
    for (int p = 0; p < 4; ++p) o[p] = v[p] * (q[p] * c[p] + 0.5f);
}

__device__ __forceinline__ f32x2 gelu_pk(f32x2 v) {
    f32x2 c; c.x = __builtin_amdgcn_fmed3f(v.x, -5.0f, 5.0f); c.y = __builtin_amdgcn_fmed3f(v.y, -5.0f, 5.0f);
    const f32x2 w = (c * c) * 0.08f + (-1.0f);
    f32x2 q = w * 7.353763795e-04f + (-1.676730928e-03f);
    q = q * w + 1.374596148e-03f; q = q * w + (-2.526916796e-03f); q = q * w + 6.766527425e-03f; q = q * w + (-1.130712498e-02f); q = q * w + 1.623608917e-02f;
    q = q * w + (-2.321312763e-02f); q = q * w + 3.147675842e-02f; q = q * w + (-4.045128077e-02f); q = q * w + 5.151792988e-02f; q = q * w + (-7.029590756e-02f); q = q * w + 1.413638145e-01f;
    return v * (q * c + 0.5f);
}

struct EpiBf16 {
    static constexpr bool PERM = true;
    bf16_t* O; int ldc;
    __device__ __forceinline__ void operator()(const f32x4 (&acc)[2][2][4][2], const Unit& u, int wr, int wc, int fr, int fq) const {
        const int row0 = u.pm * BM + wr * 64 + fr; const int col0 = u.pn * BM + wc * 32 + 8 * fq;
#pragma unroll
        for (int ai = 0; ai < 2; ++ai)
#pragma unroll
            for (int m = 0; m < 4; ++m) { bf16_t* rowp = O + (size_t)(row0 + ai * HALF + m * 16) * ldc + col0;
#pragma unroll
                for (int bj = 0; bj < 2; ++bj) { const f32x4 v0 = acc[ai][bj][m][0], v1 = acc[ai][bj][m][1];
                    u32x4 w; w.x = cvt_pk_bf16(v0[0], v0[1]); w.y = cvt_pk_bf16(v0[2], v0[3]); w.z = cvt_pk_bf16(v1[0], v1[1]); w.w = cvt_pk_bf16(v1[2], v1[3]);
                    *(u32x4*)(rowp + bj * HALF) = w; } }
    }
};
struct EpiGlu {
    static constexpr bool PERM = true;
    bf16_t* ACT; int ldc; const float* cw; const float* cb; float* SB; int dff; PG8_LAS float* XB;
    static __device__ __forceinline__ float ror1(float v)  { return __builtin_bit_cast(float, __builtin_amdgcn_update_dpp(0, __builtin_bit_cast(int, v), 0x121, 0xf, 0xf, true)); }
    static __device__ __forceinline__ float ror15(float v) { return __builtin_bit_cast(float, __builtin_amdgcn_update_dpp(0, __builtin_bit_cast(int, v), 0x12f, 0xf, 0xf, true)); }
    __device__ __forceinline__ void operator()(const f32x4 (&acc)[2][2][4][2], const Unit& u, int wr, int wc, int fr, int fq) const {
        const int ch0 = u.pn * HALF + wc * 32 + 8 * fq; const bool l0 = (fr == 0), l15 = (fr == 15);
        PG8_LAS float* xme = XB + ((wr * 4 + wc) * 4) * 32 + fq * 8;
#pragma unroll
        for (int ai = 0; ai < 2; ++ai) {
            if (fr == 0)  { *(PG8_LAS f32x4*)(xme + (ai * 2 + 0) * 32) = acc[ai][1][0][0]; *(PG8_LAS f32x4*)(xme + (ai * 2 + 0) * 32 + 4) = acc[ai][1][0][1]; }
            if (fr == 15) { *(PG8_LAS f32x4*)(xme + (ai * 2 + 1) * 32) = acc[ai][1][3][0]; *(PG8_LAS f32x4*)(xme + (ai * 2 + 1) * 32 + 4) = acc[ai][1][3][1]; }
        }
        asm volatile("s_waitcnt lgkmcnt(0)" ::: "memory"); __builtin_amdgcn_s_barrier(); asm volatile("" ::: "memory");
        f32x4 w0[2], w1[2], w2[2], bb[2];
#pragma unroll
        for (int n = 0; n < 2; ++n) { w0[n] = *(const f32x4*)(cw + ch0 + 4 * n); w1[n] = *(const f32x4*)(cw + dff + ch0 + 4 * n); w2[n] = *(const f32x4*)(cw + 2 * dff + ch0 + 4 * n); bb[n] = *(const f32x4*)(cb + ch0 + 4 * n); }
#pragma unroll
        for (int ai = 0; ai < 2; ++ai) {
            const int rp = 128 * ai + 64 * wr - 1, rn = 128 * ai + 64 * wr + 64;
            f32x4 xp[2], xn[2];
#pragma unroll
            for (int n = 0; n < 2; ++n) { xp[n] = (f32x4){0.f, 0.f, 0.f, 0.f}; xn[n] = (f32x4){0.f, 0.f, 0.f, 0.f}; }
            if (rp >= 0)  { const PG8_LAS float* s = XB + ((((rp >> 6) & 1) * 4 + wc) * 4 + (rp >> 7) * 2 + 1) * 32 + fq * 8; xp[0] = *(const PG8_LAS f32x4*)s; xp[1] = *(const PG8_LAS f32x4*)(s + 4); }
            if (rn < 256) { const PG8_LAS float* s = XB + ((((rn >> 6) & 1) * 4 + wc) * 4 + (rn >> 7) * 2 + 0) * 32 + fq * 8; xn[0] = *(const PG8_LAS f32x4*)s; xn[1] = *(const PG8_LAS f32x4*)(s + 4); }
#pragma unroll
            for (int m = 0; m < 4; ++m) {
                const int row = u.pm * BM + ai * HALF + wr * 64 + m * 16 + fr;
                u32x4 ow; float cv[8];
#pragma unroll
                for (int n = 0; n < 2; ++n)
#pragma unroll
                    for (int j = 0; j < 4; ++j) {
                        const float g = acc[ai][1][m][n][j];
                        const float tp = l15 ? ((m > 0) ? acc[ai][1][m > 0 ? m - 1 : 0][n][j] : xp[n][j]) : g;
                        const float tn = l0  ? ((m < 3) ? acc[ai][1][m < 3 ? m + 1 : 3][n][j] : xn[n][j]) : g;
                        const float gp = ror1(tp), gn = ror15(tn);
                        cv[4 * n + j] = fmaf(w0[n][j], gp, fmaf(w1[n][j], g, fmaf(w2[n][j], gn, bb[n][j])));
                    }
                const int tr = ai * HALF + wr * 64 + m * 16 + fr;
                if (tr == 0 || tr == 255) { float* sb = SB + ((size_t)(u.pm * 2 + (tr ? 1 : 0)) * 3) * dff + ch0;
#pragma unroll
                    for (int n = 0; n < 2; ++n) { *(f32x4*)(sb + 4 * n) = (f32x4){cv[4 * n], cv[4 * n + 1], cv[4 * n + 2], cv[4 * n + 3]}; *(f32x4*)(sb + dff + 4 * n) = acc[ai][0][m][n]; *(f32x4*)(sb + 2 * dff + 4 * n) = acc[ai][1][m][n]; } }
                f32x2 gv[4], go[4]; float a[8];
#pragma unroll
                for (int p = 0; p < 4; ++p) gv[p] = (f32x2){cv[2 * p], cv[2 * p + 1]};
                gelu4(gv, go);
#pragma unroll
                for (int e = 0; e < 8; e += 2) { a[e] = go[e >> 1].x * acc[ai][0][m][e >> 2][e & 3]; a[e + 1] = go[e >> 1].y * acc[ai][0][m][(e + 1) >> 2][(e + 1) & 3]; }
                ow.x = cvt_pk_bf16(a[0], a[1]); ow.y = cvt_pk_bf16(a[2], a[3]); ow.z = cvt_pk_bf16(a[4], a[5]); ow.w = cvt_pk_bf16(a[6], a[7]);
                *(u32x4*)(ACT + (size_t)row * ldc + ch0) = ow;
            }
        }
    }
};
struct EpiResid {
    static constexpr bool PERM = true;
    float* PART; bf16_t* X16; int ldx; const float* gate; int gstride; const float* cscale; int gcols; int mlat; int mctx;
    __device__ __forceinline__ void operator()(const f32x4 (&acc)[2][2][4][2], const Unit& u, int wr, int wc, int fr_, int fq_) const {
        int fr = fr_, fq = fq_; asm volatile("" : "+v"(fr), "+v"(fq));
        const int row0 = u.pm * BM + wr * 64 + fr, col0 = u.grp * gcols + u.pn * BM + wc * 32 + 8 * fq;
        const int rowt = u.pm * BM; const int bidx = rowt < mlat ? (rowt >> 12) : 4;
        const float* gp = gate + (size_t)bidx * gstride + col0;
        f32x4 gv[2][2];
#pragma unroll
        for (int bj = 0; bj < 2; ++bj)
#pragma unroll
            for (int n = 0; n < 2; ++n) { gv[bj][n] = *(const f32x4*)(gp + bj * HALF + n * 4); if (cscale) gv[bj][n] = gv[bj][n] * *(const f32x4*)(cscale + col0 + bj * HALF + n * 4); }
        if (rowt >= mlat) {
            float* base = PART + ((size_t)(u.atomic ? u.atomic - 1 : 0) * mctx + (size_t)(row0 - mlat)) * ldx + col0;
            f32x4 gc[2][2] = {{gv[0][0], gv[0][1]}, {gv[1][0], gv[1][1]}}; asm volatile("" : "+v"(gc[0][0]), "+v"(gc[0][1]), "+v"(gc[1][0]), "+v"(gc[1][1]));
#pragma unroll
            for (int ai = 0; ai < 2; ++ai)
#pragma unroll
                for (int m = 0; m < 4; ++m) { float* rowp = base + (size_t)(ai * HALF + m * 16) * ldx;
#pragma unroll
                    for (int bj = 0; bj < 2; ++bj)
#pragma unroll
                        for (int n = 0; n < 2; ++n) *(f32x4*)(rowp + bj * HALF + n * 4) = acc[ai][bj][m][n] * gc[bj][n]; }
        } else {
            u32x4 xin[2][4][2];
#pragma unroll
            for (int ai = 0; ai < 2; ++ai)
#pragma unroll
                for (int m = 0; m < 4; ++m)
#pragma unroll
                    for (int bj = 0; bj < 2; ++bj) xin[ai][m][bj] = *(const u32x4*)(X16 + (size_t)(row0 + ai * HALF + m * 16) * ldx + col0 + bj * HALF);
            asm volatile("" ::: "memory");
#pragma unroll
            for (int ai = 0; ai < 2; ++ai)
#pragma unroll
                for (int m = 0; m < 4; ++m)
#pragma unroll
                    for (int bj = 0; bj < 2; ++bj) { const u32x4 h = xin[ai][m][bj]; const f32x4 a0 = acc[ai][bj][m][0] * gv[bj][0], a1 = acc[ai][bj][m][1] * gv[bj][1];
                        u32x4 w;
                        w.x = pk_h2(h_lo(h.x) + a0[0], h_hi(h.x) + a0[1]); w.y = pk_h2(h_lo(h.y) + a0[2], h_hi(h.y) + a0[3]);
                        w.z = pk_h2(h_lo(h.z) + a1[0], h_hi(h.z) + a1[1]); w.w = pk_h2(h_lo(h.w) + a1[2], h_hi(h.w) + a1[3]);
                        *(u32x4*)(X16 + (size_t)(row0 + ai * HALF + m * 16) * ldx + col0 + bj * HALF) = w; }
        }
    }
};

template <class Epi, class Sched, bool ALIGN_EPI = true>
__device__ __forceinline__ void gemm_phase(PG8_LAS unsigned char* lds, const Gemm g, const Sched& S, const Epi& E, const int tid) {
    const int wid = __builtin_amdgcn_readfirstlane(tid >> 6), lane = tid & 63, wr = wid >> 2, wc = wid & 3, fr = lane & 15, fq = lane >> 4;
    unsigned voffA[2], voffB[2];
#pragma unroll
    for (int i = 0; i < 2; ++i) { int R, C; stage_rc(tid * 16 + i * 8192, R, C); const int Rb = Epi::PERM ? ((R & ~31) + perm32(R & 31)) : R;
        voffA[i] = (unsigned)(R * g.lda + C) * 2u; voffB[i] = (unsigned)(Rb * g.ldb + C) * 2u; }
    const size_t kstep = (size_t)(BK * 2);
    const size_t hstepA = (size_t)HALF * g.lda * 2, hstepB = (size_t)HALF * g.ldb * 2;
    const size_t tstepA = 2 * hstepA, tstepB = 2 * hstepB;
    const unsigned ldsw = (unsigned)wid * 1024u;
    const int aoff = lds_byte(wr * 64 + fr, fq * 8), boff = lds_byte(wc * 32 + fr, fq * 8);
#define PG8_SA(b, h) (((b) * 2 + (h)) * HTB)
#define PG8_SB(b, h) ((4 + (b) * 2 + (h)) * HTB)
#define PG8_STAGE(bufoff, gbase, voff) do { _Pragma("unroll") for (int _i = 0; _i < 2; ++_i) \
        __builtin_amdgcn_global_load_lds((const unsigned*)((const char*)(gbase) + (voff)[_i]), (PG8_LAS unsigned*)(lds + (bufoff) + ldsw + _i * 8192), 16, 0, 0); } while (0)
#define PG8_LDA(dst, b, h) do { _Pragma("unroll") for (int m = 0; m < 4; ++m) _Pragma("unroll") for (int k = 0; k < 2; ++k) dst[m][k] = *(const PG8_LAS bf16x8*)(lds + PG8_SA(b, h) + aoff + m * 2048 + k * 1024); } while (0)
#define PG8_LDB(dst, b, h) do { _Pragma("unroll") for (int n = 0; n < 2; ++n) _Pragma("unroll") for (int k = 0; k < 2; ++k) dst[n][k] = *(const PG8_LAS bf16x8*)(lds + PG8_SB(b, h) + boff + n * 2048 + k * 1024); } while (0)
#define PG8_MMA(ai, bj, At, Bt) do { __builtin_amdgcn_s_setprio(1); _Pragma("unroll") for (int m = 0; m < 4; ++m) _Pragma("unroll") for (int n = 0; n < 2; ++n) _Pragma("unroll") for (int k = 0; k < 2; ++k) \
        acc[ai][bj][m][n] = __builtin_amdgcn_mfma_f32_16x16x32_bf16(Bt[n][k], At[m][k], acc[ai][bj][m][n], 0, 0, 0); __builtin_amdgcn_s_setprio(0); } while (0)
#define PG8_WAIT_V(n) asm volatile("s_waitcnt vmcnt(" #n ")" ::: "memory")
#define PG8_WAIT_L(n) asm volatile("s_waitcnt lgkmcnt(" #n ")" ::: "memory")
#define PG8_BAR __builtin_amdgcn_s_barrier()
#define PG8_SCHED __builtin_amdgcn_sched_barrier(0)
    Unit cur, nxt; int ui = 0;
    if (!S.next(0, cur)) return;
    f32x4 acc[2][2][4][2];
#pragma unroll
    for (int a = 0; a < 2; ++a)
#pragma unroll
        for (int b = 0; b < 2; ++b)
#pragma unroll
            for (int m = 0; m < 4; ++m)
#pragma unroll
                for (int n = 0; n < 2; ++n) acc[a][b][m][n] = (f32x4){0.f, 0.f, 0.f, 0.f};
    bf16x8 At[4][2], B0[2][2], B1[2][2];
    const char* cA = (const char*)g.A + (size_t)cur.pm * tstepA + (size_t)cur.grp * g.gsA + (size_t)cur.kt0 * kstep; const char* cB = (const char*)g.Bt + (size_t)cur.pn * tstepB + (size_t)cur.grp * g.gsB + (size_t)cur.kt0 * kstep;
    S.a_ready(cur);
    PG8_STAGE(PG8_SB(0, 0), cB, voffB); PG8_STAGE(PG8_SB(0, 1), cB + hstepB, voffB); PG8_STAGE(PG8_SA(0, 0), cA, voffA); PG8_STAGE(PG8_SA(0, 1), cA + hstepA, voffA);
    if (wr == 1) PG8_BAR;
    PG8_WAIT_V(2); PG8_BAR;
    PG8_STAGE(PG8_SB(1, 0), cB + kstep, voffB); PG8_STAGE(PG8_SA(1, 0), cA + kstep, voffA); PG8_STAGE(PG8_SB(1, 1), cB + hstepB + kstep, voffB);
    PG8_WAIT_V(6); PG8_BAR;
    for (;;) {
        const bool has_next = S.next(ui + 1, nxt);
        const char* nA = has_next ? (const char*)g.A + (size_t)nxt.pm * tstepA + (size_t)nxt.grp * g.gsA + (size_t)nxt.kt0 * kstep : cA;
        const char* nB = has_next ? (const char*)g.Bt + (size_t)nxt.pn * tstepB + (size_t)nxt.grp * g.gsB + (size_t)nxt.kt0 * kstep : cB;
        const int nt = cur.nkt;
        for (int t = 0; t < nt; t += 2) {
            const bool last = (t == nt - 2);
            const char* a1 = cA + (size_t)(t + 1) * kstep;
            const char* a2 = last ? nA : cA + (size_t)(t + 2) * kstep; const char* b2 = last ? nB : cB + (size_t)(t + 2) * kstep;
            const char* a3 = a2 + kstep; const char* b3 = b2 + kstep;
            if (last && has_next) S.a_ready(nxt);
            PG8_LDB(B0, 0, 0); PG8_LDB(B1, 0, 1); PG8_SCHED; PG8_LDA(At, 0, 0); PG8_STAGE(PG8_SA(1, 1), a1 + hstepA, voffA);
            PG8_WAIT_V(8); PG8_WAIT_L(0); PG8_BAR; PG8_MMA(0, 0, At, B0); PG8_MMA(0, 1, At, B1); PG8_BAR; PG8_SCHED;
            PG8_LDA(At, 0, 1); PG8_STAGE(PG8_SB(0, 0), b2, voffB); PG8_STAGE(PG8_SB(0, 1), b2 + hstepB, voffB); PG8_STAGE(PG8_SA(0, 0), a2, voffA);
            PG8_WAIT_V(8); PG8_WAIT_L(0); PG8_BAR; PG8_MMA(1, 0, At, B0); PG8_MMA(1, 1, At, B1); PG8_BAR; PG8_SCHED;
            PG8_LDB(B0, 1, 0); PG8_LDB(B1, 1, 1); PG8_SCHED; PG8_LDA(At, 1, 0); PG8_STAGE(PG8_SA(0, 1), a2 + hstepA, voffA);
            PG8_WAIT_V(8); PG8_WAIT_L(0); PG8_BAR; PG8_MMA(0, 0, At, B0); PG8_MMA(0, 1, At, B1); PG8_BAR; PG8_SCHED;
            PG8_LDA(At, 1, 1); PG8_STAGE(PG8_SB(1, 0), b3, voffB); PG8_STAGE(PG8_SB(1, 1), b3 + hstepB, voffB); PG8_STAGE(PG8_SA(1, 0), a3, voffA);
            PG8_WAIT_V(8); PG8_WAIT_L(0); PG8_BAR; PG8_MMA(1, 0, At, B0); PG8_MMA(1, 1, At, B1); PG8_BAR; PG8_SCHED;
        }
        if constexpr (ALIGN_EPI) { if (wr == 0) PG8_BAR; }
        E(acc, cur, wr, wc, fr, fq); S.done(cur);
        if (!has_next) break;
#pragma unroll
        for (int a = 0; a < 2; ++a)
#pragma unroll
            for (int b = 0; b < 2; ++b)
#pragma unroll
                for (int m = 0; m < 4; ++m)
#pragma unroll
                    for (int n = 0; n < 2; ++n) acc[a][b][m][n] = (f32x4){0.f, 0.f, 0.f, 0.f};
        cur = nxt; cA = nA; cB = nB; ++ui;
        if constexpr (ALIGN_EPI) { if (wr == 1) PG8_BAR; }
    }
    PG8_WAIT_V(0);
    if constexpr (!ALIGN_EPI) { if (wr == 0) PG8_BAR; }
    PG8_BAR;
#undef PG8_SA
#undef PG8_SB
#undef PG8_STAGE
#undef PG8_LDA
#undef PG8_LDB
#undef PG8_MMA
#undef PG8_WAIT_V
#undef PG8_WAIT_L
#undef PG8_BAR
#undef PG8_SCHED
}
}

namespace na {
typedef unsigned short bf16;
using bf16x8 = __attribute__((ext_vector_type(8))) short;
using s16x4  = __attribute__((ext_vector_type(4))) short;
using f32x16 = __attribute__((ext_vector_type(16))) float;
using u32x4  = __attribute__((ext_vector_type(4))) unsigned;
constexpr int   D = 128, NW = 8, QBLK = 32, KVBLK = 64;
constexpr float SCALE = 0.088388347648318440f;
constexpr float THR = 8.f;
constexpr float NEG = -1.0e30f;
constexpr size_t SHM_V = KVBLK * D * 2, SHM_K = KVBLK * D * 2, SHM_ATTN = 2 * SHM_V + 2 * SHM_K + NW * 64 * 4;
constexpr size_t BIAS_OFF = 69632;
constexpr size_t PEN_OFF = BIAS_OFF + 640 * 4;
constexpr size_t QS_OFF = 73728;
constexpr size_t LDS_END = QS_OFF + NW * 8192;
#define NA_KSWZ(row, colB) ((row) * 256 + ((colB) ^ (((row) & 7) << 4)))
#define NA_SBAR() __builtin_amdgcn_sched_barrier(0)
__device__ __forceinline__ int crow(int r, int hi) { return (r & 3) + 8 * (r >> 2) + 4 * hi; }
__device__ __forceinline__ unsigned cvtpk(float lo, float hi) { unsigned r; asm volatile("v_cvt_pk_bf16_f32 %0, %1, %2" : "=v"(r) : "v"(lo), "v"(hi)); return r; }

__device__ __forceinline__ void partialSM(f32x16& p0, f32x16& p1, float& m_reg, float& mn, float& alpha) {
  constexpr float C = SCALE * 1.4426950408889634f;
  float pmax = p0[0];
#pragma unroll
  for (int r = 1; r < 16; ++r) pmax = fmaxf(pmax, p0[r]);
#pragma unroll
  for (int r = 0; r < 16; ++r) pmax = fmaxf(pmax, p1[r]);
  { auto rr = __builtin_amdgcn_permlane32_swap(__float_as_uint(pmax), __float_as_uint(pmax), false, false);
    pmax = fmaxf(__uint_as_float(rr[0]), __uint_as_float(rr[1])); }
  if (__builtin_expect(__all(pmax - m_reg <= THR / SCALE), 1)) { mn = m_reg; alpha = 1.f; }
  else { mn = fmaxf(m_reg, pmax); alpha = __builtin_amdgcn_exp2f((m_reg - mn) * C); m_reg = mn; }
  float mnC = -mn * C;
#pragma unroll
  for (int r = 0; r < 16; ++r) p0[r] = fmaf(p0[r], C, mnC);
#pragma unroll
  for (int r = 0; r < 16; ++r) p1[r] = fmaf(p1[r], C, mnC);
#pragma unroll
  for (int r = 0; r < 16; ++r) p0[r] = __builtin_amdgcn_exp2f(p0[r]);
}
__device__ __forceinline__ void finishSM(f32x16& p0, f32x16& p1, float alpha, float& l_reg, bf16x8& pa0, bf16x8& pa1, bf16x8& pa2, bf16x8& pa3) {
#pragma unroll
  for (int r = 0; r < 16; ++r) p1[r] = __builtin_amdgcn_exp2f(p1[r]);
  float ps = 0;
#pragma unroll
  for (int r = 0; r < 16; ++r) ps += p0[r];
#pragma unroll
  for (int r = 0; r < 16; ++r) ps += p1[r];
  { auto rr = __builtin_amdgcn_permlane32_swap(__float_as_uint(ps), __float_as_uint(ps), false, false);
    ps = __uint_as_float(rr[0]) + __uint_as_float(rr[1]); }
  l_reg = l_reg * alpha + ps;
#define NA_PK4(P, BASE, OUT) do { unsigned a0 = cvtpk(P[BASE + 0], P[BASE + 1]), a1 = cvtpk(P[BASE + 2], P[BASE + 3]);   \
    unsigned b0 = cvtpk(P[BASE + 4], P[BASE + 5]), b1 = cvtpk(P[BASE + 6], P[BASE + 7]);                              \
    auto r0 = __builtin_amdgcn_permlane32_swap(a0, b0, false, false); auto r1 = __builtin_amdgcn_permlane32_swap(a1, b1, false, false); \
    u32x4 w = {r0[0], r1[0], r0[1], r1[1]}; OUT = *reinterpret_cast<bf16x8*>(&w); } while (0)
  NA_PK4(p0, 0, pa0); NA_PK4(p0, 8, pa1); NA_PK4(p1, 0, pa2); NA_PK4(p1, 8, pa3);
#undef NA_PK4
}
__device__ __forceinline__ void qkt(f32x16& p0, f32x16& p1, const bf16* Ks, const bf16x8* qs, int r32, int hi) {
#pragma unroll
  for (int d0 = 0; d0 < 8; ++d0) { int cb = (d0 * 16 + hi * 8) * 2; const bf16x8 q = qs[d0 * 64];
    bf16x8 b0 = *reinterpret_cast<const bf16x8*>((const char*)Ks + NA_KSWZ(r32, cb));
    bf16x8 b1 = *reinterpret_cast<const bf16x8*>((const char*)Ks + NA_KSWZ(32 + r32, cb));
    p0 = __builtin_amdgcn_mfma_f32_32x32x16_bf16(b0, q, p0, 0, 0, 0);
    p1 = __builtin_amdgcn_mfma_f32_32x32x16_bf16(b1, q, p1, 0, 0, 0); }
}
__device__ __forceinline__ int v_st(int k, int c) { const int kk = (k & ~0xC) | ((k & 4) << 1) | ((k & 8) >> 1); return ((kk >> 3) * 4 + (c >> 5)) * 512 + ((kk & 7) * 32 + (c & 31)) * 2; }
__device__ __forceinline__ int v_rd_base(int lane) { return ((lane & 3) << 3) | (((lane >> 2) & 3) << 6) | (((lane >> 4) & 1) << 5) | (((lane >> 5) & 1) << 8); }
constexpr int v_rd_off(int d0, int ks, int half) { return d0 * 512 + ks * 4096 + half * 2048; }
template <int OFF> __device__ __forceinline__ s16x4 tr_read(int vb) {
  s16x4 r; asm volatile("ds_read_b64_tr_b16 %0, %1 offset:%2" : "=&v"(r) : "v"(vb), "i"(OFF) : "memory"); return r;
}
template <int D0> __device__ __forceinline__ void pv_one(f32x16& od, int vb, bf16x8 pa0, bf16x8 pa1, bf16x8 pa2, bf16x8 pa3) {
  const s16x4 l0 = tr_read<v_rd_off(D0, 0, 0)>(vb), h0 = tr_read<v_rd_off(D0, 0, 1)>(vb), l1 = tr_read<v_rd_off(D0, 1, 0)>(vb), h1 = tr_read<v_rd_off(D0, 1, 1)>(vb);
  const s16x4 l2 = tr_read<v_rd_off(D0, 2, 0)>(vb), h2 = tr_read<v_rd_off(D0, 2, 1)>(vb), l3 = tr_read<v_rd_off(D0, 3, 0)>(vb), h3 = tr_read<v_rd_off(D0, 3, 1)>(vb);
  asm volatile("s_waitcnt lgkmcnt(0)" ::: "memory"); NA_SBAR();
#define NA_PK(L, H) (bf16x8){L[0], L[1], L[2], L[3], H[0], H[1], H[2], H[3]}
  od = __builtin_amdgcn_mfma_f32_32x32x16_bf16(pa0, NA_PK(l0, h0), od, 0, 0, 0);
  od = __builtin_amdgcn_mfma_f32_32x32x16_bf16(pa1, NA_PK(l1, h1), od, 0, 0, 0);
  od = __builtin_amdgcn_mfma_f32_32x32x16_bf16(pa2, NA_PK(l2, h2), od, 0, 0, 0);
  od = __builtin_amdgcn_mfma_f32_32x32x16_bf16(pa3, NA_PK(l3, h3), od, 0, 0, 0);
#undef NA_PK
}
__device__ __forceinline__ void pv_d0(f32x16* o, int vb, bf16x8 pa0, bf16x8 pa1, bf16x8 pa2, bf16x8 pa3) {
  pv_one<0>(o[0], vb, pa0, pa1, pa2, pa3); pv_one<1>(o[1], vb, pa0, pa1, pa2, pa3); pv_one<2>(o[2], vb, pa0, pa1, pa2, pa3); pv_one<3>(o[3], vb, pa0, pa1, pa2, pa3);
}

__device__ __forceinline__ void init_scores(f32x16& p0, f32x16& p1, int j, int klo, int qrow, const float* bt_l, const float* pen_l) {
  if (j < 4) { p0 = f32x16{}; p1 = f32x16{}; return; }
  const int kr = klo + j - 4, rs = min(max(qrow - 4, 0), 56);
  if (kr < rs || kr >= rs + 8) {
#pragma unroll
    for (int r = 0; r < 16; ++r) { p0[r] = NEG; p1[r] = NEG; }
    return;
  }
  int zo; asm volatile("v_mov_b32 %0, 0" : "=v"(zo));
  const float* bl = bt_l + (kr - qrow + 7) * 32; pen_l += zo;
#pragma unroll
  for (int r = 0; r < 16; ++r) { const int c = (r & 3) + 8 * (r >> 2); p0[r] = bl[c] + pen_l[c]; p1[r] = bl[32 + c] + pen_l[32 + c]; }
}

template <int LDP, int LDO>
__device__ __forceinline__ void na_unit(const bf16* __restrict__ P, int qcol, int kcol, int vcol, long qrow0, long crow0, long brow0, int nband, int klo, int qg0,
                                        bf16* __restrict__ O, int ocol, const float* __restrict__ rpbh, char* lds, const int tid) {
  const int wid = tid >> 6, lane = tid & 63, r32 = lane & 31, hi = lane >> 5;
  bf16* V_lds = (bf16*)lds; bf16* K_lds = (bf16*)(lds + 2 * SHM_V);
  float* ws = (float*)(lds + 2 * SHM_V + 2 * SHM_K) + wid * 64; float* li_l = ws; float* al_l = ws + 32;
  float* blds = (float*)(lds + BIAS_OFF); float* pens = (float*)(lds + PEN_OFF);
  __syncthreads();
  if (nband > 0) {
    for (int i = tid; i < 640; i += 512) { const int t2 = i - 64, dri = t2 >> 5, dci = t2 & 31; blds[i] = (t2 >= 0 && t2 < 480 && dci < 31) ? rpbh[dri * 31 + dci] * (1.0f / SCALE) : 0.f; }
    if (tid < 128) pens[tid] = (tid >= 48 && tid < 64) ? 0.f : NEG;
  }
  float m_reg = -1e30f, l_reg = 0; f32x16 o[4] = {};
  bf16x8* qs = (bf16x8*)(lds + QS_OFF + wid * 8192) + lane;
  { const bf16* Qw = P + (qrow0 + wid * QBLK + r32) * LDP + qcol + hi * 8;
#pragma unroll
    for (int d0 = 0; d0 < 8; ++d0) qs[d0 * 64] = *reinterpret_cast<const bf16x8*>(Qw + d0 * 16); }
  const int sr = tid >> 4, sc = (tid & 15) * 8, vst0 = v_st(sr, sc), vst1 = v_st(32 + sr, sc);
  const int vb0 = (int)(uintptr_t)V_lds + v_rd_base(lane);
  const int qrow = qg0 + (wid >> 1), qc = (wid & 1) * 32 + r32;
  const float* bt_l = blds + 64 + 15 - qc + 4 * hi; const float* pen_l = pens + 48 - min(max(qc - 8, 0), 48) + 4 * hi;
  const bf16* Kh = P + kcol; const bf16* Vh = P + vcol;
  bf16x8 vs0, vs1, ks0, ks1;
#define NA_TROW(j) ((j) < 4 ? crow0 + (long)(j) * 64 : brow0 + (long)((j) - 4) * 64)
#define NA_SLOAD(j) do { const long _k0 = NA_TROW(j); vs0 = *reinterpret_cast<const bf16x8*>(&Vh[(_k0 + sr) * LDP + sc]); vs1 = *reinterpret_cast<const bf16x8*>(&Vh[(_k0 + 32 + sr) * LDP + sc]); \
    ks0 = *reinterpret_cast<const bf16x8*>(&Kh[(_k0 + sr) * LDP + sc]); ks1 = *reinterpret_cast<const bf16x8*>(&Kh[(_k0 + 32 + sr) * LDP + sc]); } while (0)
#define NA_SWRITE(b) do { *(bf16x8*)((char*)V_lds + (b) * SHM_V + vst0) = vs0; *(bf16x8*)((char*)V_lds + (b) * SHM_V + vst1) = vs1; const int kc = sc * 2; \
    *(bf16x8*)((char*)K_lds + (b) * SHM_K + NA_KSWZ(sr, kc)) = ks0; *(bf16x8*)((char*)K_lds + (b) * SHM_K + NA_KSWZ(32 + sr, kc)) = ks1; } while (0)
#define NA_RESC(a) do { if (__any((a) < 1.f)) { if (hi == 0) al_l[r32] = (a); asm volatile("s_waitcnt lgkmcnt(0)" ::: "memory"); \
    _Pragma("unroll") for (int d = 0; d < 4; ++d) _Pragma("unroll") for (int r = 0; r < 16; ++r) o[d][r] *= al_l[crow(r, hi)]; } } while (0)
  f32x16 p0, p1; float mn, al; bf16x8 pa0, pa1, pa2, pa3; const int NT = 4 + nband; const int rs_ = min(max(qrow - 4, 0), 56);
  NA_SLOAD(0);
  for (int j = 0; j < NT; ++j) {
    const int b = j & 1;
    NA_SWRITE(b);
    if (j + 1 < NT) NA_SLOAD(j + 1);
    __syncthreads();
    const int kr_ = klo + j - 4;
    if (j < 4 || (kr_ >= rs_ && kr_ < rs_ + 8)) {
      init_scores(p0, p1, j, klo, qrow, bt_l, pen_l);
      qkt(p0, p1, (const bf16*)((const char*)K_lds + b * SHM_K), qs, r32, hi);
      partialSM(p0, p1, m_reg, mn, al);
      NA_RESC(al);
      finishSM(p0, p1, al, l_reg, pa0, pa1, pa2, pa3); NA_SBAR();
      pv_d0(o, vb0 + b * (int)SHM_V, pa0, pa1, pa2, pa3);
    }
  }
  if (hi == 0) li_l[r32] = l_reg; asm volatile("s_waitcnt lgkmcnt(0)" ::: "memory");
  float rli[16];
#pragma unroll
  for (int r = 0; r < 16; ++r) rli[r] = __builtin_amdgcn_rcpf(li_l[crow(r, hi)]);
  bf16* Ow = O + (qrow0 + wid * QBLK) * LDO + ocol;
#pragma unroll
  for (int r = 0; r < 16; ++r) { const int orow = crow(r, hi);
#pragma unroll
    for (int d0 = 0; d0 < 4; ++d0) { const float v = o[d0][r] * rli[r]; Ow[(long)orow * LDO + d0 * 32 + r32] = (bf16)pg8::f2bfc(v); } }
#undef NA_TROW
#undef NA_SLOAD
#undef NA_SWRITE
#undef NA_RESC
}
}

constexpr int NWAVES = 8;
constexpr int D = 2048, NBATCH = 4, SEQ = 4096, MLAT = NBATCH * SEQ, CTXL = 256, MCTX = NBATCH * CTXL, MR = MLAT + MCTX;
#ifndef PADF
#define PADF 128
#endif
constexpr int DFF = 5632, DUP = 2 * DFF, DIN = 6176, DINP = 6400, DEPTH = 4, LDF = DFF + PADF;
constexpr int MODW = 6 * D;
constexpr float EPS = 1e-6f;
constexpr int C_QA = 0, C_KA = 1024, C_VA = 2048, C_QB = 3072, C_KB = 3584, C_VB = 4096, C_GB = 5120, C_AB = 6144;

constexpr size_t MiB = 1u << 20;
constexpr size_t WS_CTL = 0, CTL_ZERO_BYTES = 32768;
constexpr size_t WS_MOD = 1 * MiB;
constexpr size_t WS_ROPE = WS_MOD + (size_t)DEPTH * 5 * MODW * 4;
constexpr size_t WS_WIN = 2 * MiB;
constexpr size_t WS_WOUT = WS_WIN + (size_t)2 * DINP * D * 2;
constexpr size_t WS_WPOOL = WS_WOUT + (size_t)2 * D * D * 2;
constexpr size_t WS_WUP = WS_WPOOL + (size_t)2 * 4 * 512 * 512 * 2;
constexpr size_t WS_WDOWN = WS_WUP + (size_t)DEPTH * DUP * D * 2;
constexpr size_t WS_XR = WS_WDOWN + (size_t)DEPTH * D * LDF * 2;
constexpr size_t WS_X16 = WS_XR;
constexpr size_t WS_PART = WS_XR + (size_t)MLAT * D * 2;
constexpr size_t WS_H = WS_XR + (size_t)MR * D * 4;
constexpr size_t WS_MIX = WS_H + (size_t)MR * D * 2;
constexpr size_t WS_BIG = WS_MIX + (size_t)MR * D * 2;
constexpr size_t WS_U = WS_BIG;
constexpr size_t WS_ACT = WS_U + (size_t)MR * DUP * 2;
constexpr size_t WS_P = WS_BIG;
constexpr size_t WS_QF = WS_P + (size_t)MR * DINP * 2;
constexpr size_t WS_KF = WS_QF + (size_t)MR * 512 * 2;
constexpr size_t WS_QB = WS_KF + (size_t)MR * 512 * 2;
constexpr size_t WS_KB = WS_QB + (size_t)MR * 512 * 2;
constexpr size_t WS_KHT = WS_KB + (size_t)MR * 512 * 2;
constexpr size_t WS_AL = WS_KHT + (size_t)2 * MR * 512 * 2;
constexpr size_t WS_UT = WS_AL + (size_t)2 * (MR / 64) * 512 * 4;
constexpr size_t WS_ST = WS_UT + (size_t)64 * 68 * 8192 * 2;
constexpr size_t WS_MIXEND = WS_ST + (size_t)64 * 68 * 8192 * 2;
constexpr size_t WS_SB = WS_ACT + (size_t)MR * LDF * 2;
constexpr size_t WS_END = WS_SB + (size_t)(MR / 256) * 2 * 3 * DFF * 4;
static_assert(WS_MIXEND <= WS_END, "even-mixer view fits inside the FFN view");
static_assert(WS_ROPE + 2 * 64 * 16 * 4 <= WS_WIN, "small tables fit below the weights");
constexpr int CW_BAR = 4096;

constexpr int RING_OFF = 0, RING_BYTES = 143360;
constexpr int LDSCTL_OFF = RING_BYTES, MISC_OFF = LDSCTL_OFF + 320;
constexpr int LDS_BYTES = 147456;
static_assert(na::LDS_END <= RING_BYTES, "attention LDS fits the ring");

#define GAS __attribute__((address_space(1)))
#define LAS __attribute__((address_space(3)))
typedef unsigned short bf16;
typedef unsigned v4u __attribute__((ext_vector_type(4)));
typedef unsigned v2u __attribute__((ext_vector_type(2)));
typedef float f32x4 __attribute__((ext_vector_type(4)));
#define LDS_WAIT() asm volatile("s_waitcnt lgkmcnt(0)" ::: "memory")
__device__ __forceinline__ unsigned f2bf(float f) { return pg8::f2bfc(f); }
__device__ __forceinline__ unsigned pk2(float lo, float hi) { return pg8::pkc(lo, hi); }
__device__ __forceinline__ unsigned pk2h(float lo, float hi) { return pg8::cvt_pk_bf16(lo, hi); }
__device__ __forceinline__ float bflo(unsigned w) { return __builtin_bit_cast(float, w << 16); }
__device__ __forceinline__ float bfhi(unsigned w) { return __builtin_bit_cast(float, w & 0xffff0000u); }
__device__ __forceinline__ float bf2f(bf16 b) { return __builtin_bit_cast(float, (unsigned)b << 16); }

#define XB_TMO      128
#define XB_XCNT(j)  (256  + 64 * (j))
#define XB_XSUB(j)  (1280 + 64 * (j))
#define XB_XGEN(j)  (2304 + 64 * (j))
#define XB_TOP      3328
#define XB_TOPGEN   3392
#define XCD_BAR_WORDS 3456
#define XB_SPIN_CAP (1u << 18)
__device__ __forceinline__ unsigned xb_ld(unsigned* p)              { return __hip_atomic_load(p, __ATOMIC_RELAXED, __HIP_MEMORY_SCOPE_AGENT); }
__device__ __forceinline__ unsigned xb_add(unsigned* p, unsigned v) { return __hip_atomic_fetch_add(p, v, __ATOMIC_RELAXED, __HIP_MEMORY_SCOPE_AGENT); }
__device__ __forceinline__ unsigned xb_xcc_id() { return (unsigned)__builtin_amdgcn_s_getreg((3 << 11) | 20) & 0xFu; }
#define XB_SPIN(cond, bar) do { unsigned _sp = 0; while (cond) { __builtin_amdgcn_s_sleep(1); \
    if ((++_sp & 255u) == 0u) { if (xb_ld(&(bar)[XB_TMO])) break; if (_sp > XB_SPIN_CAP) { atomicAdd(&(bar)[XB_TMO], 1u); break; } } } } while (0)
struct XcdBarrier { unsigned* bar; unsigned x; volatile LAS unsigned* st; };
__device__ __forceinline__ XcdBarrier xcd_barrier_post(unsigned* bar, volatile LAS unsigned* st) {
    XcdBarrier b; b.bar = bar; b.x = xb_xcc_id(); b.st = st;
    if (threadIdx.x == 0) (void)xb_add(&bar[XB_XCNT(b.x)], 1u);
    return b;
}
__device__ __forceinline__ void xcd_barrier_complete(unsigned* bar, unsigned x, unsigned& nloc, unsigned& nx) {
    const unsigned G = gridDim.x * gridDim.y * gridDim.z;
    unsigned sum, cnt, mine, sp = 0u;
    for (;;) {
        sum = 0u; cnt = 0u; mine = 0u;
#pragma unroll
        for (unsigned j = 0; j < 16; ++j) { const unsigned c = xb_ld(&bar[XB_XCNT(j)]); sum += c; cnt += (c > 0u) ? 1u : 0u; mine = (j == x) ? c : mine; }
        if (sum == G) break;
        __builtin_amdgcn_s_sleep(1);
        if ((++sp & 255u) == 0u) { if (xb_ld(&bar[XB_TMO])) break; if (sp > XB_SPIN_CAP) { atomicAdd(&bar[XB_TMO], 1u); break; } }
    }
    nloc = mine > 0u ? mine : 1u; nx = cnt > 0u ? cnt : 1u;
}
__device__ __forceinline__ void xcd_barrier(const XcdBarrier& b) {
    asm volatile("s_waitcnt vmcnt(0)" ::: "memory");
    __syncthreads();
    if (threadIdx.x == 0) {
        unsigned* bar = b.bar;
        __builtin_amdgcn_s_waitcnt(0);
        unsigned nloc = b.st[0], nx = b.st[1];
        if (nloc == 0u) { xcd_barrier_complete(bar, b.x, nloc, nx); b.st[0] = nloc; b.st[1] = nx; }
        const unsigned old = xb_add(&bar[XB_XSUB(b.x)], 1u);
        const unsigned gen = old / nloc;
        if (old + 1u == (gen + 1u) * nloc) {
            __builtin_amdgcn_fence(__ATOMIC_RELEASE, "agent");
            asm volatile("s_waitcnt vmcnt(0)" ::: "memory");
            const unsigned og = xb_add(&bar[XB_TOP], 1u);
            const unsigned tg = og / nx;
            if (og + 1u == (tg + 1u) * nx) xb_add(&bar[XB_TOPGEN], 1u);
            else XB_SPIN(xb_ld(&bar[XB_TOPGEN]) == tg, bar);
            __builtin_amdgcn_fence(__ATOMIC_ACQUIRE, "agent");
            xb_add(&bar[XB_XGEN(b.x)], 1u);
            asm volatile("s_waitcnt vmcnt(0)" ::: "memory");
        } else {
            XB_SPIN(xb_ld(&bar[XB_XGEN(b.x)]) == gen, bar);
            __builtin_amdgcn_fence(__ATOMIC_ACQUIRE, "agent");
            asm volatile("s_waitcnt vmcnt(0)" ::: "memory");
        }
    }
    __syncthreads();
}

struct Args { const float* in[21]; float* out; unsigned char* ws; int ph_lo, ph_hi; };
static_assert(sizeof(Args) == 23 * 8 + 8, "Args has no padding bytes");
typedef const __attribute__((address_space(4))) Args* KArgs;
enum { I_X = 0, I_C, I_CTX, I_CCTX, I_WMOD, I_BMOD, I_N1G, I_N2G, I_WIN, I_WG2, I_BG, I_RPB, I_GLAG, I_WOUT, I_POOLW, I_POOLS, I_WUP, I_CONVW, I_CONVB, I_WDOWN, I_FING };
struct Frame {
    LAS unsigned char* lds; unsigned char* ldsg;
    volatile LAS unsigned* MISC;
    int tid, lane, wave, vcu, G;
    KArgs ka; unsigned char* ws;
};
__device__ __forceinline__ float wave_sum(float v) {
#pragma unroll
    for (int o = 1; o < 64; o <<= 1) v += __shfl_xor(v, o);
    return v;
}

__device__ __forceinline__ void p0_transpose_item(const float* W, int K, int N, bf16* WT, LAS float* scr, int item, int lane, int ldt = 0) {
    if (ldt == 0) ldt = K;
    const int nblk = N / 32, kb = item / nblk, nb = item % nblk, k0 = 64 * kb, n0 = 32 * nb;
#pragma unroll 8
    for (int i = 0; i < 32; ++i) { const int kk = 2 * i + (lane >> 5); scr[kk * 33 + (lane & 31)] = W[(size_t)(k0 + kk) * N + n0 + (lane & 31)]; }
    LDS_WAIT(); asm volatile("" ::: "memory");
    const int c = lane & 7;
#pragma unroll
    for (int j = 0; j < 4; ++j) { const int n = (lane >> 3) + 8 * j; const LAS float* s = scr + (8 * c) * 33 + n;
        v4u o; o.x = pk2(s[0 * 33], s[1 * 33]); o.y = pk2(s[2 * 33], s[3 * 33]); o.z = pk2(s[4 * 33], s[5 * 33]); o.w = pk2(s[6 * 33], s[7 * 33]);
        *(GAS v4u*)(WT + (size_t)(n0 + n) * ldt + k0 + 8 * c) = o; }
    LDS_WAIT(); asm volatile("" ::: "memory");
}
__device__ __forceinline__ void p0_transpose_item_up(const float* W, bf16* WT, LAS float* scr, int item, int lane) {
    constexpr int K = D, N = DUP;
    const int nblk = N / 32, kb = item / nblk, nb = item % nblk, k0 = 64 * kb, n0 = 32 * nb;
    const int isg = n0 >= DFF, c0 = isg ? n0 - DFF : n0, d0 = 256 * (c0 >> 7) + (isg ? 128 : 0) + (c0 & 127);
#pragma unroll 8
    for (int i = 0; i < 32; ++i) { const int kk = 2 * i + (lane >> 5); scr[kk * 33 + (lane & 31)] = W[(size_t)(k0 + kk) * N + n0 + (lane & 31)]; }
    LDS_WAIT(); asm volatile("" ::: "memory");
    const int c = lane & 7;
#pragma unroll
    for (int j = 0; j < 4; ++j) { const int n = (lane >> 3) + 8 * j; const LAS float* s = scr + (8 * c) * 33 + n;
        v4u o; o.x = pk2(s[0 * 33], s[1 * 33]); o.y = pk2(s[2 * 33], s[3 * 33]); o.z = pk2(s[4 * 33], s[5 * 33]); o.w = pk2(s[6 * 33], s[7 * 33]);
        *(GAS v4u*)(WT + (size_t)(d0 + n) * K + k0 + 8 * c) = o; }
    LDS_WAIT(); asm volatile("" ::: "memory");
}
__device__ __forceinline__ void ph_prologue(Frame& F) {
    const int gw = F.vcu * NWAVES + F.wave, NGW = F.G * NWAVES;
    const int gt = F.vcu * NWAVES * 64 + F.tid, NGT = F.G * NWAVES * 64;
    {
        LAS float* scr = (LAS float*)(F.lds + RING_OFF + F.wave * 16384);
        constexpr int I_IN = (D / 64) * (DIN / 32), I_OUT = (D / 64) * (D / 32), I_POOL = (512 / 64) * (512 / 32), I_UP = (D / 64) * (DUP / 32), I_DOWN = (DFF / 64) * (D / 32);
        constexpr int NITEMS = 2 * I_IN + 2 * I_OUT + 8 * I_POOL + 4 * I_UP + 4 * I_DOWN;
        bf16* WIN = (bf16*)(F.ws + WS_WIN); bf16* WOUT = (bf16*)(F.ws + WS_WOUT); bf16* WPOOL = (bf16*)(F.ws + WS_WPOOL); bf16* WUP = (bf16*)(F.ws + WS_WUP); bf16* WDOWN = (bf16*)(F.ws + WS_WDOWN);
        for (int it = gw; it < NITEMS; it += NGW) {
            int r = it;
            if (r < 4 * I_UP) { const int l = r / I_UP; p0_transpose_item_up((F.ka->in[I_WUP]) + (size_t)l * D * DUP, WUP + (size_t)l * DUP * D, scr, r % I_UP, F.lane); continue; } r -= 4 * I_UP;
            if (r < 4 * I_DOWN) { const int l = r / I_DOWN; p0_transpose_item((F.ka->in[I_WDOWN]) + (size_t)l * DFF * D, DFF, D, WDOWN + (size_t)l * D * LDF, scr, r % I_DOWN, F.lane, LDF); continue; } r -= 4 * I_DOWN;
            if (r < 2 * I_IN) { const int l = r / I_IN; p0_transpose_item((F.ka->in[I_WIN]) + (size_t)l * D * DIN, D, DIN, WIN + (size_t)l * DINP * D, scr, r % I_IN, F.lane); continue; } r -= 2 * I_IN;
            if (r < 2 * I_OUT) { const int l = r / I_OUT; p0_transpose_item((F.ka->in[I_WOUT]) + (size_t)l * D * D, D, D, WOUT + (size_t)l * D * D, scr, r % I_OUT, F.lane); continue; } r -= 2 * I_OUT;
            { const int l = r / I_POOL; p0_transpose_item((F.ka->in[I_POOLW]) + (size_t)l * 512 * 512, 512, 512, WPOOL + (size_t)l * 512 * 512, scr, r % I_POOL, F.lane); }
        }
        constexpr int ZV = (DINP - DIN) * D / 8;
        for (int i = gt; i < 2 * ZV; i += NGT) { const int l = i / ZV, j = i % ZV; *(GAS v4u*)(WIN + (size_t)l * DINP * D + (size_t)DIN * D + (size_t)j * 8) = (v4u){0u, 0u, 0u, 0u}; }
    }
    if (blockIdx.x == 0) {
        float* rc = (float*)(F.ws + WS_ROPE); float* rs = rc + 64 * 16;
        for (int i = F.tid; i < 64 * 16; i += NWAVES * 64) { const int pos = i >> 4, f = i & 15; const float inv = powf(10000.0f, -(float)f / 16.0f); const float ang = (float)pos * inv; rc[i] = cosf(ang); rs[i] = sinf(ang); }
    }
    __syncthreads();
    {
        LAS float* S = (LAS float*)(F.lds + RING_OFF);
        LAS float* RED = (LAS float*)(F.lds + RING_OFF + 40960);
        float* MOD = (float*)(F.ws + WS_MOD);
        constexpr int NTASK = DEPTH * (MODW / 256);
        if ((int)blockIdx.x < NTASK) {
            for (int i = F.tid; i < 5 * D; i += NWAVES * 64) { const int r = i / D, k = i % D; const float v = r < 4 ? (F.ka->in[I_C])[r * D + k] : (F.ka->in[I_CCTX])[k]; S[i] = v / (1.0f + __expf(-v)); }
            __syncthreads();
            for (int t = blockIdx.x; t < NTASK; t += F.G) {
                const int l = t / (MODW / 256), n0 = (t % (MODW / 256)) * 256, k0 = F.wave * 256;
                float acc[5][4];
#pragma unroll
                for (int r = 0; r < 5; ++r)
#pragma unroll
                    for (int cc = 0; cc < 4; ++cc) acc[r][cc] = 0.f;
                const float* Wp = (F.ka->in[I_WMOD]) + ((size_t)l * D + k0) * MODW + n0 + 4 * F.lane;
                for (int kk = 0; kk < 256; kk += 8) {
                    f32x4 wv[8];
#pragma unroll
                    for (int u = 0; u < 8; ++u) wv[u] = *(const f32x4*)(Wp + (size_t)(kk + u) * MODW);
#pragma unroll
                    for (int u = 0; u < 8; ++u)
#pragma unroll
                        for (int r = 0; r < 5; ++r) { const float s = S[r * D + k0 + kk + u];
#pragma unroll
                            for (int cc = 0; cc < 4; ++cc) acc[r][cc] = fmaf(s, wv[u][cc], acc[r][cc]); }
                }
#pragma unroll
                for (int r = 0; r < 5; ++r)
#pragma unroll
                    for (int cc = 0; cc < 4; ++cc) RED[(F.wave * 5 + r) * 256 + 4 * F.lane + cc] = acc[r][cc];
                __syncthreads();
                for (int o = F.tid; o < 5 * 256; o += NWAVES * 64) { const int r = o >> 8, ci = o & 255; float s = (F.ka->in[I_BMOD])[l * MODW + n0 + ci];
#pragma unroll
                    for (int w = 0; w < 8; ++w) s += RED[(w * 5 + r) * 256 + ci];
                    MOD[((size_t)l * 5 + r) * MODW + n0 + ci] = s; }
                __syncthreads();
            }
        }
    }
}

__device__ __forceinline__ f32x4 bf4_unpack(v2u h) { f32x4 r; r.x = pg8::h_lo(h.x); r.y = pg8::h_hi(h.x); r.z = pg8::h_lo(h.y); r.w = pg8::h_hi(h.y); return r; }
template <bool L16, bool CPY, bool CI>
__device__ __forceinline__ void norm_rows(Frame& F, const int ra, const int rb, const void* src, const int rbase, const float* g, const float* modl, const int off_sh, const int off_sc, const int nparts) {
    if (ra >= rb) return;
    bf16* H = (bf16*)(F.ws + WS_H);
    f32x4 gm[8], sh[8]; int cb = -1;
    f32x4 v[8], w[8]; v2u hv[8], hw[8];
#define NORM_P32(m) ((const f32x4*)((const float*)src + (size_t)((m) - rbase) * D) + F.lane)
#define NORM_P16(m) ((const v2u*)((const bf16*)src + (size_t)((m) - rbase) * D) + F.lane)
    if constexpr (L16) { const v2u* xr = NORM_P16(ra);
#pragma unroll
        for (int j = 0; j < 8; ++j) hv[j] = xr[64 * j];
    } else { const f32x4* xr = NORM_P32(ra);
#pragma unroll
        for (int j = 0; j < 8; ++j) v[j] = xr[64 * j]; }
    for (int m = ra; m < rb; ++m) {
        if (m + 1 < rb) {
            if constexpr (L16) { const v2u* xn = NORM_P16(m + 1);
#pragma unroll
                for (int j = 0; j < 8; ++j) hw[j] = xn[64 * j];
            } else { const f32x4* xn = NORM_P32(m + 1);
#pragma unroll
                for (int j = 0; j < 8; ++j) w[j] = xn[64 * j]; } }
        const int bidx = m < MLAT ? (m >> 12) : 4;
        if (bidx != cb) { cb = bidx;
            const f32x4* gp = (const f32x4*)g + F.lane; const f32x4* shp = (const f32x4*)(modl + (size_t)bidx * MODW + off_sh) + F.lane; const f32x4* scp = (const f32x4*)(modl + (size_t)bidx * MODW + off_sc) + F.lane;
#pragma unroll
            for (int j = 0; j < 8; ++j) { gm[j] = gp[64 * j] * (scp[64 * j] + 1.0f); sh[j] = shp[64 * j]; } }
        if constexpr (L16) {
#pragma unroll
            for (int j = 0; j < 8; ++j) v[j] = bf4_unpack(hv[j]); }
        if constexpr (CI) {
            for (int k = 0; k < nparts; ++k) { const f32x4* pp = (const f32x4*)((const float*)(F.ws + WS_PART) + ((size_t)k * MCTX + (size_t)(m - rbase)) * D) + F.lane;
#pragma unroll
                for (int j = 0; j < 8; ++j) v[j] = v[j] + pp[64 * j]; }
            f32x4* xw = (f32x4*)((float*)(F.ws + WS_XR) + (size_t)m * D) + F.lane;
#pragma unroll
            for (int j = 0; j < 8; ++j) xw[64 * j] = v[j]; }
        float s = 0.f;
#pragma unroll
        for (int j = 0; j < 8; ++j) s += (v[j].x * v[j].x + v[j].y * v[j].y) + (v[j].z * v[j].z + v[j].w * v[j].w);
        const float r = 1.0f / sqrtf(wave_sum(s) * (1.0f / D) + EPS);
        v2u* o8 = (v2u*)(H + (size_t)m * D) + F.lane;
#pragma unroll
        for (int j = 0; j < 8; ++j) { const f32x4 y = v[j] * r * gm[j] + sh[j]; v2u ww; ww.x = pk2h(y.x, y.y); ww.y = pk2h(y.z, y.w); o8[64 * j] = ww; }
        if constexpr (CPY) { v2u* c8 = (v2u*)((bf16*)(F.ws + WS_X16) + (size_t)m * D) + F.lane;
#pragma unroll
            for (int j = 0; j < 8; ++j) { v2u ww; ww.x = pg8::pk_h2(v[j].x, v[j].y); ww.y = pg8::pk_h2(v[j].z, v[j].w); c8[64 * j] = ww; } }
        if constexpr (L16) {
#pragma unroll
            for (int j = 0; j < 8; ++j) hv[j] = hw[j];
        } else {
#pragma unroll
            for (int j = 0; j < 8; ++j) v[j] = w[j]; }
    }
#undef NORM_P32
#undef NORM_P16
}
__device__ __forceinline__ void ph_norm(Frame& F, int nrows, const float* xl32, const float* xc, const float* g, const float* modl, int off_sh, int off_sc, int nparts) {
    const int gw = F.vcu * NWAVES + F.wave; int NGW = F.G * NWAVES; asm volatile("" : "+s"(NGW));
    const int nctx = nrows - MLAT;
    const int r0 = (int)((unsigned)gw * (unsigned)MLAT / (unsigned)NGW), r1 = (int)((unsigned)(gw + 1) * (unsigned)MLAT / (unsigned)NGW);
    const int c0 = MLAT + (int)((unsigned)gw * (unsigned)nctx / (unsigned)NGW), c1 = MLAT + (int)((unsigned)(gw + 1) * (unsigned)nctx / (unsigned)NGW);
    if (xl32) { norm_rows<false, true, false>(F, r0, r1, xl32, 0, g, modl, off_sh, off_sc, 0); norm_rows<false, false, false>(F, c0, c1, xc, MLAT, g, modl, off_sh, off_sc, 0); }
    else      { norm_rows<true, false, false>(F, r0, r1, F.ws + WS_X16, 0, g, modl, off_sh, off_sc, 0); norm_rows<false, false, true>(F, c0, c1, xc, MLAT, g, modl, off_sh, off_sc, nparts); }
}
__device__ __forceinline__ void ph_final(Frame& F) {
    const int gw = F.vcu * NWAVES + F.wave, NGW = F.G * NWAVES;
    const bf16* X16 = (const bf16*)(F.ws + WS_X16);
    const int r0 = (int)((long)gw * MLAT / NGW), r1 = (int)((long)(gw + 1) * MLAT / NGW);
    if (r0 >= r1) return;
    f32x4 gf[8], v[8]; v2u hv[8], hw[8];
    { const f32x4* gp = (const f32x4*)(F.ka->in[I_FING]) + F.lane; const v2u* xr = (const v2u*)(X16 + (size_t)r0 * D) + F.lane;
#pragma unroll
      for (int j = 0; j < 8; ++j) { gf[j] = gp[64 * j]; hv[j] = xr[64 * j]; } }
    for (int m = r0; m < r1; ++m) {
        if (m + 1 < r1) { const v2u* xn = (const v2u*)(X16 + (size_t)(m + 1) * D) + F.lane;
#pragma unroll
            for (int j = 0; j < 8; ++j) hw[j] = xn[64 * j]; }
#pragma unroll
        for (int j = 0; j < 8; ++j) v[j] = bf4_unpack(hv[j]);
        float s = 0.f;
#pragma unroll
        for (int j = 0; j < 8; ++j) s += (v[j].x * v[j].x + v[j].y * v[j].y) + (v[j].z * v[j].z + v[j].w * v[j].w);
        const float r = 1.0f / sqrtf(wave_sum(s) * (1.0f / D) + EPS);
        f32x4* op = (f32x4*)((F.ka->out) + (size_t)m * D) + F.lane;
#pragma unroll
        for (int j = 0; j < 8; ++j) __builtin_nontemporal_store(v[j] * r * gf[j], op + 64 * j);
#pragma unroll
        for (int j = 0; j < 8; ++j) hv[j] = hw[j];
    }
}
template <int HW>
__device__ __forceinline__ void pool_strip(const bf16* H, bf16* HP, int m0, int t0, int L, int c8) {
    constexpr int NR = 8 + 2 * HW - 1;
    v4u R[NR];
#pragma unroll
    for (int j = 0; j < NR; ++j) { const int tr = t0 - HW + j; R[j] = (v4u){0u, 0u, 0u, 0u}; if (tr >= 0 && tr < L) R[j] = *(const v4u*)(H + (size_t)(m0 - HW + j) * D + c8); }
    float s[8];
#pragma unroll
    for (int e = 0; e < 8; ++e) s[e] = 0.f;
#pragma unroll
    for (int j = 0; j < 2 * HW; ++j) { s[0] += bflo(R[j].x); s[1] += bfhi(R[j].x); s[2] += bflo(R[j].y); s[3] += bfhi(R[j].y); s[4] += bflo(R[j].z); s[5] += bfhi(R[j].z); s[6] += bflo(R[j].w); s[7] += bfhi(R[j].w); }
#pragma unroll
    for (int r = 0; r < 8; ++r) {
        const int t = t0 + r; const float inv = 1.0f / (float)(min(t + HW, L) - max(t - HW, 0));
        const v4u w = R[r + HW];
        v4u o; o.x = pk2h(s[0] * inv - bflo(w.x), s[1] * inv - bfhi(w.x)); o.y = pk2h(s[2] * inv - bflo(w.y), s[3] * inv - bfhi(w.y));
        o.z = pk2h(s[4] * inv - bflo(w.z), s[5] * inv - bfhi(w.z)); o.w = pk2h(s[6] * inv - bflo(w.w), s[7] * inv - bfhi(w.w));
        *(v4u*)(HP + (size_t)(m0 + r) * D + c8) = o;
        if (r < 7) { const v4u a = R[r + 2 * HW], b = R[r];
            s[0] += bflo(a.x) - bflo(b.x); s[1] += bfhi(a.x) - bfhi(b.x); s[2] += bflo(a.y) - bflo(b.y); s[3] += bfhi(a.y) - bfhi(b.y);
            s[4] += bflo(a.z) - bflo(b.z); s[5] += bfhi(a.z) - bfhi(b.z); s[6] += bflo(a.w) - bflo(b.w); s[7] += bfhi(a.w) - bfhi(b.w); }
    }
}
__device__ __forceinline__ void ph_pool(Frame& F, int nrows) {
    const int gt = F.vcu * NWAVES * 64 + F.tid, NGT = F.G * NWAVES * 64;
    const bf16* H = (const bf16*)(F.ws + WS_H); bf16* HP = (bf16*)(F.ws + WS_MIX);
    const int nitems = (nrows / 8) * (D / 8);
    for (int it = gt; it < nitems; it += NGT) {
        const int strip = it >> 8, c8 = (it & 255) * 8, gi = __builtin_amdgcn_readfirstlane(c8 >> 9), m0 = strip * 8;
        int t0, L;
        if (m0 < MLAT) { t0 = m0 & (SEQ - 1); L = SEQ; } else { t0 = (m0 - MLAT) & (CTXL - 1); L = CTXL; }
        if (gi == 0) pool_strip<1>(H, HP, m0, t0, L, c8); else if (gi == 1) pool_strip<2>(H, HP, m0, t0, L, c8); else if (gi == 2) pool_strip<4>(H, HP, m0, t0, L, c8); else pool_strip<8>(H, HP, m0, t0, L, c8);
    }
}
__device__ __forceinline__ void ph_glufix(Frame& F, int nrows, const float* cw, const float* cb) {
    const int gt = F.vcu * NWAVES * 64 + F.tid, NGT = F.G * NWAVES * 64;
    const float* SB = (const float*)(F.ws + WS_SB); bf16* ACT = (bf16*)(F.ws + WS_ACT);
    constexpr int C4 = DFF / 4;
    const int nitems = (nrows / 256) * 2 * C4;
    for (int it = gt; it < nitems; it += NGT) {
        const int c4 = (it % C4) * 4, pw = it / C4, which = pw & 1, pm = pw >> 1, row = 256 * pm + (which ? 255 : 0);
        int t, L;
        if (row < MLAT) { t = row & (SEQ - 1); L = SEQ; } else { t = (row - MLAT) & (CTXL - 1); L = CTXL; }
        const float* sb = SB + ((size_t)(pm * 2 + which) * 3) * DFF + c4;
        f32x4 cv = *(const f32x4*)sb; const f32x4 vl = *(const f32x4*)(sb + DFF);
        if (which == 0 && t > 0)     cv = cv + *(const f32x4*)(cw + c4) * *(const f32x4*)(SB + ((size_t)((pm - 1) * 2 + 1) * 3 + 2) * DFF + c4);
        if (which == 1 && t < L - 1) cv = cv + *(const f32x4*)(cw + 2 * DFF + c4) * *(const f32x4*)(SB + ((size_t)((pm + 1) * 2 + 0) * 3 + 2) * DFF + c4);
        const pg8::f32x2 g0 = pg8::gelu_pk((pg8::f32x2){cv.x, cv.y}), g1 = pg8::gelu_pk((pg8::f32x2){cv.z, cv.w});
        v2u o; o.x = pk2h(g0.x * vl.x, g0.y * vl.y); o.y = pk2h(g1.x * vl.z, g1.y * vl.w);
        *(v2u*)(ACT + (size_t)row * LDF + c4) = o;
    }
}

namespace gla {
typedef short bf16x8 __attribute__((ext_vector_type(8)));
typedef float f32x16 __attribute__((ext_vector_type(16)));
typedef unsigned u32x4 __attribute__((ext_vector_type(4)));
constexpr int NRC = MR / 64;
constexpr int PITCH = 72;
__device__ __forceinline__ int crow(int r, int hi) { return (r & 3) + 8 * (r >> 2) + 4 * hi; }
__device__ __forceinline__ unsigned cvtpk(float lo, float hi) { unsigned r; asm volatile("v_cvt_pk_bf16_f32 %0, %1, %2" : "=v"(r) : "v"(lo), "v"(hi)); return r; }
__device__ __forceinline__ int chain_slot_rc(int b, int dir, int s) { return s < 4 ? 256 + 4 * b + (dir ? 3 - s : s) : 64 * b + (dir ? 63 - (s - 4) : s - 4); }
__device__ __forceinline__ int rc_slot(int rc, int dir) { return rc < 256 ? 4 + (dir ? 63 - (rc & 63) : (rc & 63)) : (dir ? 3 - (rc & 3) : (rc & 3)); }
__device__ __forceinline__ int rc_batch(int rc) { return rc < 256 ? rc >> 6 : (rc - 256) >> 2; }
__device__ __forceinline__ float logsig16(float z2) { return (fminf(z2, 0.f) - __builtin_amdgcn_logf(1.0f + __builtin_amdgcn_exp2f(-fabsf(z2)))) * (1.0f / 16.0f); }

__device__ __forceinline__ void ph_prep(Frame& F, int e) {
    const bf16* P = (const bf16*)(F.ws + WS_P);
    bf16* QF = (bf16*)(F.ws + WS_QF); bf16* KF = (bf16*)(F.ws + WS_KF); bf16* QB = (bf16*)(F.ws + WS_QB); bf16* KB = (bf16*)(F.ws + WS_KB);
    float* AL = (float*)(F.ws + WS_AL);
    const float* ropec = (const float*)(F.ws + WS_ROPE); const float* ropes = ropec + 64 * 16;
    const float* w2 = (F.ka->in[I_WG2]) + (size_t)e * 2 * 16 * 512; const float* bg = (F.ka->in[I_BG]) + (size_t)e * 2 * 512;
    LAS float* ABf = (LAS float*)(F.lds + RING_OFF);
    LAS float* RTc = (LAS float*)(F.lds + RING_OFF + 8192); LAS float* RTs = RTc + 64 * 16;
    for (int i = F.tid; i < 2 * 64 * 16; i += NWAVES * 64) RTc[i] = ropec[i];
    const int dk = F.lane;
    pg8::f32x2 wfb[16], bfb; int col;
    const int hf = dk >> 5, f = dk & 15; const float sgn = ((dk >> 4) & 1) ? 1.0f : -1.0f;
#define GLA_Z(t, zf, zb) do { const LAS f32x4* ap = (const LAS f32x4*)(ABf + (t) * 32); pg8::f32x2 z2 = bfb; \
        _Pragma("unroll") for (int i = 0; i < 8; ++i) { const f32x4 a = ap[i]; z2 = (pg8::f32x2){a.x, a.y} * wfb[2 * i] + z2; z2 = (pg8::f32x2){a.z, a.w} * wfb[2 * i + 1] + z2; } \
        zf = z2.x; zb = z2.y; } while (0)
    const int NT = 256 + (NRC - 256) * 8;
    for (int task = blockIdx.x; task < NT; task += F.G) {
        const int rc = task < 256 ? task : 256 + ((task - 256) >> 3), h = task < 256 ? F.wave : ((task - 256) & 7);
        const bool active = task < 256 || F.wave == 0;
        const bool lat = rc < 256;
        const bf16* Prow0 = P + (size_t)rc * 64 * DINP;
        col = 64 * h + dk;
#pragma unroll
        for (int i = 0; i < 16; ++i) wfb[i] = (pg8::f32x2){w2[i * 512 + col], w2[(16 + i) * 512 + col]} * 1.4426950408889634f;
        bfb = (pg8::f32x2){bg[col], bg[512 + col]} * 1.4426950408889634f;
        __syncthreads();
        if (F.tid < 256) { const int row = F.tid >> 2, part = F.tid & 3; const v4u w = *(const v4u*)(Prow0 + (size_t)row * DINP + C_AB + 8 * part);
            LAS float* d = ABf + row * 32 + 16 * (part & 1) + (part >> 1);
            d[0] = bflo(w.x); d[2] = bfhi(w.x); d[4] = bflo(w.y); d[6] = bfhi(w.y); d[8] = bflo(w.z); d[10] = bfhi(w.z); d[12] = bflo(w.w); d[14] = bfhi(w.w); }
        __syncthreads();
        if (!active) continue;
        const int prw = rc & 63;
        float pf = 0.f, pbx = 0.f;
        for (int t8 = 0; t8 < 64; t8 += 8) {
            float qv[8], kv[8];
#pragma unroll
            for (int tt = 0; tt < 8; ++tt) { const bf16* prow = Prow0 + (size_t)(t8 + tt) * DINP; qv[tt] = bf2f(prow[C_QB + col]); kv[tt] = bf2f(prow[C_KB + col]); }
#pragma unroll
            for (int tt = 0; tt < 8; ++tt) {
                const int t = t8 + tt;
                float zf, zb; GLA_Z(t, zf, zb);
                const float gf = logsig16(zf), gb = logsig16(zb);
                pf += gf; const float cumf = pf, pbe = pbx; pbx += gb;
                float q = qv[tt], k = kv[tt];
                const float qp = __shfl_xor(q, 16), kp = __shfl_xor(k, 16);
                if (lat) { const int ri = (hf ? t : prw) * 16 + f; const float c = RTc[ri], s = RTs[ri];
                    const float ss = s * sgn; q = fmaf(qp, ss, q * c); k = fmaf(kp, ss, k * c); }
                q *= 0.125f;
                const unsigned o = (unsigned)((rc * 64 + t) * 512 + col);
                const unsigned wq = pg8::cvt_pk_bf16(q * __builtin_amdgcn_exp2f(cumf), q * __builtin_amdgcn_exp2f(fminf(-pbe, 115.f))), wk = pg8::cvt_pk_bf16(k * __builtin_amdgcn_exp2f(fminf(-cumf, 115.f)), k * __builtin_amdgcn_exp2f(pbe));
                QF[o] = (bf16)(wq & 0xffffu); QB[o] = (bf16)(wq >> 16); KF[o] = (bf16)(wk & 0xffffu); KB[o] = (bf16)(wk >> 16);
            }
        }
        AL[(size_t)(0 * NRC + rc) * 512 + col] = __builtin_amdgcn_exp2f(pf); AL[(size_t)(1 * NRC + rc) * 512 + col] = __builtin_amdgcn_exp2f(pbx);
    }
#undef GLA_Z
    __syncthreads();
}

__device__ __forceinline__ void stage_vt(Frame& F, const bf16* P, int rc, int h, LAS bf16* VT) {
    const int tp = (F.tid & 31) * 2, d8 = (F.tid >> 5) * 8;
    const bf16* src = P + (size_t)(rc * 64 + tp) * DINP + C_VB + 128 * h + d8;
    const v4u w0 = *(const v4u*)src, w1 = *(const v4u*)(src + DINP);
    LAS unsigned* dst = (LAS unsigned*)(VT + d8 * PITCH + tp);
    dst[0 * (PITCH / 2)] = (w0.x & 0xffffu) | (w1.x << 16); dst[1 * (PITCH / 2)] = (w0.x >> 16) | (w1.x & 0xffff0000u);
    dst[2 * (PITCH / 2)] = (w0.y & 0xffffu) | (w1.y << 16); dst[3 * (PITCH / 2)] = (w0.y >> 16) | (w1.y & 0xffff0000u);
    dst[4 * (PITCH / 2)] = (w0.z & 0xffffu) | (w1.z << 16); dst[5 * (PITCH / 2)] = (w0.z >> 16) | (w1.z & 0xffff0000u);
    dst[6 * (PITCH / 2)] = (w0.w & 0xffffu) | (w1.w << 16); dst[7 * (PITCH / 2)] = (w0.w >> 16) | (w1.w & 0xffff0000u);
}
#define GLA_BAR() do { asm volatile("s_waitcnt lgkmcnt(0)" ::: "memory"); __builtin_amdgcn_s_barrier(); asm volatile("" ::: "memory"); } while (0)
#define GLA_FRAG(base, row, col) (*(const LAS bf16x8*)((base) + (row) * PITCH + (col)))

__device__ __forceinline__ void ph_g1(Frame& F) {
    const bf16* P = (const bf16*)(F.ws + WS_P); const bf16* KFg = (const bf16*)(F.ws + WS_KF); const bf16* KBg = (const bf16*)(F.ws + WS_KB); bf16* UT = (bf16*)(F.ws + WS_UT); const float* AL = (const float*)(F.ws + WS_AL);
    LAS bf16* VT = (LAS bf16*)(F.lds + RING_OFF); LAS bf16* KH0 = VT + 128 * PITCH; LAS bf16* KH1 = KH0 + 64 * PITCH;
    const int r32 = F.lane & 31, hi = F.lane >> 5, dir = F.wave >> 2, db = F.wave & 3;
    for (int u = blockIdx.x; u < NRC * 8; u += F.G) {
        const int rc = u >> 3, h = u & 7;
        __syncthreads();
        stage_vt(F, P, rc, h, VT);
        {
            const int half = F.tid >> 8, tl = F.tid & 255, tp = (tl & 31) * 2, d8 = (tl >> 5) * 8;
            const bf16* src = (half ? KBg : KFg) + (size_t)(rc * 64 + tp) * 512 + 64 * h + d8;
            const v4u w0 = *(const v4u*)src, w1 = *(const v4u*)(src + 512);
            LAS unsigned* dst = (LAS unsigned*)((half ? KH1 : KH0) + d8 * PITCH + tp);
            dst[0 * (PITCH / 2)] = (w0.x & 0xffffu) | (w1.x << 16); dst[1 * (PITCH / 2)] = (w0.x >> 16) | (w1.x & 0xffff0000u);
            dst[2 * (PITCH / 2)] = (w0.y & 0xffffu) | (w1.y << 16); dst[3 * (PITCH / 2)] = (w0.y >> 16) | (w1.y & 0xffff0000u);
            dst[4 * (PITCH / 2)] = (w0.z & 0xffffu) | (w1.z << 16); dst[5 * (PITCH / 2)] = (w0.z >> 16) | (w1.z & 0xffff0000u);
            dst[6 * (PITCH / 2)] = (w0.w & 0xffffu) | (w1.w << 16); dst[7 * (PITCH / 2)] = (w0.w >> 16) | (w1.w & 0xffff0000u); }
        __syncthreads();
        const LAS bf16* KH = dir ? KH1 : KH0;
        f32x16 acc0 = {}, acc1 = {};
#pragma unroll
        for (int ks = 0; ks < 4; ++ks) { const bf16x8 a = GLA_FRAG(VT, 32 * db + r32, 16 * ks + 8 * hi);
            acc0 = __builtin_amdgcn_mfma_f32_32x32x16_bf16(a, GLA_FRAG(KH, r32, 16 * ks + 8 * hi), acc0, 0, 0, 0);
            acc1 = __builtin_amdgcn_mfma_f32_32x32x16_bf16(a, GLA_FRAG(KH, 32 + r32, 16 * ks + 8 * hi), acc1, 0, 0, 0); }
        const int b = rc_batch(rc), chain = (b * 8 + h) * 2 + dir, slot = rc_slot(rc, dir);
        if (dir == 0) { const float a0 = AL[(size_t)rc * 512 + 64 * h + r32], a1 = AL[(size_t)rc * 512 + 64 * h + 32 + r32];
#pragma unroll
            for (int r = 0; r < 16; ++r) { acc0[r] *= a0; acc1[r] *= a1; } }
        bf16* dst = UT + ((size_t)chain * 68 + slot) * 8192;
#pragma unroll
        for (int r = 0; r < 16; ++r) { const int dv = 32 * db + crow(r, hi); const unsigned w2_ = pk2(acc0[r], acc1[r]); dst[dv * 64 + r32] = (bf16)(w2_ & 0xffffu); dst[dv * 64 + 32 + r32] = (bf16)(w2_ >> 16); }
    }
    __syncthreads();
}

__device__ __forceinline__ void ph_g2(Frame& F) {
    const int gt = F.vcu * NWAVES * 64 + F.tid, NGT = F.G * NWAVES * 64;
    const bf16* UT = (const bf16*)(F.ws + WS_UT); bf16* ST = (bf16*)(F.ws + WS_ST); const float* AL = (const float*)(F.ws + WS_AL);
    for (int it = gt; it < 64 * 128 * 16; it += NGT) {
        const int chain = it >> 11, rem = it & 2047, dv = rem >> 4, dk4 = (rem & 15) * 4;
        const int dir = chain & 1, h = (chain >> 1) & 7, b = chain >> 4;
        float S0 = 0.f, S1 = 0.f, S2 = 0.f, S3 = 0.f;
        const size_t base = (size_t)chain * 68 * 8192 + dv * 64 + dk4;
#pragma unroll 17
        for (int s = 0; s < 68; ++s) {
            const v2u uw = *(const v2u*)(UT + base + (size_t)s * 8192);
            const int rc = chain_slot_rc(b, dir, s);
            const f32x4 a = *(const f32x4*)(AL + (size_t)(dir * NRC + rc) * 512 + 64 * h + dk4);
            v2u o; if (dir) { o.x = pk2(S0 * a.x, S1 * a.y); o.y = pk2(S2 * a.z, S3 * a.w); } else { o.x = pk2(S0, S1); o.y = pk2(S2, S3); }
            *(v2u*)(ST + base + (size_t)s * 8192) = o;
            S0 = fmaf(a.x, S0, bflo(uw.x)); S1 = fmaf(a.y, S1, bfhi(uw.x)); S2 = fmaf(a.z, S2, bflo(uw.y)); S3 = fmaf(a.w, S3, bfhi(uw.y));
        }
    }
}

#define GLA_PK4(P, BASE, OUT) do { unsigned a0 = pk2(P[BASE + 0], P[BASE + 1]), a1 = pk2(P[BASE + 2], P[BASE + 3]);   \
    unsigned b0 = pk2(P[BASE + 4], P[BASE + 5]), b1 = pk2(P[BASE + 6], P[BASE + 7]);                              \
    auto r0 = __builtin_amdgcn_permlane32_swap(a0, b0, false, false); auto r1 = __builtin_amdgcn_permlane32_swap(a1, b1, false, false); \
    u32x4 w = {r0[0], r1[0], r0[1], r1[1]}; OUT = *reinterpret_cast<bf16x8*>(&w); } while (0)
template <int DIR>
__device__ __forceinline__ void g3_intra(f32x16& o, const LAS bf16* Kt, const LAS bf16* Qt, const LAS bf16* VT, int jb, int tb, int db, int r32, int hi) {
    f32x16 X = {};
#pragma unroll
    for (int ks = 0; ks < 4; ++ks) X = __builtin_amdgcn_mfma_f32_32x32x16_bf16(GLA_FRAG(Kt, 32 * jb + r32, 16 * ks + 8 * hi), GLA_FRAG(Qt, 32 * tb + r32, 16 * ks + 8 * hi), X, 0, 0, 0);
    if (jb == tb) {
#pragma unroll
        for (int r = 0; r < 16; ++r) { const int tj = crow(r, hi); const bool keep = DIR ? (tj >= r32) : (tj <= r32); X[r] = keep ? X[r] : 0.f; }
    }
    bf16x8 x0, x1; GLA_PK4(X, 0, x0); GLA_PK4(X, 8, x1);
    o = __builtin_amdgcn_mfma_f32_32x32x16_bf16(GLA_FRAG(VT, 32 * db + r32, 32 * jb + 8 * hi), x0, o, 0, 0, 0);
    o = __builtin_amdgcn_mfma_f32_32x32x16_bf16(GLA_FRAG(VT, 32 * db + r32, 32 * jb + 16 + 8 * hi), x1, o, 0, 0, 0);
}
__device__ __forceinline__ void ph_g3(Frame& F, int e, int nrc) {
    const bf16* P = (const bf16*)(F.ws + WS_P); const bf16* ST = (const bf16*)(F.ws + WS_ST); bf16* MIX = (bf16*)(F.ws + WS_MIX);
    const bf16* QFg = (const bf16*)(F.ws + WS_QF); const bf16* KFg = (const bf16*)(F.ws + WS_KF); const bf16* QBg = (const bf16*)(F.ws + WS_QB); const bf16* KBg = (const bf16*)(F.ws + WS_KB);
    const float* gg = (F.ka->in[I_GLAG]) + (size_t)e * 8 * 128;
    LAS bf16* VT = (LAS bf16*)(F.lds + RING_OFF); LAS bf16* QFl = VT + 128 * PITCH; LAS bf16* KFl = QFl + 64 * PITCH; LAS bf16* QBl = KFl + 64 * PITCH; LAS bf16* KBl = QBl + 64 * PITCH;
    LAS float* SS = (LAS float*)(KBl + 64 * PITCH);
    const int r32 = F.lane & 31, hi = F.lane >> 5, tb = F.wave & 1, db = F.wave >> 1;
    const int s_tp = (F.tid & 31) * 2, s_d8 = (F.tid >> 5) * 8, s_t = F.tid >> 3, s_c8 = (F.tid & 7) * 8;
    v4u pv0, pv1, pqf, pkf, pqb, pkb; bf16x8 nsf[4], nsb[4];
#define G3_LOAD(uu) do { const int _rc = (uu) >> 3, _h = (uu) & 7, _b = rc_batch(_rc); \
        const bf16* _vs = P + (size_t)(_rc * 64 + s_tp) * DINP + C_VB + 128 * _h + s_d8; pv0 = *(const v4u*)_vs; pv1 = *(const v4u*)(_vs + DINP); \
        const size_t _go = (size_t)(_rc * 64 + s_t) * 512 + 64 * _h + s_c8; pqf = *(const v4u*)(QFg + _go); pkf = *(const v4u*)(KFg + _go); pqb = *(const v4u*)(QBg + _go); pkb = *(const v4u*)(KBg + _go); \
        const bf16* _sf = ST + ((size_t)((_b * 8 + _h) * 2 + 0) * 68 + rc_slot(_rc, 0)) * 8192 + (size_t)(32 * db + r32) * 64 + 8 * hi; \
        const bf16* _sb = ST + ((size_t)((_b * 8 + _h) * 2 + 1) * 68 + rc_slot(_rc, 1)) * 8192 + (size_t)(32 * db + r32) * 64 + 8 * hi; \
        _Pragma("unroll") for (int ks = 0; ks < 4; ++ks) { nsf[ks] = *(const bf16x8*)(_sf + 16 * ks); nsb[ks] = *(const bf16x8*)(_sb + 16 * ks); } } while (0)
    int u = blockIdx.x;
    if (u < nrc * 8) G3_LOAD(u);
    for (; u < nrc * 8; u += F.G) {
        const int rc = u >> 3, h = u & 7;
        GLA_BAR();
        { LAS unsigned* dst = (LAS unsigned*)(VT + s_d8 * PITCH + s_tp);
            dst[0 * (PITCH / 2)] = (pv0.x & 0xffffu) | (pv1.x << 16); dst[1 * (PITCH / 2)] = (pv0.x >> 16) | (pv1.x & 0xffff0000u);
            dst[2 * (PITCH / 2)] = (pv0.y & 0xffffu) | (pv1.y << 16); dst[3 * (PITCH / 2)] = (pv0.y >> 16) | (pv1.y & 0xffff0000u);
            dst[4 * (PITCH / 2)] = (pv0.z & 0xffffu) | (pv1.z << 16); dst[5 * (PITCH / 2)] = (pv0.z >> 16) | (pv1.z & 0xffff0000u);
            dst[6 * (PITCH / 2)] = (pv0.w & 0xffffu) | (pv1.w << 16); dst[7 * (PITCH / 2)] = (pv0.w >> 16) | (pv1.w & 0xffff0000u);
            const int lo = s_t * PITCH + s_c8;
            *(LAS v4u*)(QFl + lo) = pqf; *(LAS v4u*)(KFl + lo) = pkf; *(LAS v4u*)(QBl + lo) = pqb; *(LAS v4u*)(KBl + lo) = pkb; }
        bf16x8 sf[4], sb[4];
#pragma unroll
        for (int ks = 0; ks < 4; ++ks) { sf[ks] = nsf[ks]; sb[ks] = nsb[ks]; }
        GLA_BAR();
        if (u + F.G < nrc * 8) G3_LOAD(u + F.G);
        f32x16 o = {};
#pragma unroll
        for (int ks = 0; ks < 4; ++ks) { o = __builtin_amdgcn_mfma_f32_32x32x16_bf16(sf[ks], GLA_FRAG(QFl, 32 * tb + r32, 16 * ks + 8 * hi), o, 0, 0, 0);
            o = __builtin_amdgcn_mfma_f32_32x32x16_bf16(sb[ks], GLA_FRAG(QBl, 32 * tb + r32, 16 * ks + 8 * hi), o, 0, 0, 0); }
        if (tb == 0) { g3_intra<0>(o, KFl, QFl, VT, 0, 0, db, r32, hi); g3_intra<1>(o, KBl, QBl, VT, 0, 0, db, r32, hi); g3_intra<1>(o, KBl, QBl, VT, 1, 0, db, r32, hi); }
        else         { g3_intra<0>(o, KFl, QFl, VT, 0, 1, db, r32, hi); g3_intra<0>(o, KFl, QFl, VT, 1, 1, db, r32, hi); g3_intra<1>(o, KBl, QBl, VT, 1, 1, db, r32, hi); }
        float ss = 0.f;
#pragma unroll
        for (int r = 0; r < 16; ++r) ss = fmaf(o[r], o[r], ss);
        { auto rr = __builtin_amdgcn_permlane32_swap(__float_as_uint(ss), __float_as_uint(ss), false, false); ss = __uint_as_float(rr[0]) + __uint_as_float(rr[1]); }
        if (hi == 0) SS[db * 64 + 32 * tb + r32] = ss;
        GLA_BAR();
        const int t = 32 * tb + r32;
        const float tot = (SS[t] + SS[64 + t]) + (SS[128 + t] + SS[192 + t]);
        const float rn = 1.0f / sqrtf(tot * (1.0f / 128.0f) + EPS);
        const size_t row = (size_t)rc * 64 + t;
#pragma unroll
        for (int g4 = 0; g4 < 4; ++g4) { const int dv0 = 32 * db + 8 * g4 + 4 * hi;
            const v2u gw = *(const v2u*)(P + row * DINP + C_GB + 128 * h + dv0); const f32x4 gn = *(const f32x4*)(gg + 128 * h + dv0);
            const float g0 = bflo(gw.x), g1 = bfhi(gw.x), g2 = bflo(gw.y), g3 = bfhi(gw.y);
            const float y0 = o[4 * g4 + 0] * rn * gn.x * (g0 / (1.0f + __expf(-g0))), y1 = o[4 * g4 + 1] * rn * gn.y * (g1 / (1.0f + __expf(-g1)));
            const float y2 = o[4 * g4 + 2] * rn * gn.z * (g2 / (1.0f + __expf(-g2))), y3 = o[4 * g4 + 3] * rn * gn.w * (g3 / (1.0f + __expf(-g3)));
            v2u w; w.x = pk2(y0, y1); w.y = pk2(y2, y3);
            *(v2u*)(MIX + row * D + 1024 + 128 * h + dv0) = w; }
    }
#undef G3_LOAD
    __syncthreads();
}
#undef GLA_PK4
#undef GLA_FRAG
#undef GLA_BAR
}

constexpr int N_PHASES = 54;
__host__ __device__ constexpr bool phase_active(int id) {
    if (id == 0 || id == N_PHASES - 1) return true;
    const int L = (id - 1) / 13, k = (id - 1) % 13; const bool even = (L & 1) == 0;
    if (k == 1 || k == 8) return !even;
    if (k >= 2 && k <= 7) return even;
    return true;
}

__global__ void __launch_bounds__(NWAVES * 64, 2) fwd_kernel(Args args) {
    extern __shared__ __attribute__((aligned(16))) unsigned char lds[];
    Frame F;
    F.lds = (LAS unsigned char*)lds; F.ldsg = lds;
    F.MISC = (volatile LAS unsigned*)(F.lds + MISC_OFF);
    F.tid = threadIdx.x; F.lane = F.tid & 63; F.wave = __builtin_amdgcn_readfirstlane(F.tid >> 6);
    F.G = gridDim.x; { const int bx = blockIdx.x; F.vcu = (F.G % 8 == 0) ? (bx % 8) * (F.G / 8) + bx / 8 : bx; }
    F.ka = (KArgs)__builtin_amdgcn_kernarg_segment_ptr(); F.ws = F.ka->ws;
    for (int u = F.tid; u < (LDS_BYTES - LDSCTL_OFF) / 4; u += NWAVES * 64) ((LAS unsigned*)(F.lds + LDSCTL_OFF))[u] = 0u;
    __syncthreads();
    unsigned* barw = (unsigned*)(F.ws + WS_CTL) + CW_BAR;
    XcdBarrier bar = xcd_barrier_post(barw, F.MISC + 8);
    const int lo = args.ph_lo, hi = args.ph_hi;
    bool started = false;
#ifndef PH_MASK
#define PH_MASK 0xFFFFFFFFu
#endif
#ifndef PH_REP
#define PH_REP 0u
#endif
#define PHASE_BEGIN(id, kind) if (((PH_MASK >> (kind)) & 1u) && lo <= (id) && (id) < hi) { if (started) xcd_barrier(bar); started = true; for (int _rep = 0; _rep < (((PH_REP >> (kind)) & 1u) ? 2 : 1); ++_rep) { \
    { int _t = threadIdx.x; asm volatile("" : "+v"(_t)); F.tid = _t; F.lane = _t & 63; F.wave = __builtin_amdgcn_readfirstlane(_t >> 6); KArgs _k = (KArgs)__builtin_amdgcn_kernarg_segment_ptr(); asm volatile("" : "+s"(_k)); F.ka = _k; F.ws = _k->ws; }
#define PHASE_END } }

    PHASE_BEGIN(0, 0) ph_prologue(F); PHASE_END

    const float* MOD = (const float*)(F.ws + WS_MOD);
    for (int L = 0; L < DEPTH; ++L) {
        const int base = 1 + 13 * L; const bool even = (L & 1) == 0; const int e = L >> 1;
        const float* modl = MOD + (size_t)L * 5 * MODW;
#define XRc ((const float*)(F.ws + WS_XR) + (size_t)MLAT * D)
        const int rows_mix_in = (L <= 2) ? MR : MLAT;
        const int rows_upd = (L <= 1) ? MR : MLAT;

        PHASE_BEGIN(base + 0, 1) {
            ph_norm(F, rows_mix_in, L == 0 ? (F.ka->in[I_X]) : (const float*)nullptr, L == 0 ? (F.ka->in[I_CTX]) : XRc, (F.ka->in[I_N1G]) + (size_t)L * D, modl, 0, D, 4);
            if (L == 0) {
                const f32x4* cs = (const f32x4*)(F.ka->in[I_CTX]); f32x4* xd = (f32x4*)(F.ws + WS_XR) + (size_t)MLAT * D / 4;
                for (int i = F.vcu * NWAVES * 64 + F.tid; i < MCTX * D / 4; i += F.G * NWAVES * 64) xd[i] = cs[i];
            }
        } PHASE_END
        if (!even) {
            PHASE_BEGIN(base + 1, 2) ph_pool(F, rows_upd); PHASE_END
        }
        if (even) {
            PHASE_BEGIN(base + 2, 3) {
                pg8::Gemm g{(const pg8::bf16_t*)(F.ws + WS_H), (const pg8::bf16_t*)(F.ws + WS_WIN) + (size_t)e * DINP * D, MR, DINP, D, D, D, 1, 0, 0};
                pg8::StaticOrder S; S.init(MR, DINP, D, 1, F.G, (int)blockIdx.x);
                pg8::EpiBf16 E{(pg8::bf16_t*)(F.ws + WS_P), DINP};
                pg8::gemm_phase<pg8::EpiBf16, pg8::StaticOrder, false>(F.lds + RING_OFF, g, S, E, F.tid);
            } PHASE_END
            PHASE_BEGIN(base + 3, 4) {
                gla::ph_prep(F, e);
                if (L == 0) {
                    const na::bf16* P = (const na::bf16*)(F.ws + WS_P); na::bf16* MIX = (na::bf16*)(F.ws + WS_MIX);
                    for (int q = blockIdx.x; q < 48; q += F.G) { const int uc = q - 16; if (uc < 0) continue; const int b = uc >> 3, h = uc & 7;
                        na::na_unit<DINP, D>(P, C_QA + 128 * h, C_KA + 128 * h, C_VA + 128 * h, (long)MLAT + b * CTXL, (long)MLAT + b * CTXL, 0, 0, 0, 0,
                                             MIX, 128 * h, (F.ka->in[I_RPB]), (char*)lds + RING_OFF, F.tid); }
                }
            } PHASE_END
            PHASE_BEGIN(base + 4, 5) {
                gla::ph_g1(F);
                const na::bf16* P = (const na::bf16*)(F.ws + WS_P); na::bf16* MIX = (na::bf16*)(F.ws + WS_MIX);
                for (int u = F.vcu; u < 512; u += F.G) { const int b = u >> 7, h = (u >> 4) & 7, i = u & 15;
                    const int klo = i == 0 ? 0 : (i == 15 ? 56 : 4 * i - 4), nband = (i == 0 || i == 15) ? 8 : 12;
                    na::na_unit<DINP, D>(P, C_QA + 128 * h, C_KA + 128 * h, C_VA + 128 * h, (long)b * SEQ + 256 * i, (long)MLAT + b * CTXL, (long)b * SEQ + 64 * klo, nband, klo, 4 * i,
                                         MIX, 128 * h, (F.ka->in[I_RPB]) + ((size_t)e * 8 + h) * 15 * 31, (char*)lds + RING_OFF, F.tid); }
            } PHASE_END
            PHASE_BEGIN(base + 5, 6) {
                gla::ph_g2(F);
            } PHASE_END
            PHASE_BEGIN(base + 6, 7) gla::ph_g3(F, e, L == 0 ? MR / 64 : MLAT / 64); PHASE_END
            PHASE_BEGIN(base + 7, 8) {
                const int M = rows_upd;
                pg8::Gemm g{(const pg8::bf16_t*)(F.ws + WS_MIX), (const pg8::bf16_t*)(F.ws + WS_WOUT) + (size_t)e * D * D, M, D, D, D, D, 1, 0, 0};
                pg8::SplitTailOrder S; S.init(MLAT, M - MLAT, D, D, 4, F.G, (int)blockIdx.x);
                pg8::EpiResid E{(float*)(F.ws + WS_PART), (pg8::bf16_t*)(F.ws + WS_X16), D, modl + 2 * D, MODW, nullptr, 0, MLAT, MCTX};
                pg8::gemm_phase<pg8::EpiResid, pg8::SplitTailOrder, true>(F.lds + RING_OFF, g, S, E, F.tid);
            } PHASE_END
        } else {
            PHASE_BEGIN(base + 8, 9) {
                const int M = rows_upd;
                pg8::Gemm g{(const pg8::bf16_t*)(F.ws + WS_MIX), (const pg8::bf16_t*)(F.ws + WS_WPOOL) + (size_t)e * 4 * 512 * 512, M, 512, 512, D, 512, 4, (size_t)512 * 2, (size_t)512 * 512 * 2};
                pg8::StaticOrder S; S.init(M, 512, 512, 4, F.G, (int)blockIdx.x);
                pg8::EpiResid E{(float*)(F.ws + WS_PART), (pg8::bf16_t*)(F.ws + WS_X16), D, modl + 2 * D, MODW, (F.ka->in[I_POOLS]) + (size_t)e * D, 512, MLAT, MCTX};
                pg8::gemm_phase<pg8::EpiResid, pg8::StaticOrder, true>(F.lds + RING_OFF, g, S, E, F.tid);
            } PHASE_END
        }
        PHASE_BEGIN(base + 9, 10) ph_norm(F, rows_upd, (const float*)nullptr, XRc, (F.ka->in[I_N2G]) + (size_t)L * D, modl, 3 * D, 4 * D, even ? 4 : 1); PHASE_END
        PHASE_BEGIN(base + 10, 11) {
            const int M = rows_upd;
            pg8::Gemm g{(const pg8::bf16_t*)(F.ws + WS_H), (const pg8::bf16_t*)(F.ws + WS_WUP) + (size_t)L * DUP * D, M, DUP, D, D, D, 1, 0, 0};
            pg8::StaticOrder S; S.init(M, DUP, D, 1, F.G, (int)blockIdx.x);
            pg8::EpiGlu E{(pg8::bf16_t*)(F.ws + WS_ACT), LDF, (F.ka->in[I_CONVW]) + (size_t)L * 3 * DFF, (F.ka->in[I_CONVB]) + (size_t)L * DFF, (float*)(F.ws + WS_SB), DFF, (PG8_LAS float*)(F.lds + RING_OFF + 131072)};
            pg8::gemm_phase<pg8::EpiGlu, pg8::StaticOrder, true>(F.lds + RING_OFF, g, S, E, F.tid);
        } PHASE_END
        PHASE_BEGIN(base + 11, 12) ph_glufix(F, rows_upd, (F.ka->in[I_CONVW]) + (size_t)L * 3 * DFF, (F.ka->in[I_CONVB]) + (size_t)L * DFF); PHASE_END
        PHASE_BEGIN(base + 12, 13) {
            const int M = rows_upd;
            pg8::Gemm g{(const pg8::bf16_t*)(F.ws + WS_ACT), (const pg8::bf16_t*)(F.ws + WS_WDOWN) + (size_t)L * D * LDF, M, D, DFF, LDF, LDF, 1, 0, 0};
            pg8::SplitTailOrder S; S.init(MLAT, M - MLAT, D, DFF, 4, F.G, (int)blockIdx.x);
            pg8::EpiResid E{(float*)(F.ws + WS_PART), (pg8::bf16_t*)(F.ws + WS_X16), D, modl + 5 * D, MODW, nullptr, 0, MLAT, MCTX};
            pg8::gemm_phase<pg8::EpiResid, pg8::SplitTailOrder, true>(F.lds + RING_OFF, g, S, E, F.tid);
        } PHASE_END
    }
#ifdef XTRA_BARRIERS
    for (int xb = 0; xb < XTRA_BARRIERS; ++xb) xcd_barrier(bar);
#endif
    PHASE_BEGIN(N_PHASES - 1, 14) ph_final(F); PHASE_END
#undef PHASE_BEGIN
#undef PHASE_END
#undef XRc
}

#ifndef MK_PER_PHASE
#define MK_PER_PHASE 0
#endif
extern "C" void kernel_launch(void* const* d_in, const int* in_sizes, int n_in, void* d_out, int out_size, void* d_ws, size_t ws_size, hipStream_t stream) {
    static int grid = 0;
    if (grid == 0) {
        if (n_in != 21 || in_sizes[0] != MLAT * D || out_size != MLAT * D || ws_size < WS_END) {
            fprintf(stderr, "kernel_launch: shape mismatch: n_in %d in0 %d out %d ws %zu (need %zu); nothing launched\n", n_in, n_in > 0 ? in_sizes[0] : -1, out_size, ws_size, (size_t)WS_END); grid = -1; return; }
        int dev = 0, cus = 0, per_cu = 0;
        if (hipGetDevice(&dev) != hipSuccess || hipDeviceGetAttribute(&cus, hipDeviceAttributeMultiprocessorCount, dev) != hipSuccess) { fprintf(stderr, "kernel_launch: device query failed\n"); grid = -1; return; }
        if (hipFuncSetAttribute((const void*)fwd_kernel, hipFuncAttributeMaxDynamicSharedMemorySize, LDS_BYTES) != hipSuccess) { fprintf(stderr, "kernel_launch: hipFuncSetAttribute failed\n"); grid = -1; return; }
        if (hipOccupancyMaxActiveBlocksPerMultiprocessor(&per_cu, (const void*)fwd_kernel, NWAVES * 64, LDS_BYTES) != hipSuccess || per_cu < 1) {
            fprintf(stderr, "kernel_launch: occupancy query reports %d workgroups per CU\n", per_cu); }
        (void)hipGetLastError();
        grid = cus;
    }
    if (grid < 0) return;
    if (hipMemsetAsync((char*)d_ws + WS_CTL, 0, CTL_ZERO_BYTES, stream) != hipSuccess) { fprintf(stderr, "kernel_launch: memset failed\n"); return; }
    Args a{};
    for (int i = 0; i < 21; ++i) a.in[i] = (const float*)d_in[i];
    a.out = (float*)d_out; a.ws = (unsigned char*)d_ws;
#if MK_PER_PHASE
    for (int p = 0; p < N_PHASES; ++p) { if (!phase_active(p)) continue; a.ph_lo = p; a.ph_hi = p + 1;
        hipLaunchKernelGGL(fwd_kernel, dim3(grid), dim3(NWAVES * 64), LDS_BYTES, stream, a); }
#else
    a.ph_lo = 0; a.ph_hi = N_PHASES;
    hipLaunchKernelGGL(fwd_kernel, dim3(grid), dim3(NWAVES * 64), LDS_BYTES, stream, a);
#endif
    const hipError_t le = hipPeekAtLastError();
    if (le != hipSuccess) fprintf(stderr, "kernel_launch: launch failed: %s\n", hipGetErrorName(le));
}
```

```cpp
#include <hip/hip_runtime.h>
#include <cstdio>
#include <cstdint>

namespace pg8 {
#define PG8_LAS __attribute__((address_space(3)))
typedef unsigned short bf16_t;
typedef short bf16x8 __attribute__((ext_vector_type(8)));
typedef float f32x4 __attribute__((ext_vector_type(4)));
typedef float f32x2 __attribute__((ext_vector_type(2)));
typedef unsigned u32x4 __attribute__((ext_vector_type(4)));
constexpr int BM = 256, BK = 64, HALF = 128, HTB = HALF * BK * 2  , STAGE_BYTES = 8 * HTB, NXCD = 8;

__host__ __device__ __forceinline__ int lds_byte(int r, int c) { const int st = (r >> 4) * 2 + (c >> 5), rr = r & 15, cc = c & 31, ob = rr * 64 + cc * 2; return st * 1024 + (ob ^ (((ob >> 9) & 1) << 5)); }
__host__ __device__ __forceinline__ void stage_rc(int b, int& R, int& C) { const int st = b / 1024, sb = b % 1024, swz = sb ^ (((sb >> 9) & 1) << 5); R = (st >> 1) * 16 + swz / 64; C = (st & 1) * 32 + (swz % 64) / 2; }
__host__ __device__ __forceinline__ int perm32(int rho) { const int n = rho >> 4, i = rho & 15; return 8 * (i >> 2) + 4 * n + (i & 3); }

struct Unit { int pm, pn, grp, kt0, nkt, atomic; };
struct Gemm { const bf16_t* A; const bf16_t* Bt; int M, N, K, lda, ldb, ngrp; size_t gsA, gsB; };

struct StaticOrder {
    int nM, nN, nNr, nwg, G, c, nktK, WGM = 4;
    __host__ __device__ void init(int M, int N, int K, int ngrp, int G_, int c_) { nM = M / BM; nNr = N / BM; nN = nNr * ngrp; nwg = nM * nN; G = G_; c = c_; nktK = K / BK; }
    __host__ __device__ bool next(int i, Unit& u) const {
        const long L = (long)i * G + c; if (L >= nwg) return false;
        int wgid = (int)L; { const int q = nwg / NXCD, r = nwg % NXCD, xcd = wgid % NXCD, off = wgid / NXCD; wgid = (xcd < r ? xcd * (q + 1) : r * (q + 1) + (xcd - r) * q) + off; }
        int nig = WGM * nN, nr = nNr;
#if defined(__HIP_DEVICE_COMPILE__)
        asm volatile("" : "+s"(nig), "+s"(nr));
#endif
        const int gid = wgid / nig, fm = gid * WGM, gsz = (nM - fm) < WGM ? (nM - fm) : WGM;
        u.pm = fm + ((wgid % nig) % gsz); const int vn = (wgid % nig) / gsz; u.pn = vn % nr; u.grp = vn / nr; u.kt0 = 0; u.nkt = nktK; u.atomic = 0; return true;
    }
    __device__ __forceinline__ void a_ready(const Unit&) const {}
    __device__ __forceinline__ void done(const Unit&) const {}
};
struct SplitTailOrder {
    StaticOrder main; int nA, nB, nNr, SK, nks, pmB, G, c;
    __host__ __device__ void init(int MA, int MB, int N, int K, int SK_, int G_, int c_) { main.init(MA, N, K, 1, G_, c_); nA = main.nwg; nNr = N / BM; SK = SK_; nks = (K / BK) / SK_; pmB = MA / BM; nB = (MB / BM) * nNr * SK_; G = G_; c = c_; }
    __host__ __device__ bool next(int i, Unit& u) const {
        const long L = (long)i * G + c;
        if (L < nA) return main.next(i, u);
        const int Lb = (int)(L - nA); if (Lb >= nB) return false;
        const int ks = Lb % SK, tile = Lb / SK; u.pn = tile % nNr; u.pm = pmB + tile / nNr; u.grp = 0; u.kt0 = ks * nks; u.nkt = nks; u.atomic = 1 + ks; return true;
    }
    __device__ __forceinline__ void a_ready(const Unit&) const {}
    __device__ __forceinline__ void done(const Unit&) const {}
};

__device__ __forceinline__ unsigned cvt_pk_bf16(float lo, float hi) { unsigned r; asm volatile("v_cvt_pk_bf16_f32 %0, %1, %2" : "=v"(r) : "v"(lo), "v"(hi)); return r; }
typedef float cf32x2 __attribute__((ext_vector_type(2)));
typedef __bf16 cbf16x2 __attribute__((ext_vector_type(2)));
__device__ __forceinline__ unsigned pkc(float lo, float hi) { return __builtin_bit_cast(unsigned, __builtin_convertvector((cf32x2){lo, hi}, cbf16x2)); }
__device__ __forceinline__ unsigned f2bfc(float f) { return pkc(f, f) & 0xffffu; }
typedef _Float16 f16x2 __attribute__((ext_vector_type(2)));
__device__ __forceinline__ unsigned pk_h2(float lo, float hi) { f16x2 p; p.x = (_Float16)__builtin_amdgcn_fmed3f(lo, -65504.0f, 65504.0f); p.y = (_Float16)__builtin_amdgcn_fmed3f(hi, -65504.0f, 65504.0f); return __builtin_bit_cast(unsigned, p); }
__device__ __forceinline__ float h_lo(unsigned w) { return (float)__builtin_bit_cast(f16x2, w).x; }
__device__ __forceinline__ float h_hi(unsigned w) { return (float)__builtin_bit_cast(f16x2, w).y; }
template <unsigned BITS> __device__ __forceinline__ float kc() { float r; asm volatile("s_mov_b32 %0, %1" : "=s"(r) : "n"(BITS)); return r; }
__device__ __forceinline__ void gelu4(const f32x2 (&v)[4], f32x2 (&o)[4]) {
    f32x2 c[4], w[4], q[4];
#pragma unroll
    for (int p = 0; p < 4; ++p) { c[p].x = __builtin_amdgcn_fmed3f(v[p].x, -5.0f, 5.0f); c[p].y = __builtin_amdgcn_fmed3f(v[p].y, -5.0f, 5.0f); w[p] = (c[p] * c[p]) * 0.08f + (-1.0f); }
    { const float ka = kc<0x3a40c646u>(), kb = kc<0xbadbc5c1u>();
#pragma unroll
      for (int p = 0; p < 4; ++p) q[p] = w[p] * ka + kb; }
    { const float kk = kc<0x3ab42bcbu>();
#pragma unroll
      for (int p = 0; p < 4; ++p) q[p] = q[p] * w[p] + kk; }
    { const float kk = kc<0xbb259aa1u>();
#pragma unroll
      for (int p = 0; p < 4; ++p) q[p] = q[p] * w[p] + kk; }
    { const float kk = kc<0x3bddb9bfu>();
#pragma unroll
      for (int p = 0; p < 4; ++p) q[p] = q[p] * w[p] + kk; }
    { const float kk = kc<0xbc394185u>();
#pragma unroll
      for (int p = 0; p < 4; ++p) q[p] = q[p] * w[p] + kk; }
    { const float kk = kc<0x3c85018cu>();
#pragma unroll
      for (int p = 0; p < 4; ++p) q[p] = q[p] * w[p] + kk; }
    { const float kk = kc<0xbcbe2975u>();
#pragma unroll
      for (int p = 0; p < 4; ++p) q[p] = q[p] * w[p] + kk; }
    { const float kk = kc<0x3d00edc6u>();
#pragma unroll
      for (int p = 0; p < 4; ++p) q[p] = q[p] * w[p] + kk; }
    { const float kk = kc<0xbd25b03eu>();
#pragma unroll
      for (int p = 0; p < 4; ++p) q[p] = q[p] * w[p] + kk; }
    { const float kk = kc<0x3d530477u>();
#pragma unroll
      for (int p = 0; p < 4; ++p) q[p] = q[p] * w[p] + kk; }
    { const float kk = kc<0xbd8ff74du>();
#pragma unroll
      for (int p = 0; p < 4; ++p) q[p] = q[p] * w[p] + kk; }
    { const float kk = kc<0x3e10c1adu>();
#pragma unroll
      for (int p = 0; p < 4; ++p) q[p] = q[p] * w[p] + kk; }
#pragma unroll
    for (int p = 0; p < 4; ++p) o[p] = v[p] * (q[p] * c[p] + 0.5f);
}

__device__ __forceinline__ f32x2 gelu_pk(f32x2 v) {
    f32x2 c; c.x = __builtin_amdgcn_fmed3f(v.x, -5.0f, 5.0f); c.y = __builtin_amdgcn_fmed3f(v.y, -5.0f, 5.0f);
    const f32x2 w = (c * c) * 0.08f + (-1.0f);
    f32x2 q = w * 7.353763795e-04f + (-1.676730928e-03f);
    q = q * w + 1.374596148e-03f; q = q * w + (-2.526916796e-03f); q = q * w + 6.766527425e-03f; q = q * w + (-1.130712498e-02f); q = q * w + 1.623608917e-02f;
    q = q * w + (-2.321312763e-02f); q = q * w + 3.147675842e-02f; q = q * w + (-4.045128077e-02f); q = q * w + 5.151792988e-02f; q = q * w + (-7.029590756e-02f); q = q * w + 1.413638145e-01f;
    return v * (q * c + 0.5f);
}

struct EpiBf16 {
    static constexpr bool PERM = true;
    bf16_t* O; int ldc;
    __device__ __forceinline__ void operator()(const f32x4 (&acc)[2][2][4][2], const Unit& u, int wr, int wc, int fr, int fq) const {
        const int row0 = u.pm * BM + wr * 64 + fr; const int col0 = u.pn * BM + wc * 32 + 8 * fq;
#pragma unroll
        for (int ai = 0; ai < 2; ++ai)
#pragma unroll
            for (int m = 0; m < 4; ++m) { bf16_t* rowp = O + (size_t)(row0 + ai * HALF + m * 16) * ldc + col0;
#pragma unroll
                for (int bj = 0; bj < 2; ++bj) { const f32x4 v0 = acc[ai][bj][m][0], v1 = acc[ai][bj][m][1];
                    u32x4 w; w.x = cvt_pk_bf16(v0[0], v0[1]); w.y = cvt_pk_bf16(v0[2], v0[3]); w.z = cvt_pk_bf16(v1[0], v1[1]); w.w = cvt_pk_bf16(v1[2], v1[3]);
                    *(u32x4*)(rowp + bj * HALF) = w; } }
    }
};
struct EpiGlu {
    static constexpr bool PERM = true;
    bf16_t* ACT; int ldc; const float* cw; const float* cb; float* SB; int dff; PG8_LAS float* XB;
    static __device__ __forceinline__ float ror1(float v)  { return __builtin_bit_cast(float, __builtin_amdgcn_update_dpp(0, __builtin_bit_cast(int, v), 0x121, 0xf, 0xf, true)); }
    static __device__ __forceinline__ float ror15(float v) { return __builtin_bit_cast(float, __builtin_amdgcn_update_dpp(0, __builtin_bit_cast(int, v), 0x12f, 0xf, 0xf, true)); }
    __device__ __forceinline__ void operator()(const f32x4 (&acc)[2][2][4][2], const Unit& u, int wr, int wc, int fr, int fq) const {
        const int ch0 = u.pn * HALF + wc * 32 + 8 * fq; const bool l0 = (fr == 0), l15 = (fr == 15);
        PG8_LAS float* xme = XB + ((wr * 4 + wc) * 4) * 32 + fq * 8;
#pragma unroll
        for (int ai = 0; ai < 2; ++ai) {
            if (fr == 0)  { *(PG8_LAS f32x4*)(xme + (ai * 2 + 0) * 32) = acc[ai][1][0][0]; *(PG8_LAS f32x4*)(xme + (ai * 2 + 0) * 32 + 4) = acc[ai][1][0][1]; }
            if (fr == 15) { *(PG8_LAS f32x4*)(xme + (ai * 2 + 1) * 32) = acc[ai][1][3][0]; *(PG8_LAS f32x4*)(xme + (ai * 2 + 1) * 32 + 4) = acc[ai][1][3][1]; }
        }
        asm volatile("s_waitcnt lgkmcnt(0)" ::: "memory"); __builtin_amdgcn_s_barrier(); asm volatile("" ::: "memory");
        f32x4 w0[2], w1[2], w2[2], bb[2];
#pragma unroll
        for (int n = 0; n < 2; ++n) { w0[n] = *(const f32x4*)(cw + ch0 + 4 * n); w1[n] = *(const f32x4*)(cw + dff + ch0 + 4 * n); w2[n] = *(const f32x4*)(cw + 2 * dff + ch0 + 4 * n); bb[n] = *(const f32x4*)(cb + ch0 + 4 * n); }
#pragma unroll
        for (int ai = 0; ai < 2; ++ai) {
            const int rp = 128 * ai + 64 * wr - 1, rn = 128 * ai + 64 * wr + 64;
            f32x4 xp[2], xn[2];
#pragma unroll
            for (int n = 0; n < 2; ++n) { xp[n] = (f32x4){0.f, 0.f, 0.f, 0.f}; xn[n] = (f32x4){0.f, 0.f, 0.f, 0.f}; }
            if (rp >= 0)  { const PG8_LAS float* s = XB + ((((rp >> 6) & 1) * 4 + wc) * 4 + (rp >> 7) * 2 + 1) * 32 + fq * 8; xp[0] = *(const PG8_LAS f32x4*)s; xp[1] = *(const PG8_LAS f32x4*)(s + 4); }
            if (rn < 256) { const PG8_LAS float* s = XB + ((((rn >> 6) & 1) * 4 + wc) * 4 + (rn >> 7) * 2 + 0) * 32 + fq * 8; xn[0] = *(const PG8_LAS f32x4*)s; xn[1] = *(const PG8_LAS f32x4*)(s + 4); }
#pragma unroll
            for (int m = 0; m < 4; ++m) {
                const int row = u.pm * BM + ai * HALF + wr * 64 + m * 16 + fr;
                u32x4 ow; float cv[8];
#pragma unroll
                for (int n = 0; n < 2; ++n)
#pragma unroll
                    for (int j = 0; j < 4; ++j) {
                        const float g = acc[ai][1][m][n][j];
                        const float tp = l15 ? ((m > 0) ? acc[ai][1][m > 0 ? m - 1 : 0][n][j] : xp[n][j]) : g;
                        const float tn = l0  ? ((m < 3) ? acc[ai][1][m < 3 ? m + 1 : 3][n][j] : xn[n][j]) : g;
                        const float gp = ror1(tp), gn = ror15(tn);
                        cv[4 * n + j] = fmaf(w0[n][j], gp, fmaf(w1[n][j], g, fmaf(w2[n][j], gn, bb[n][j])));
                    }
                const int tr = ai * HALF + wr * 64 + m * 16 + fr;
                if (tr == 0 || tr == 255) { float* sb = SB + ((size_t)(u.pm * 2 + (tr ? 1 : 0)) * 3) * dff + ch0;
#pragma unroll
                    for (int n = 0; n < 2; ++n) { *(f32x4*)(sb + 4 * n) = (f32x4){cv[4 * n], cv[4 * n + 1], cv[4 * n + 2], cv[4 * n + 3]}; *(f32x4*)(sb + dff + 4 * n) = acc[ai][0][m][n]; *(f32x4*)(sb + 2 * dff + 4 * n) = acc[ai][1][m][n]; } }
                f32x2 gv[4], go[4]; float a[8];
#pragma unroll
                for (int p = 0; p < 4; ++p) gv[p] = (f32x2){cv[2 * p], cv[2 * p + 1]};
                gelu4(gv, go);
#pragma unroll
                for (int e = 0; e < 8; e += 2) { a[e] = go[e >> 1].x * acc[ai][0][m][e >> 2][e & 3]; a[e + 1] = go[e >> 1].y * acc[ai][0][m][(e + 1) >> 2][(e + 1) & 3]; }
                ow.x = cvt_pk_bf16(a[0], a[1]); ow.y = cvt_pk_bf16(a[2], a[3]); ow.z = cvt_pk_bf16(a[4], a[5]); ow.w = cvt_pk_bf16(a[6], a[7]);
                *(u32x4*)(ACT + (size_t)row * ldc + ch0) = ow;
            }
        }
    }
};
struct EpiResid {
    static constexpr bool PERM = true;
    float* PART; bf16_t* X16; int ldx; const float* gate; int gstride; const float* cscale; int gcols; int mlat; int mctx;
    __device__ __forceinline__ void operator()(const f32x4 (&acc)[2][2][4][2], const Unit& u, int wr, int wc, int fr_, int fq_) const {
        int fr = fr_, fq = fq_; asm volatile("" : "+v"(fr), "+v"(fq));
        const int row0 = u.pm * BM + wr * 64 + fr, col0 = u.grp * gcols + u.pn * BM + wc * 32 + 8 * fq;
        const int rowt = u.pm * BM; const int bidx = rowt < mlat ? (rowt >> 12) : 4;
        const float* gp = gate + (size_t)bidx * gstride + col0;
        f32x4 gv[2][2];
#pragma unroll
        for (int bj = 0; bj < 2; ++bj)
#pragma unroll
            for (int n = 0; n < 2; ++n) { gv[bj][n] = *(const f32x4*)(gp + bj * HALF + n * 4); if (cscale) gv[bj][n] = gv[bj][n] * *(const f32x4*)(cscale + col0 + bj * HALF + n * 4); }
        if (rowt >= mlat) {
            float* base = PART + ((size_t)(u.atomic ? u.atomic - 1 : 0) * mctx + (size_t)(row0 - mlat)) * ldx + col0;
            f32x4 gc[2][2] = {{gv[0][0], gv[0][1]}, {gv[1][0], gv[1][1]}}; asm volatile("" : "+v"(gc[0][0]), "+v"(gc[0][1]), "+v"(gc[1][0]), "+v"(gc[1][1]));
#pragma unroll
            for (int ai = 0; ai < 2; ++ai)
#pragma unroll
                for (int m = 0; m < 4; ++m) { float* rowp = base + (size_t)(ai * HALF + m * 16) * ldx;
#pragma unroll
                    for (int bj = 0; bj < 2; ++bj)
#pragma unroll
                        for (int n = 0; n < 2; ++n) *(f32x4*)(rowp + bj * HALF + n * 4) = acc[ai][bj][m][n] * gc[bj][n]; }
        } else {
            u32x4 xin[2][4][2];
#pragma unroll
            for (int ai = 0; ai < 2; ++ai)
#pragma unroll
                for (int m = 0; m < 4; ++m)
#pragma unroll
                    for (int bj = 0; bj < 2; ++bj) xin[ai][m][bj] = *(const u32x4*)(X16 + (size_t)(row0 + ai * HALF + m * 16) * ldx + col0 + bj * HALF);
            asm volatile("" ::: "memory");
#pragma unroll
            for (int ai = 0; ai < 2; ++ai)
#pragma unroll
                for (int m = 0; m < 4; ++m)
#pragma unroll
                    for (int bj = 0; bj < 2; ++bj) { const u32x4 h = xin[ai][m][bj]; const f32x4 a0 = acc[ai][bj][m][0] * gv[bj][0], a1 = acc[ai][bj][m][1] * gv[bj][1];
                        u32x4 w;
                        w.x = pk_h2(h_lo(h.x) + a0[0], h_hi(h.x) + a0[1]); w.y = pk_h2(h_lo(h.y) + a0[2], h_hi(h.y) + a0[3]);
                        w.z = pk_h2(h_lo(h.z) + a1[0], h_hi(h.z) + a1[1]); w.w = pk_h2(h_lo(h.w) + a1[2], h_hi(h.w) + a1[3]);
                        *(u32x4*)(X16 + (size_t)(row0 + ai * HALF + m * 16) * ldx + col0 + bj * HALF) = w; }
        }
    }
};

template <class Epi, class Sched, bool ALIGN_EPI = true>
__device__ __forceinline__ void gemm_phase(PG8_LAS unsigned char* lds, const Gemm g, const Sched& S, const Epi& E, const int tid) {
    const int wid = __builtin_amdgcn_readfirstlane(tid >> 6), lane = tid & 63, wr = wid >> 2, wc = wid & 3, fr = lane & 15, fq = lane >> 4;
    unsigned voffA[2], voffB[2];
#pragma unroll
    for (int i = 0; i < 2; ++i) { int R, C; stage_rc(tid * 16 + i * 8192, R, C); const int Rb = Epi::PERM ? ((R & ~31) + perm32(R & 31)) : R;
        voffA[i] = (unsigned)(R * g.lda + C) * 2u; voffB[i] = (unsigned)(Rb * g.ldb + C) * 2u; }
    const size_t kstep = (size_t)(BK * 2);
    const size_t hstepA = (size_t)HALF * g.lda * 2, hstepB = (size_t)HALF * g.ldb * 2;
    const size_t tstepA = 2 * hstepA, tstepB = 2 * hstepB;
    const unsigned ldsw = (unsigned)wid * 1024u;
    const int aoff = lds_byte(wr * 64 + fr, fq * 8), boff = lds_byte(wc * 32 + fr, fq * 8);
#define PG8_SA(b, h) (((b) * 2 + (h)) * HTB)
#define PG8_SB(b, h) ((4 + (b) * 2 + (h)) * HTB)
#define PG8_STAGE(bufoff, gbase, voff) do { _Pragma("unroll") for (int _i = 0; _i < 2; ++_i) \
        __builtin_amdgcn_global_load_lds((const unsigned*)((const char*)(gbase) + (voff)[_i]), (PG8_LAS unsigned*)(lds + (bufoff) + ldsw + _i * 8192), 16, 0, 0); } while (0)
#define PG8_LDA(dst, b, h) do { _Pragma("unroll") for (int m = 0; m < 4; ++m) _Pragma("unroll") for (int k = 0; k < 2; ++k) dst[m][k] = *(const PG8_LAS bf16x8*)(lds + PG8_SA(b, h) + aoff + m * 2048 + k * 1024); } while (0)
#define PG8_LDB(dst, b, h) do { _Pragma("unroll") for (int n = 0; n < 2; ++n) _Pragma("unroll") for (int k = 0; k < 2; ++k) dst[n][k] = *(const PG8_LAS bf16x8*)(lds + PG8_SB(b, h) + boff + n * 2048 + k * 1024); } while (0)
#define PG8_MMA(ai, bj, At, Bt) do { __builtin_amdgcn_s_setprio(1); _Pragma("unroll") for (int m = 0; m < 4; ++m) _Pragma("unroll") for (int n = 0; n < 2; ++n) _Pragma("unroll") for (int k = 0; k < 2; ++k) \
        acc[ai][bj][m][n] = __builtin_amdgcn_mfma_f32_16x16x32_bf16(Bt[n][k], At[m][k], acc[ai][bj][m][n], 0, 0, 0); __builtin_amdgcn_s_setprio(0); } while (0)
#define PG8_WAIT_V(n) asm volatile("s_waitcnt vmcnt(" #n ")" ::: "memory")
#define PG8_WAIT_L(n) asm volatile("s_waitcnt lgkmcnt(" #n ")" ::: "memory")
#define PG8_BAR __builtin_amdgcn_s_barrier()
#define PG8_SCHED __builtin_amdgcn_sched_barrier(0)
    Unit cur, nxt; int ui = 0;
    if (!S.next(0, cur)) return;
    f32x4 acc[2][2][4][2];
#pragma unroll
    for (int a = 0; a < 2; ++a)
#pragma unroll
        for (int b = 0; b < 2; ++b)
#pragma unroll
            for (int m = 0; m < 4; ++m)
#pragma unroll
                for (int n = 0; n < 2; ++n) acc[a][b][m][n] = (f32x4){0.f, 0.f, 0.f, 0.f};
    bf16x8 At[4][2], B0[2][2], B1[2][2];
    const char* cA = (const char*)g.A + (size_t)cur.pm * tstepA + (size_t)cur.grp * g.gsA + (size_t)cur.kt0 * kstep; const char* cB = (const char*)g.Bt + (size_t)cur.pn * tstepB + (size_t)cur.grp * g.gsB + (size_t)cur.kt0 * kstep;
    S.a_ready(cur);
    PG8_STAGE(PG8_SB(0, 0), cB, voffB); PG8_STAGE(PG8_SB(0, 1), cB + hstepB, voffB); PG8_STAGE(PG8_SA(0, 0), cA, voffA); PG8_STAGE(PG8_SA(0, 1), cA + hstepA, voffA);
    if (wr == 1) PG8_BAR;
    PG8_WAIT_V(2); PG8_BAR;
    PG8_STAGE(PG8_SB(1, 0), cB + kstep, voffB); PG8_STAGE(PG8_SA(1, 0), cA + kstep, voffA); PG8_STAGE(PG8_SB(1, 1), cB + hstepB + kstep, voffB);
    PG8_WAIT_V(6); PG8_BAR;
    for (;;) {
        const bool has_next = S.next(ui + 1, nxt);
        const char* nA = has_next ? (const char*)g.A + (size_t)nxt.pm * tstepA + (size_t)nxt.grp * g.gsA + (size_t)nxt.kt0 * kstep : cA;
        const char* nB = has_next ? (const char*)g.Bt + (size_t)nxt.pn * tstepB + (size_t)nxt.grp * g.gsB + (size_t)nxt.kt0 * kstep : cB;
        const int nt = cur.nkt;
        for (int t = 0; t < nt; t += 2) {
            const bool last = (t == nt - 2);
            const char* a1 = cA + (size_t)(t + 1) * kstep;
            const char* a2 = last ? nA : cA + (size_t)(t + 2) * kstep; const char* b2 = last ? nB : cB + (size_t)(t + 2) * kstep;
            const char* a3 = a2 + kstep; const char* b3 = b2 + kstep;
            if (last && has_next) S.a_ready(nxt);
            PG8_LDB(B0, 0, 0); PG8_LDB(B1, 0, 1); PG8_SCHED; PG8_LDA(At, 0, 0); PG8_STAGE(PG8_SA(1, 1), a1 + hstepA, voffA);
            PG8_WAIT_V(8); PG8_WAIT_L(0); PG8_BAR; PG8_MMA(0, 0, At, B0); PG8_MMA(0, 1, At, B1); PG8_BAR; PG8_SCHED;
            PG8_LDA(At, 0, 1); PG8_STAGE(PG8_SB(0, 0), b2, voffB); PG8_STAGE(PG8_SB(0, 1), b2 + hstepB, voffB); PG8_STAGE(PG8_SA(0, 0), a2, voffA);
            PG8_WAIT_V(8); PG8_WAIT_L(0); PG8_BAR; PG8_MMA(1, 0, At, B0); PG8_MMA(1, 1, At, B1); PG8_BAR; PG8_SCHED;
            PG8_LDB(B0, 1, 0); PG8_LDB(B1, 1, 1); PG8_SCHED; PG8_LDA(At, 1, 0); PG8_STAGE(PG8_SA(0, 1), a2 + hstepA, voffA);
            PG8_WAIT_V(8); PG8_WAIT_L(0); PG8_BAR; PG8_MMA(0, 0, At, B0); PG8_MMA(0, 1, At, B1); PG8_BAR; PG8_SCHED;
            PG8_LDA(At, 1, 1); PG8_STAGE(PG8_SB(1, 0), b3, voffB); PG8_STAGE(PG8_SB(1, 1), b3 + hstepB, voffB); PG8_STAGE(PG8_SA(1, 0), a3, voffA);
            PG8_WAIT_V(8); PG8_WAIT_L(0); PG8_BAR; PG8_MMA(1, 0, At, B0); PG8_MMA(1, 1, At, B1); PG8_BAR; PG8_SCHED;
        }
        if constexpr (ALIGN_EPI) { if (wr == 0) PG8_BAR; }
        E(acc, cur, wr, wc, fr, fq); S.done(cur);
        if (!has_next) break;
#pragma unroll
        for (int a = 0; a < 2; ++a)
#pragma unroll
            for (int b = 0; b < 2; ++b)
#pragma unroll
                for (int m = 0; m < 4; ++m)
#pragma unroll
                    for (int n = 0; n < 2; ++n) acc[a][b][m][n] = (f32x4){0.f, 0.f, 0.f, 0.f};
        cur = nxt; cA = nA; cB = nB; ++ui;
        if constexpr (ALIGN_EPI) { if (wr == 1) PG8_BAR; }
    }
    PG8_WAIT_V(0);
    if constexpr (!ALIGN_EPI) { if (wr == 0) PG8_BAR; }
    PG8_BAR;
#undef PG8_SA
#undef PG8_SB
#undef PG8_STAGE
#undef PG8_LDA
#undef PG8_LDB
#undef PG8_MMA
#undef PG8_WAIT_V
#undef PG8_WAIT_L
#undef PG8_BAR
#undef PG8_SCHED
}
}

namespace na {
typedef unsigned short bf16;
using bf16x8 = __attribute__((ext_vector_type(8))) short;
using s16x4  = __attribute__((ext_vector_type(4))) short;
using f32x16 = __attribute__((ext_vector_type(16))) float;
using u32x4  = __attribute__((ext_vector_type(4))) unsigned;
constexpr int   D = 128, NW = 8, QBLK = 32, KVBLK = 64;
constexpr float SCALE = 0.088388347648318440f;
constexpr float THR = 8.f;
constexpr float NEG = -1.0e30f;
constexpr size_t SHM_V = KVBLK * D * 2, SHM_K = KVBLK * D * 2, SHM_ATTN = 2 * SHM_V + 2 * SHM_K + NW * 64 * 4;
constexpr size_t BIAS_OFF = 69632;
constexpr size_t PEN_OFF = BIAS_OFF + 640 * 4;
constexpr size_t QS_OFF = 73728;
constexpr size_t LDS_END = QS_OFF + NW * 8192;
#define NA_KSWZ(row, colB) ((row) * 256 + ((colB) ^ (((row) & 7) << 4)))
#define NA_SBAR() __builtin_amdgcn_sched_barrier(0)
__device__ __forceinline__ int crow(int r, int hi) { return (r & 3) + 8 * (r >> 2) + 4 * hi; }
__device__ __forceinline__ unsigned cvtpk(float lo, float hi) { unsigned r; asm volatile("v_cvt_pk_bf16_f32 %0, %1, %2" : "=v"(r) : "v"(lo), "v"(hi)); return r; }

__device__ __forceinline__ void partialSM(f32x16& p0, f32x16& p1, float& m_reg, float& mn, float& alpha) {
  constexpr float C = SCALE * 1.4426950408889634f;
  float pmax = p0[0];
#pragma unroll
  for (int r = 1; r < 16; ++r) pmax = fmaxf(pmax, p0[r]);
#pragma unroll
  for (int r = 0; r < 16; ++r) pmax = fmaxf(pmax, p1[r]);
  { auto rr = __builtin_amdgcn_permlane32_swap(__float_as_uint(pmax), __float_as_uint(pmax), false, false);
    pmax = fmaxf(__uint_as_float(rr[0]), __uint_as_float(rr[1])); }
  if (__builtin_expect(__all(pmax - m_reg <= THR / SCALE), 1)) { mn = m_reg; alpha = 1.f; }
  else { mn = fmaxf(m_reg, pmax); alpha = __builtin_amdgcn_exp2f((m_reg - mn) * C); m_reg = mn; }
  float mnC = -mn * C;
#pragma unroll
  for (int r = 0; r < 16; ++r) p0[r] = fmaf(p0[r], C, mnC);
#pragma unroll
  for (int r = 0; r < 16; ++r) p1[r] = fmaf(p1[r], C, mnC);
#pragma unroll
  for (int r = 0; r < 16; ++r) p0[r] = __builtin_amdgcn_exp2f(p0[r]);
}
__device__ __forceinline__ void finishSM(f32x16& p0, f32x16& p1, float alpha, float& l_reg, bf16x8& pa0, bf16x8& pa1, bf16x8& pa2, bf16x8& pa3) {
#pragma unroll
  for (int r = 0; r < 16; ++r) p1[r] = __builtin_amdgcn_exp2f(p1[r]);
  float ps = 0;
#pragma unroll
  for (int r = 0; r < 16; ++r) ps += p0[r];
#pragma unroll
  for (int r = 0; r < 16; ++r) ps += p1[r];
  { auto rr = __builtin_amdgcn_permlane32_swap(__float_as_uint(ps), __float_as_uint(ps), false, false);
    ps = __uint_as_float(rr[0]) + __uint_as_float(rr[1]); }
  l_reg = l_reg * alpha + ps;
#define NA_PK4(P, BASE, OUT) do { unsigned a0 = cvtpk(P[BASE + 0], P[BASE + 1]), a1 = cvtpk(P[BASE + 2], P[BASE + 3]);   \
    unsigned b0 = cvtpk(P[BASE + 4], P[BASE + 5]), b1 = cvtpk(P[BASE + 6], P[BASE + 7]);                              \
    auto r0 = __builtin_amdgcn_permlane32_swap(a0, b0, false, false); auto r1 = __builtin_amdgcn_permlane32_swap(a1, b1, false, false); \
    u32x4 w = {r0[0], r1[0], r0[1], r1[1]}; OUT = *reinterpret_cast<bf16x8*>(&w); } while (0)
  NA_PK4(p0, 0, pa0); NA_PK4(p0, 8, pa1); NA_PK4(p1, 0, pa2); NA_PK4(p1, 8, pa3);
#undef NA_PK4
}
__device__ __forceinline__ void qkt(f32x16& p0, f32x16& p1, const bf16* Ks, const bf16x8* qs, int r32, int hi) {
#pragma unroll
  for (int d0 = 0; d0 < 8; ++d0) { int cb = (d0 * 16 + hi * 8) * 2; const bf16x8 q = qs[d0 * 64];
    bf16x8 b0 = *reinterpret_cast<const bf16x8*>((const char*)Ks + NA_KSWZ(r32, cb));
    bf16x8 b1 = *reinterpret_cast<const bf16x8*>((const char*)Ks + NA_KSWZ(32 + r32, cb));
    p0 = __builtin_amdgcn_mfma_f32_32x32x16_bf16(b0, q, p0, 0, 0, 0);
    p1 = __builtin_amdgcn_mfma_f32_32x32x16_bf16(b1, q, p1, 0, 0, 0); }
}
__device__ __forceinline__ int v_st(int k, int c) { const int kk = (k & ~0xC) | ((k & 4) << 1) | ((k & 8) >> 1); return ((kk >> 3) * 4 + (c >> 5)) * 512 + ((kk & 7) * 32 + (c & 31)) * 2; }
__device__ __forceinline__ int v_rd_base(int lane) { return ((lane & 3) << 3) | (((lane >> 2) & 3) << 6) | (((lane >> 4) & 1) << 5) | (((lane >> 5) & 1) << 8); }
constexpr int v_rd_off(int d0, int ks, int half) { return d0 * 512 + ks * 4096 + half * 2048; }
template <int OFF> __device__ __forceinline__ s16x4 tr_read(int vb) {
  s16x4 r; asm volatile("ds_read_b64_tr_b16 %0, %1 offset:%2" : "=&v"(r) : "v"(vb), "i"(OFF) : "memory"); return r;
}
template <int D0> __device__ __forceinline__ void pv_one(f32x16& od, int vb, bf16x8 pa0, bf16x8 pa1, bf16x8 pa2, bf16x8 pa3) {
  const s16x4 l0 = tr_read<v_rd_off(D0, 0, 0)>(vb), h0 = tr_read<v_rd_off(D0, 0, 1)>(vb), l1 = tr_read<v_rd_off(D0, 1, 0)>(vb), h1 = tr_read<v_rd_off(D0, 1, 1)>(vb);
  const s16x4 l2 = tr_read<v_rd_off(D0, 2, 0)>(vb), h2 = tr_read<v_rd_off(D0, 2, 1)>(vb), l3 = tr_read<v_rd_off(D0, 3, 0)>(vb), h3 = tr_read<v_rd_off(D0, 3, 1)>(vb);
  asm volatile("s_waitcnt lgkmcnt(0)" ::: "memory"); NA_SBAR();
#define NA_PK(L, H) (bf16x8){L[0], L[1], L[2], L[3], H[0], H[1], H[2], H[3]}
  od = __builtin_amdgcn_mfma_f32_32x32x16_bf16(pa0, NA_PK(l0, h0), od, 0, 0, 0);
  od = __builtin_amdgcn_mfma_f32_32x32x16_bf16(pa1, NA_PK(l1, h1), od, 0, 0, 0);
  od = __builtin_amdgcn_mfma_f32_32x32x16_bf16(pa2, NA_PK(l2, h2), od, 0, 0, 0);
  od = __builtin_amdgcn_mfma_f32_32x32x16_bf16(pa3, NA_PK(l3, h3), od, 0, 0, 0);
#undef NA_PK
}
__device__ __forceinline__ void pv_d0(f32x16* o, int vb, bf16x8 pa0, bf16x8 pa1, bf16x8 pa2, bf16x8 pa3) {
  pv_one<0>(o[0], vb, pa0, pa1, pa2, pa3); pv_one<1>(o[1], vb, pa0, pa1, pa2, pa3); pv_one<2>(o[2], vb, pa0, pa1, pa2, pa3); pv_one<3>(o[3], vb, pa0, pa1, pa2, pa3);
}

__device__ __forceinline__ void init_scores(f32x16& p0, f32x16& p1, int j, int klo, int qrow, const float* bt_l, const float* pen_l) {
  if (j < 4) { p0 = f32x16{}; p1 = f32x16{}; return; }
  const int kr = klo + j - 4, rs = min(max(qrow - 4, 0), 56);
  if (kr < rs || kr >= rs + 8) {
#pragma unroll
    for (int r = 0; r < 16; ++r) { p0[r] = NEG; p1[r] = NEG; }
    return;
  }
  int zo; asm volatile("v_mov_b32 %0, 0" : "=v"(zo));
  const float* bl = bt_l + (kr - qrow + 7) * 32; pen_l += zo;
#pragma unroll
  for (int r = 0; r < 16; ++r) { const int c = (r & 3) + 8 * (r >> 2); p0[r] = bl[c] + pen_l[c]; p1[r] = bl[32 + c] + pen_l[32 + c]; }
}

template <int LDP, int LDO>
__device__ __forceinline__ void na_unit(const bf16* __restrict__ P, int qcol, int kcol, int vcol, long qrow0, long crow0, long brow0, int nband, int klo, int qg0,
                                        bf16* __restrict__ O, int ocol, const float* __restrict__ rpbh, char* lds, const int tid) {
  const int wid = tid >> 6, lane = tid & 63, r32 = lane & 31, hi = lane >> 5;
  bf16* V_lds = (bf16*)lds; bf16* K_lds = (bf16*)(lds + 2 * SHM_V);
  float* ws = (float*)(lds + 2 * SHM_V + 2 * SHM_K) + wid * 64; float* li_l = ws; float* al_l = ws + 32;
  float* blds = (float*)(lds + BIAS_OFF); float* pens = (float*)(lds + PEN_OFF);
  __syncthreads();
  if (nband > 0) {
    for (int i = tid; i < 640; i += 512) { const int t2 = i - 64, dri = t2 >> 5, dci = t2 & 31; blds[i] = (t2 >= 0 && t2 < 480 && dci < 31) ? rpbh[dri * 31 + dci] * (1.0f / SCALE) : 0.f; }
    if (tid < 128) pens[tid] = (tid >= 48 && tid < 64) ? 0.f : NEG;
  }
  float m_reg = -1e30f, l_reg = 0; f32x16 o[4] = {};
  bf16x8* qs = (bf16x8*)(lds + QS_OFF + wid * 8192) + lane;
  { const bf16* Qw = P + (qrow0 + wid * QBLK + r32) * LDP + qcol + hi * 8;
#pragma unroll
    for (int d0 = 0; d0 < 8; ++d0) qs[d0 * 64] = *reinterpret_cast<const bf16x8*>(Qw + d0 * 16); }
  const int sr = tid >> 4, sc = (tid & 15) * 8, vst0 = v_st(sr, sc), vst1 = v_st(32 + sr, sc);
  const int vb0 = (int)(uintptr_t)V_lds + v_rd_base(lane);
  const int qrow = qg0 + (wid >> 1), qc = (wid & 1) * 32 + r32;
  const float* bt_l = blds + 64 + 15 - qc + 4 * hi; const float* pen_l = pens + 48 - min(max(qc - 8, 0), 48) + 4 * hi;
  const bf16* Kh = P + kcol; const bf16* Vh = P + vcol;
  bf16x8 vs0, vs1, ks0, ks1;
#define NA_TROW(j) ((j) < 4 ? crow0 + (long)(j) * 64 : brow0 + (long)((j) - 4) * 64)
#define NA_SLOAD(j) do { const long _k0 = NA_TROW(j); vs0 = *reinterpret_cast<const bf16x8*>(&Vh[(_k0 + sr) * LDP + sc]); vs1 = *reinterpret_cast<const bf16x8*>(&Vh[(_k0 + 32 + sr) * LDP + sc]); \
    ks0 = *reinterpret_cast<const bf16x8*>(&Kh[(_k0 + sr) * LDP + sc]); ks1 = *reinterpret_cast<const bf16x8*>(&Kh[(_k0 + 32 + sr) * LDP + sc]); } while (0)
#define NA_SWRITE(b) do { *(bf16x8*)((char*)V_lds + (b) * SHM_V + vst0) = vs0; *(bf16x8*)((char*)V_lds + (b) * SHM_V + vst1) = vs1; const int kc = sc * 2; \
    *(bf16x8*)((char*)K_lds + (b) * SHM_K + NA_KSWZ(sr, kc)) = ks0; *(bf16x8*)((char*)K_lds + (b) * SHM_K + NA_KSWZ(32 + sr, kc)) = ks1; } while (0)
#define NA_RESC(a) do { if (__any((a) < 1.f)) { if (hi == 0) al_l[r32] = (a); asm volatile("s_waitcnt lgkmcnt(0)" ::: "memory"); \
    _Pragma("unroll") for (int d = 0; d < 4; ++d) _Pragma("unroll") for (int r = 0; r < 16; ++r) o[d][r] *= al_l[crow(r, hi)]; } } while (0)
  f32x16 p0, p1; float mn, al; bf16x8 pa0, pa1, pa2, pa3; const int NT = 4 + nband; const int rs_ = min(max(qrow - 4, 0), 56);
  NA_SLOAD(0);
  for (int j = 0; j < NT; ++j) {
    const int b = j & 1;
    NA_SWRITE(b);
    if (j + 1 < NT) NA_SLOAD(j + 1);
    __syncthreads();
    const int kr_ = klo + j - 4;
    if (j < 4 || (kr_ >= rs_ && kr_ < rs_ + 8)) {
      init_scores(p0, p1, j, klo, qrow, bt_l, pen_l);
      qkt(p0, p1, (const bf16*)((const char*)K_lds + b * SHM_K), qs, r32, hi);
      partialSM(p0, p1, m_reg, mn, al);
      NA_RESC(al);
      finishSM(p0, p1, al, l_reg, pa0, pa1, pa2, pa3); NA_SBAR();
      pv_d0(o, vb0 + b * (int)SHM_V, pa0, pa1, pa2, pa3);
    }
  }
  if (hi == 0) li_l[r32] = l_reg; asm volatile("s_waitcnt lgkmcnt(0)" ::: "memory");
  float rli[16];
#pragma unroll
  for (int r = 0; r < 16; ++r) rli[r] = __builtin_amdgcn_rcpf(li_l[crow(r, hi)]);
  bf16* Ow = O + (qrow0 + wid * QBLK) * LDO + ocol;
#pragma unroll
  for (int r = 0; r < 16; ++r) { const int orow = crow(r, hi);
#pragma unroll
    for (int d0 = 0; d0 < 4; ++d0) { const float v = o[d0][r] * rli[r]; Ow[(long)orow * LDO + d0 * 32 + r32] = (bf16)pg8::f2bfc(v); } }
#undef NA_TROW
#undef NA_SLOAD
#undef NA_SWRITE
#undef NA_RESC
}
}

constexpr int NWAVES = 8;
constexpr int D = 2048, NBATCH = 4, SEQ = 4096, MLAT = NBATCH * SEQ, CTXL = 256, MCTX = NBATCH * CTXL, MR = MLAT + MCTX;
#ifndef PADF
#define PADF 128
#endif
constexpr int DFF = 5632, DUP = 2 * DFF, DIN = 6176, DINP = 6400, DEPTH = 4, LDF = DFF + PADF;
constexpr int MODW = 6 * D;
constexpr float EPS = 1e-6f;
constexpr int C_QA = 0, C_KA = 1024, C_VA = 2048, C_QB = 3072, C_KB = 3584, C_VB = 4096, C_GB = 5120, C_AB = 6144;

constexpr size_t MiB = 1u << 20;
constexpr size_t WS_CTL = 0, CTL_ZERO_BYTES = 32768;
constexpr size_t WS_MOD = 1 * MiB;
constexpr size_t WS_ROPE = WS_MOD + (size_t)DEPTH * 5 * MODW * 4;
constexpr size_t WS_WIN = 2 * MiB;
constexpr size_t WS_WOUT = WS_WIN + (size_t)2 * DINP * D * 2;
constexpr size_t WS_WPOOL = WS_WOUT + (size_t)2 * D * D * 2;
constexpr size_t WS_WUP = WS_WPOOL + (size_t)2 * 4 * 512 * 512 * 2;
constexpr size_t WS_WDOWN = WS_WUP + (size_t)DEPTH * DUP * D * 2;
constexpr size_t WS_XR = WS_WDOWN + (size_t)DEPTH * D * LDF * 2;
constexpr size_t WS_X16 = WS_XR;
constexpr size_t WS_PART = WS_XR + (size_t)MLAT * D * 2;
constexpr size_t WS_H = WS_XR + (size_t)MR * D * 4;
constexpr size_t WS_MIX = WS_H + (size_t)MR * D * 2;
constexpr size_t WS_BIG = WS_MIX + (size_t)MR * D * 2;
constexpr size_t WS_U = WS_BIG;
constexpr size_t WS_ACT = WS_U + (size_t)MR * DUP * 2;
constexpr size_t WS_P = WS_BIG;
constexpr size_t WS_QF = WS_P + (size_t)MR * DINP * 2;
constexpr size_t WS_KF = WS_QF + (size_t)MR * 512 * 2;
constexpr size_t WS_QB = WS_KF + (size_t)MR * 512 * 2;
constexpr size_t WS_KB = WS_QB + (size_t)MR * 512 * 2;
constexpr size_t WS_KHT = WS_KB + (size_t)MR * 512 * 2;
constexpr size_t WS_AL = WS_KHT + (size_t)2 * MR * 512 * 2;
constexpr size_t WS_UT = WS_AL + (size_t)2 * (MR / 64) * 512 * 4;
constexpr size_t WS_ST = WS_UT + (size_t)64 * 68 * 8192 * 2;
constexpr size_t WS_MIXEND = WS_ST + (size_t)64 * 68 * 8192 * 2;
constexpr size_t WS_SB = WS_ACT + (size_t)MR * LDF * 2;
constexpr size_t WS_END = WS_SB + (size_t)(MR / 256) * 2 * 3 * DFF * 4;
static_assert(WS_MIXEND <= WS_END, "even-mixer view fits inside the FFN view");
static_assert(WS_ROPE + 2 * 64 * 16 * 4 <= WS_WIN, "small tables fit below the weights");
constexpr int CW_BAR = 4096;

constexpr int RING_OFF = 0, RING_BYTES = 143360;
constexpr int LDSCTL_OFF = RING_BYTES, MISC_OFF = LDSCTL_OFF + 320;
constexpr int LDS_BYTES = 147456;
static_assert(na::LDS_END <= RING_BYTES, "attention LDS fits the ring");

#define GAS __attribute__((address_space(1)))
#define LAS __attribute__((address_space(3)))
typedef unsigned short bf16;
typedef unsigned v4u __attribute__((ext_vector_type(4)));
typedef unsigned v2u __attribute__((ext_vector_type(2)));
typedef float f32x4 __attribute__((ext_vector_type(4)));
#define LDS_WAIT() asm volatile("s_waitcnt lgkmcnt(0)" ::: "memory")
__device__ __forceinline__ unsigned f2bf(float f) { return pg8::f2bfc(f); }
__device__ __forceinline__ unsigned pk2(float lo, float hi) { return pg8::pkc(lo, hi); }
__device__ __forceinline__ unsigned pk2h(float lo, float hi) { return pg8::cvt_pk_bf16(lo, hi); }
__device__ __forceinline__ float bflo(unsigned w) { return __builtin_bit_cast(float, w << 16); }
__device__ __forceinline__ float bfhi(unsigned w) { return __builtin_bit_cast(float, w & 0xffff0000u); }
__device__ __forceinline__ float bf2f(bf16 b) { return __builtin_bit_cast(float, (unsigned)b << 16); }

#define XB_TMO      128
#define XB_XCNT(j)  (256  + 64 * (j))
#define XB_XSUB(j)  (1280 + 64 * (j))
#define XB_XGEN(j)  (2304 + 64 * (j))
#define XB_TOP      3328
#define XB_TOPGEN   3392
#define XCD_BAR_WORDS 3456
#define XB_SPIN_CAP (1u << 18)
__device__ __forceinline__ unsigned xb_ld(unsigned* p)              { return __hip_atomic_load(p, __ATOMIC_RELAXED, __HIP_MEMORY_SCOPE_AGENT); }
__device__ __forceinline__ unsigned xb_add(unsigned* p, unsigned v) { return __hip_atomic_fetch_add(p, v, __ATOMIC_RELAXED, __HIP_MEMORY_SCOPE_AGENT); }
__device__ __forceinline__ unsigned xb_xcc_id() { return (unsigned)__builtin_amdgcn_s_getreg((3 << 11) | 20) & 0xFu; }
#define XB_SPIN(cond, bar) do { unsigned _sp = 0; while (cond) { __builtin_amdgcn_s_sleep(1); \
    if ((++_sp & 255u) == 0u) { if (xb_ld(&(bar)[XB_TMO])) break; if (_sp > XB_SPIN_CAP) { atomicAdd(&(bar)[XB_TMO], 1u); break; } } } } while (0)
struct XcdBarrier { unsigned* bar; unsigned x; volatile LAS unsigned* st; };
__device__ __forceinline__ XcdBarrier xcd_barrier_post(unsigned* bar, volatile LAS unsigned* st) {
    XcdBarrier b; b.bar = bar; b.x = xb_xcc_id(); b.st = st;
    if (threadIdx.x == 0) (void)xb_add(&bar[XB_XCNT(b.x)], 1u);
    return b;
}
__device__ __forceinline__ void xcd_barrier_complete(unsigned* bar, unsigned x, unsigned& nloc, unsigned& nx) {
    const unsigned G = gridDim.x * gridDim.y * gridDim.z;
    unsigned sum, cnt, mine, sp = 0u;
    for (;;) {
        sum = 0u; cnt = 0u; mine = 0u;
#pragma unroll
        for (unsigned j = 0; j < 16; ++j) { const unsigned c = xb_ld(&bar[XB_XCNT(j)]); sum += c; cnt += (c > 0u) ? 1u : 0u; mine = (j == x) ? c : mine; }
        if (sum == G) break;
        __builtin_amdgcn_s_sleep(1);
        if ((++sp & 255u) == 0u) { if (xb_ld(&bar[XB_TMO])) break; if (sp > XB_SPIN_CAP) { atomicAdd(&bar[XB_TMO], 1u); break; } }
    }
    nloc = mine > 0u ? mine : 1u; nx = cnt > 0u ? cnt : 1u;
}
__device__ __forceinline__ void xcd_barrier(const XcdBarrier& b) {
    asm volatile("s_waitcnt vmcnt(0)" ::: "memory");
    __syncthreads();
    if (threadIdx.x == 0) {
        unsigned* bar = b.bar;
        __builtin_amdgcn_s_waitcnt(0);
        unsigned nloc = b.st[0], nx = b.st[1];
        if (nloc == 0u) { xcd_barrier_complete(bar, b.x, nloc, nx); b.st[0] = nloc; b.st[1] = nx; }
        const unsigned old = xb_add(&bar[XB_XSUB(b.x)], 1u);
        const unsigned gen = old / nloc;
        if (old + 1u == (gen + 1u) * nloc) {
            __builtin_amdgcn_fence(__ATOMIC_RELEASE, "agent");
            asm volatile("s_waitcnt vmcnt(0)" ::: "memory");
            const unsigned og = xb_add(&bar[XB_TOP], 1u);
            const unsigned tg = og / nx;
            if (og + 1u == (tg + 1u) * nx) xb_add(&bar[XB_TOPGEN], 1u);
            else XB_SPIN(xb_ld(&bar[XB_TOPGEN]) == tg, bar);
            __builtin_amdgcn_fence(__ATOMIC_ACQUIRE, "agent");
            xb_add(&bar[XB_XGEN(b.x)], 1u);
            asm volatile("s_waitcnt vmcnt(0)" ::: "memory");
        } else {
            XB_SPIN(xb_ld(&bar[XB_XGEN(b.x)]) == gen, bar);
            __builtin_amdgcn_fence(__ATOMIC_ACQUIRE, "agent");
            asm volatile("s_waitcnt vmcnt(0)" ::: "memory");
        }
    }
    __syncthreads();
}

struct Args { const float* in[21]; float* out; unsigned char* ws; int ph_lo, ph_hi; };
static_assert(sizeof(Args) == 23 * 8 + 8, "Args has no padding bytes");
typedef const __attribute__((address_space(4))) Args* KArgs;
enum { I_X = 0, I_C, I_CTX, I_CCTX, I_WMOD, I_BMOD, I_N1G, I_N2G, I_WIN, I_WG2, I_BG, I_RPB, I_GLAG, I_WOUT, I_POOLW, I_POOLS, I_WUP, I_CONVW, I_CONVB, I_WDOWN, I_FING };
struct Frame {
    LAS unsigned char* lds; unsigned char* ldsg;
    volatile LAS unsigned* MISC;
    int tid, lane, wave, vcu, G;
    KArgs ka; unsigned char* ws;
};
__device__ __forceinline__ float wave_sum(float v) {
#pragma unroll
    for (int o = 1; o < 64; o <<= 1) v += __shfl_xor(v, o);
    return v;
}

__device__ __forceinline__ void p0_transpose_item(const float* W, int K, int N, bf16* WT, LAS float* scr, int item, int lane, int ldt = 0) {
    if (ldt == 0) ldt = K;
    const int nblk = N / 32, kb = item / nblk, nb = item % nblk, k0 = 64 * kb, n0 = 32 * nb;
#pragma unroll 8
    for (int i = 0; i < 32; ++i) { const int kk = 2 * i + (lane >> 5); scr[kk * 33 + (lane & 31)] = W[(size_t)(k0 + kk) * N + n0 + (lane & 31)]; }
    LDS_WAIT(); asm volatile("" ::: "memory");
    const int c = lane & 7;
#pragma unroll
    for (int j = 0; j < 4; ++j) { const int n = (lane >> 3) + 8 * j; const LAS float* s = scr + (8 * c) * 33 + n;
        v4u o; o.x = pk2(s[0 * 33], s[1 * 33]); o.y = pk2(s[2 * 33], s[3 * 33]); o.z = pk2(s[4 * 33], s[5 * 33]); o.w = pk2(s[6 * 33], s[7 * 33]);
        *(GAS v4u*)(WT + (size_t)(n0 + n) * ldt + k0 + 8 * c) = o; }
    LDS_WAIT(); asm volatile("" ::: "memory");
}
__device__ __forceinline__ void p0_transpose_item_up(const float* W, bf16* WT, LAS float* scr, int item, int lane) {
    constexpr int K = D, N = DUP;
    const int nblk = N / 32, kb = item / nblk, nb = item % nblk, k0 = 64 * kb, n0 = 32 * nb;
    const int isg = n0 >= DFF, c0 = isg ? n0 - DFF : n0, d0 = 256 * (c0 >> 7) + (isg ? 128 : 0) + (c0 & 127);
#pragma unroll 8
    for (int i = 0; i < 32; ++i) { const int kk = 2 * i + (lane >> 5); scr[kk * 33 + (lane & 31)] = W[(size_t)(k0 + kk) * N + n0 + (lane & 31)]; }
    LDS_WAIT(); asm volatile("" ::: "memory");
    const int c = lane & 7;
#pragma unroll
    for (int j = 0; j < 4; ++j) { const int n = (lane >> 3) + 8 * j; const LAS float* s = scr + (8 * c) * 33 + n;
        v4u o; o.x = pk2(s[0 * 33], s[1 * 33]); o.y = pk2(s[2 * 33], s[3 * 33]); o.z = pk2(s[4 * 33], s[5 * 33]); o.w = pk2(s[6 * 33], s[7 * 33]);
        *(GAS v4u*)(WT + (size_t)(d0 + n) * K + k0 + 8 * c) = o; }
    LDS_WAIT(); asm volatile("" ::: "memory");
}
__device__ __forceinline__ void ph_prologue(Frame& F) {
    const int gw = F.vcu * NWAVES + F.wave, NGW = F.G * NWAVES;
    const int gt = F.vcu * NWAVES * 64 + F.tid, NGT = F.G * NWAVES * 64;
    {
        LAS float* scr = (LAS float*)(F.lds + RING_OFF + F.wave * 16384);
        constexpr int I_IN = (D / 64) * (DIN / 32), I_OUT = (D / 64) * (D / 32), I_POOL = (512 / 64) * (512 / 32), I_UP = (D / 64) * (DUP / 32), I_DOWN = (DFF / 64) * (D / 32);
        constexpr int NITEMS = 2 * I_IN + 2 * I_OUT + 8 * I_POOL + 4 * I_UP + 4 * I_DOWN;
        bf16* WIN = (bf16*)(F.ws + WS_WIN); bf16* WOUT = (bf16*)(F.ws + WS_WOUT); bf16* WPOOL = (bf16*)(F.ws + WS_WPOOL); bf16* WUP = (bf16*)(F.ws + WS_WUP); bf16* WDOWN = (bf16*)(F.ws + WS_WDOWN);
        for (int it = gw; it < NITEMS; it += NGW) {
            int r = it;
            if (r < 4 * I_UP) { const int l = r / I_UP; p0_transpose_item_up((F.ka->in[I_WUP]) + (size_t)l * D * DUP, WUP + (size_t)l * DUP * D, scr, r % I_UP, F.lane); continue; } r -= 4 * I_UP;
            if (r < 4 * I_DOWN) { const int l = r / I_DOWN; p0_transpose_item((F.ka->in[I_WDOWN]) + (size_t)l * DFF * D, DFF, D, WDOWN + (size_t)l * D * LDF, scr, r % I_DOWN, F.lane, LDF); continue; } r -= 4 * I_DOWN;
            if (r < 2 * I_IN) { const int l = r / I_IN; p0_transpose_item((F.ka->in[I_WIN]) + (size_t)l * D * DIN, D, DIN, WIN + (size_t)l * DINP * D, scr, r % I_IN, F.lane); continue; } r -= 2 * I_IN;
            if (r < 2 * I_OUT) { const int l = r / I_OUT; p0_transpose_item((F.ka->in[I_WOUT]) + (size_t)l * D * D, D, D, WOUT + (size_t)l * D * D, scr, r % I_OUT, F.lane); continue; } r -= 2 * I_OUT;
            { const int l = r / I_POOL; p0_transpose_item((F.ka->in[I_POOLW]) + (size_t)l * 512 * 512, 512, 512, WPOOL + (size_t)l * 512 * 512, scr, r % I_POOL, F.lane); }
        }
        constexpr int ZV = (DINP - DIN) * D / 8;
        for (int i = gt; i < 2 * ZV; i += NGT) { const int l = i / ZV, j = i % ZV; *(GAS v4u*)(WIN + (size_t)l * DINP * D + (size_t)DIN * D + (size_t)j * 8) = (v4u){0u, 0u, 0u, 0u}; }
    }
    if (blockIdx.x == 0) {
        float* rc = (float*)(F.ws + WS_ROPE); float* rs = rc + 64 * 16;
        for (int i = F.tid; i < 64 * 16; i += NWAVES * 64) { const int pos = i >> 4, f = i & 15; const float inv = powf(10000.0f, -(float)f / 16.0f); const float ang = (float)pos * inv; rc[i] = cosf(ang); rs[i] = sinf(ang); }
    }
    __syncthreads();
    {
        LAS float* S = (LAS float*)(F.lds + RING_OFF);
        LAS float* RED = (LAS float*)(F.lds + RING_OFF + 40960);
        float* MOD = (float*)(F.ws + WS_MOD);
        constexpr int NTASK = DEPTH * (MODW / 256);
        if ((int)blockIdx.x < NTASK) {
            for (int i = F.tid; i < 5 * D; i += NWAVES * 64) { const int r = i / D, k = i % D; const float v = r < 4 ? (F.ka->in[I_C])[r * D + k] : (F.ka->in[I_CCTX])[k]; S[i] = v / (1.0f + __expf(-v)); }
            __syncthreads();
            for (int t = blockIdx.x; t < NTASK; t += F.G) {
                const int l = t / (MODW / 256), n0 = (t % (MODW / 256)) * 256, k0 = F.wave * 256;
                float acc[5][4];
#pragma unroll
                for (int r = 0; r < 5; ++r)
#pragma unroll
                    for (int cc = 0; cc < 4; ++cc) acc[r][cc] = 0.f;
                const float* Wp = (F.ka->in[I_WMOD]) + ((size_t)l * D + k0) * MODW + n0 + 4 * F.lane;
                for (int kk = 0; kk < 256; kk += 8) {
                    f32x4 wv[8];
#pragma unroll
                    for (int u = 0; u < 8; ++u) wv[u] = *(const f32x4*)(Wp + (size_t)(kk + u) * MODW);
#pragma unroll
                    for (int u = 0; u < 8; ++u)
#pragma unroll
                        for (int r = 0; r < 5; ++r) { const float s = S[r * D + k0 + kk + u];
#pragma unroll
                            for (int cc = 0; cc < 4; ++cc) acc[r][cc] = fmaf(s, wv[u][cc], acc[r][cc]); }
                }
#pragma unroll
                for (int r = 0; r < 5; ++r)
#pragma unroll
                    for (int cc = 0; cc < 4; ++cc) RED[(F.wave * 5 + r) * 256 + 4 * F.lane + cc] = acc[r][cc];
                __syncthreads();
                for (int o = F.tid; o < 5 * 256; o += NWAVES * 64) { const int r = o >> 8, ci = o & 255; float s = (F.ka->in[I_BMOD])[l * MODW + n0 + ci];
#pragma unroll
                    for (int w = 0; w < 8; ++w) s += RED[(w * 5 + r) * 256 + ci];
                    MOD[((size_t)l * 5 + r) * MODW + n0 + ci] = s; }
                __syncthreads();
            }
        }
    }
}

__device__ __forceinline__ f32x4 bf4_unpack(v2u h) { f32x4 r; r.x = pg8::h_lo(h.x); r.y = pg8::h_hi(h.x); r.z = pg8::h_lo(h.y); r.w = pg8::h_hi(h.y); return r; }
template <bool L16, bool CPY, bool CI>
__device__ __forceinline__ void norm_rows(Frame& F, const int ra, const int rb, const void* src, const int rbase, const float* g, const float* modl, const int off_sh, const int off_sc, const int nparts) {
    if (ra >= rb) return;
    bf16* H = (bf16*)(F.ws + WS_H);
    f32x4 gm[8], sh[8]; int cb = -1;
    f32x4 v[8], w[8]; v2u hv[8], hw[8];
#define NORM_P32(m) ((const f32x4*)((const float*)src + (size_t)((m) - rbase) * D) + F.lane)
#define NORM_P16(m) ((const v2u*)((const bf16*)src + (size_t)((m) - rbase) * D) + F.lane)
    if constexpr (L16) { const v2u* xr = NORM_P16(ra);
#pragma unroll
        for (int j = 0; j < 8; ++j) hv[j] = xr[64 * j];
    } else { const f32x4* xr = NORM_P32(ra);
#pragma unroll
        for (int j = 0; j < 8; ++j) v[j] = xr[64 * j]; }
    for (int m = ra; m < rb; ++m) {
        if (m + 1 < rb) {
            if constexpr (L16) { const v2u* xn = NORM_P16(m + 1);
#pragma unroll
                for (int j = 0; j < 8; ++j) hw[j] = xn[64 * j];
            } else { const f32x4* xn = NORM_P32(m + 1);
#pragma unroll
                for (int j = 0; j < 8; ++j) w[j] = xn[64 * j]; } }
        const int bidx = m < MLAT ? (m >> 12) : 4;
        if (bidx != cb) { cb = bidx;
            const f32x4* gp = (const f32x4*)g + F.lane; const f32x4* shp = (const f32x4*)(modl + (size_t)bidx * MODW + off_sh) + F.lane; const f32x4* scp = (const f32x4*)(modl + (size_t)bidx * MODW + off_sc) + F.lane;
#pragma unroll
            for (int j = 0; j < 8; ++j) { gm[j] = gp[64 * j] * (scp[64 * j] + 1.0f); sh[j] = shp[64 * j]; } }
        if constexpr (L16) {
#pragma unroll
            for (int j = 0; j < 8; ++j) v[j] = bf4_unpack(hv[j]); }
        if constexpr (CI) {
            for (int k = 0; k < nparts; ++k) { const f32x4* pp = (const f32x4*)((const float*)(F.ws + WS_PART) + ((size_t)k * MCTX + (size_t)(m - rbase)) * D) + F.lane;
#pragma unroll
                for (int j = 0; j < 8; ++j) v[j] = v[j] + pp[64 * j]; }
            f32x4* xw = (f32x4*)((float*)(F.ws + WS_XR) + (size_t)m * D) + F.lane;
#pragma unroll
            for (int j = 0; j < 8; ++j) xw[64 * j] = v[j]; }
        float s = 0.f;
#pragma unroll
        for (int j = 0; j < 8; ++j) s += (v[j].x * v[j].x + v[j].y * v[j].y) + (v[j].z * v[j].z + v[j].w * v[j].w);
        const float r = 1.0f / sqrtf(wave_sum(s) * (1.0f / D) + EPS);
        v2u* o8 = (v2u*)(H + (size_t)m * D) + F.lane;
#pragma unroll
        for (int j = 0; j < 8; ++j) { const f32x4 y = v[j] * r * gm[j] + sh[j]; v2u ww; ww.x = pk2h(y.x, y.y); ww.y = pk2h(y.z, y.w); o8[64 * j] = ww; }
        if constexpr (CPY) { v2u* c8 = (v2u*)((bf16*)(F.ws + WS_X16) + (size_t)m * D) + F.lane;
#pragma unroll
            for (int j = 0; j < 8; ++j) { v2u ww; ww.x = pg8::pk_h2(v[j].x, v[j].y); ww.y = pg8::pk_h2(v[j].z, v[j].w); c8[64 * j] = ww; } }
        if constexpr (L16) {
#pragma unroll
            for (int j = 0; j < 8; ++j) hv[j] = hw[j];
        } else {
#pragma unroll
            for (int j = 0; j < 8; ++j) v[j] = w[j]; }
    }
#undef NORM_P32
#undef NORM_P16
}
__device__ __forceinline__ void ph_norm(Frame& F, int nrows, const float* xl32, const float* xc, const float* g, const float* modl, int off_sh, int off_sc, int nparts) {
    const int gw = F.vcu * NWAVES + F.wave; int NGW = F.G * NWAVES; asm volatile("" : "+s"(NGW));
    const int nctx = nrows - MLAT;
    const int r0 = (int)((unsigned)gw * (unsigned)MLAT / (unsigned)NGW), r1 = (int)((unsigned)(gw + 1) * (unsigned)MLAT / (unsigned)NGW);
    const int c0 = MLAT + (int)((unsigned)gw * (unsigned)nctx / (unsigned)NGW), c1 = MLAT + (int)((unsigned)(gw + 1) * (unsigned)nctx / (unsigned)NGW);
    if (xl32) { norm_rows<false, true, false>(F, r0, r1, xl32, 0, g, modl, off_sh, off_sc, 0); norm_rows<false, false, false>(F, c0, c1, xc, MLAT, g, modl, off_sh, off_sc, 0); }
    else      { norm_rows<true, false, false>(F, r0, r1, F.ws + WS_X16, 0, g, modl, off_sh, off_sc, 0); norm_rows<false, false, true>(F, c0, c1, xc, MLAT, g, modl, off_sh, off_sc, nparts); }
}
__device__ __forceinline__ void ph_final(Frame& F) {
    const int gw = F.vcu * NWAVES + F.wave, NGW = F.G * NWAVES;
    const bf16* X16 = (const bf16*)(F.ws + WS_X16);
    const int r0 = (int)((long)gw * MLAT / NGW), r1 = (int)((long)(gw + 1) * MLAT / NGW);
    if (r0 >= r1) return;
    f32x4 gf[8], v[8]; v2u hv[8], hw[8];
    { const f32x4* gp = (const f32x4*)(F.ka->in[I_FING]) + F.lane; const v2u* xr = (const v2u*)(X16 + (size_t)r0 * D) + F.lane;
#pragma unroll
      for (int j = 0; j < 8; ++j) { gf[j] = gp[64 * j]; hv[j] = xr[64 * j]; } }
    for (int m = r0; m < r1; ++m) {
        if (m + 1 < r1) { const v2u* xn = (const v2u*)(X16 + (size_t)(m + 1) * D) + F.lane;
#pragma unroll
            for (int j = 0; j < 8; ++j) hw[j] = xn[64 * j]; }
#pragma unroll
        for (int j = 0; j < 8; ++j) v[j] = bf4_unpack(hv[j]);
        float s = 0.f;
#pragma unroll
        for (int j = 0; j < 8; ++j) s += (v[j].x * v[j].x + v[j].y * v[j].y) + (v[j].z * v[j].z + v[j].w * v[j].w);
        const float r = 1.0f / sqrtf(wave_sum(s) * (1.0f / D) + EPS);
        f32x4* op = (f32x4*)((F.ka->out) + (size_t)m * D) + F.lane;
#pragma unroll
        for (int j = 0; j < 8; ++j) __builtin_nontemporal_store(v[j] * r * gf[j], op + 64 * j);
#pragma unroll
        for (int j = 0; j < 8; ++j) hv[j] = hw[j];
    }
}
template <int HW>
__device__ __forceinline__ void pool_strip(const bf16* H, bf16* HP, int m0, int t0, int L, int c8) {
    constexpr int NR = 8 + 2 * HW - 1;
    v4u R[NR];
#pragma unroll
    for (int j = 0; j < NR; ++j) { const int tr = t0 - HW + j; R[j] = (v4u){0u, 0u, 0u, 0u}; if (tr >= 0 && tr < L) R[j] = *(const v4u*)(H + (size_t)(m0 - HW + j) * D + c8); }
    float s[8];
#pragma unroll
    for (int e = 0; e < 8; ++e) s[e] = 0.f;
#pragma unroll
    for (int j = 0; j < 2 * HW; ++j) { s[0] += bflo(R[j].x); s[1] += bfhi(R[j].x); s[2] += bflo(R[j].y); s[3] += bfhi(R[j].y); s[4] += bflo(R[j].z); s[5] += bfhi(R[j].z); s[6] += bflo(R[j].w); s[7] += bfhi(R[j].w); }
#pragma unroll
    for (int r = 0; r < 8; ++r) {
        const int t = t0 + r; const float inv = __builtin_amdgcn_rcpf((float)(min(t + HW, L) - max(t - HW, 0)));
        const v4u w = R[r + HW];
        v4u o; o.x = pk2h(s[0] * inv - bflo(w.x), s[1] * inv - bfhi(w.x)); o.y = pk2h(s[2] * inv - bflo(w.y), s[3] * inv - bfhi(w.y));
        o.z = pk2h(s[4] * inv - bflo(w.z), s[5] * inv - bfhi(w.z)); o.w = pk2h(s[6] * inv - bflo(w.w), s[7] * inv - bfhi(w.w));
        *(v4u*)(HP + (size_t)(m0 + r) * D + c8) = o;
        if (r < 7) { const v4u a = R[r + 2 * HW], b = R[r];
            s[0] += bflo(a.x) - bflo(b.x); s[1] += bfhi(a.x) - bfhi(b.x); s[2] += bflo(a.y) - bflo(b.y); s[3] += bfhi(a.y) - bfhi(b.y);
            s[4] += bflo(a.z) - bflo(b.z); s[5] += bfhi(a.z) - bfhi(b.z); s[6] += bflo(a.w) - bflo(b.w); s[7] += bfhi(a.w) - bfhi(b.w); }
    }
}
__device__ __forceinline__ void ph_pool(Frame& F, int nrows) {
    const int gt = F.vcu * NWAVES * 64 + F.tid, NGT = F.G * NWAVES * 64;
    const bf16* H = (const bf16*)(F.ws + WS_H); bf16* HP = (bf16*)(F.ws + WS_MIX);
    const int nitems = (nrows / 8) * (D / 8);
    for (int it = gt; it < nitems; it += NGT) {
        const int strip = it >> 8, c8 = (it & 255) * 8, gi = __builtin_amdgcn_readfirstlane(c8 >> 9), m0 = strip * 8;
        int t0, L;
        if (m0 < MLAT) { t0 = m0 & (SEQ - 1); L = SEQ; } else { t0 = (m0 - MLAT) & (CTXL - 1); L = CTXL; }
        if (gi == 0) pool_strip<1>(H, HP, m0, t0, L, c8); else if (gi == 1) pool_strip<2>(H, HP, m0, t0, L, c8); else if (gi == 2) pool_strip<4>(H, HP, m0, t0, L, c8); else pool_strip<8>(H, HP, m0, t0, L, c8);
    }
}
__device__ __forceinline__ void ph_glufix(Frame& F, int nrows, const float* cw, const float* cb) {
    const int gt = F.vcu * NWAVES * 64 + F.tid, NGT = F.G * NWAVES * 64;
    const float* SB = (const float*)(F.ws + WS_SB); bf16* ACT = (bf16*)(F.ws + WS_ACT);
    constexpr int C4 = DFF / 4;
    const int nitems = (nrows / 256) * 2 * C4;
    for (int it = gt; it < nitems; it += NGT) {
        const int c4 = (it % C4) * 4, pw = it / C4, which = pw & 1, pm = pw >> 1, row = 256 * pm + (which ? 255 : 0);
        int t, L;
        if (row < MLAT) { t = row & (SEQ - 1); L = SEQ; } else { t = (row - MLAT) & (CTXL - 1); L = CTXL; }
        const float* sb = SB + ((size_t)(pm * 2 + which) * 3) * DFF + c4;
        f32x4 cv = *(const f32x4*)sb; const f32x4 vl = *(const f32x4*)(sb + DFF);
        if (which == 0 && t > 0)     cv = cv + *(const f32x4*)(cw + c4) * *(const f32x4*)(SB + ((size_t)((pm - 1) * 2 + 1) * 3 + 2) * DFF + c4);
        if (which == 1 && t < L - 1) cv = cv + *(const f32x4*)(cw + 2 * DFF + c4) * *(const f32x4*)(SB + ((size_t)((pm + 1) * 2 + 0) * 3 + 2) * DFF + c4);
        const pg8::f32x2 g0 = pg8::gelu_pk((pg8::f32x2){cv.x, cv.y}), g1 = pg8::gelu_pk((pg8::f32x2){cv.z, cv.w});
        v2u o; o.x = pk2h(g0.x * vl.x, g0.y * vl.y); o.y = pk2h(g1.x * vl.z, g1.y * vl.w);
        *(v2u*)(ACT + (size_t)row * LDF + c4) = o;
    }
}

namespace gla {
typedef short bf16x8 __attribute__((ext_vector_type(8)));
typedef float f32x16 __attribute__((ext_vector_type(16)));
typedef unsigned u32x4 __attribute__((ext_vector_type(4)));
constexpr int NRC = MR / 64;
constexpr int PITCH = 72;
__device__ __forceinline__ int crow(int r, int hi) { return (r & 3) + 8 * (r >> 2) + 4 * hi; }
__device__ __forceinline__ unsigned cvtpk(float lo, float hi) { unsigned r; asm volatile("v_cvt_pk_bf16_f32 %0, %1, %2" : "=v"(r) : "v"(lo), "v"(hi)); return r; }
__device__ __forceinline__ int chain_slot_rc(int b, int dir, int s) { return s < 4 ? 256 + 4 * b + (dir ? 3 - s : s) : 64 * b + (dir ? 63 - (s - 4) : s - 4); }
__device__ __forceinline__ int rc_slot(int rc, int dir) { return rc < 256 ? 4 + (dir ? 63 - (rc & 63) : (rc & 63)) : (dir ? 3 - (rc & 3) : (rc & 3)); }
__device__ __forceinline__ int rc_batch(int rc) { return rc < 256 ? rc >> 6 : (rc - 256) >> 2; }
__device__ __forceinline__ float logsig16(float z2) { return (fminf(z2, 0.f) - __builtin_amdgcn_logf(1.0f + __builtin_amdgcn_exp2f(-fabsf(z2)))) * (1.0f / 16.0f); }

__device__ __forceinline__ void ph_prep(Frame& F, int e) {
    const bf16* P = (const bf16*)(F.ws + WS_P);
    bf16* QF = (bf16*)(F.ws + WS_QF); bf16* KF = (bf16*)(F.ws + WS_KF); bf16* QB = (bf16*)(F.ws + WS_QB); bf16* KB = (bf16*)(F.ws + WS_KB);
    float* AL = (float*)(F.ws + WS_AL);
    const float* ropec = (const float*)(F.ws + WS_ROPE); const float* ropes = ropec + 64 * 16;
    const float* w2 = (F.ka->in[I_WG2]) + (size_t)e * 2 * 16 * 512; const float* bg = (F.ka->in[I_BG]) + (size_t)e * 2 * 512;
    LAS float* ABf = (LAS float*)(F.lds + RING_OFF);
    LAS float* RTc = (LAS float*)(F.lds + RING_OFF + 8192); LAS float* RTs = RTc + 64 * 16;
    for (int i = F.tid; i < 2 * 64 * 16; i += NWAVES * 64) RTc[i] = ropec[i];
    const int dk = F.lane;
    pg8::f32x2 wfb[16], bfb; int col;
    const int hf = dk >> 5, f = dk & 15; const float sgn = ((dk >> 4) & 1) ? 1.0f : -1.0f;
#define GLA_Z(t, zf, zb) do { const LAS f32x4* ap = (const LAS f32x4*)(ABf + (t) * 32); pg8::f32x2 z2 = bfb; \
        _Pragma("unroll") for (int i = 0; i < 8; ++i) { const f32x4 a = ap[i]; z2 = (pg8::f32x2){a.x, a.y} * wfb[2 * i] + z2; z2 = (pg8::f32x2){a.z, a.w} * wfb[2 * i + 1] + z2; } \
        zf = z2.x; zb = z2.y; } while (0)
    const int NT = 256 + (NRC - 256) * 8;
    for (int task = blockIdx.x; task < NT; task += F.G) {
        const int rc = task < 256 ? task : 256 + ((task - 256) >> 3), h = task < 256 ? F.wave : ((task - 256) & 7);
        const bool active = task < 256 || F.wave == 0;
        const bool lat = rc < 256;
        const bf16* Prow0 = P + (size_t)rc * 64 * DINP;
        col = 64 * h + dk;
#pragma unroll
        for (int i = 0; i < 16; ++i) wfb[i] = (pg8::f32x2){w2[i * 512 + col], w2[(16 + i) * 512 + col]} * 1.4426950408889634f;
        bfb = (pg8::f32x2){bg[col], bg[512 + col]} * 1.4426950408889634f;
        __syncthreads();
        if (F.tid < 256) { const int row = F.tid >> 2, part = F.tid & 3; const v4u w = *(const v4u*)(Prow0 + (size_t)row * DINP + C_AB + 8 * part);
            LAS float* d = ABf + row * 32 + 16 * (part & 1) + (part >> 1);
            d[0] = bflo(w.x); d[2] = bfhi(w.x); d[4] = bflo(w.y); d[6] = bfhi(w.y); d[8] = bflo(w.z); d[10] = bfhi(w.z); d[12] = bflo(w.w); d[14] = bfhi(w.w); }
        __syncthreads();
        if (!active) continue;
        const int prw = rc & 63;
        float pf = 0.f, pbx = 0.f;
        for (int t8 = 0; t8 < 64; t8 += 8) {
            float qv[8], kv[8];
#pragma unroll
            for (int tt = 0; tt < 8; ++tt) { const bf16* prow = Prow0 + (size_t)(t8 + tt) * DINP; qv[tt] = bf2f(prow[C_QB + col]); kv[tt] = bf2f(prow[C_KB + col]); }
#pragma unroll
            for (int tt = 0; tt < 8; ++tt) {
                const int t = t8 + tt;
                float zf, zb; GLA_Z(t, zf, zb);
                const float gf = logsig16(zf), gb = logsig16(zb);
                pf += gf; const float cumf = pf, pbe = pbx; pbx += gb;
                float q = qv[tt], k = kv[tt];
                const float qp = __shfl_xor(q, 16), kp = __shfl_xor(k, 16);
                if (lat) { const int ri = (hf ? t : prw) * 16 + f; const float c = RTc[ri], s = RTs[ri];
                    const float ss = s * sgn; q = fmaf(qp, ss, q * c); k = fmaf(kp, ss, k * c); }
                q *= 0.125f;
                const unsigned o = (unsigned)((rc * 64 + t) * 512 + col);
                const unsigned wq = pg8::cvt_pk_bf16(q * __builtin_amdgcn_exp2f(cumf), q * __builtin_amdgcn_exp2f(fminf(-pbe, 115.f))), wk = pg8::cvt_pk_bf16(k * __builtin_amdgcn_exp2f(fminf(-cumf, 115.f)), k * __builtin_amdgcn_exp2f(pbe));
                QF[o] = (bf16)(wq & 0xffffu); QB[o] = (bf16)(wq >> 16); KF[o] = (bf16)(wk & 0xffffu); KB[o] = (bf16)(wk >> 16);
            }
        }
        AL[(size_t)(0 * NRC + rc) * 512 + col] = __builtin_amdgcn_exp2f(pf); AL[(size_t)(1 * NRC + rc) * 512 + col] = __builtin_amdgcn_exp2f(pbx);
    }
#undef GLA_Z
    __syncthreads();
}

__device__ __forceinline__ void stage_vt(Frame& F, const bf16* P, int rc, int h, LAS bf16* VT) {
    const int tp = (F.tid & 31) * 2, d8 = (F.tid >> 5) * 8;
    const bf16* src = P + (size_t)(rc * 64 + tp) * DINP + C_VB + 128 * h + d8;
    const v4u w0 = *(const v4u*)src, w1 = *(const v4u*)(src + DINP);
    LAS unsigned* dst = (LAS unsigned*)(VT + d8 * PITCH + tp);
    dst[0 * (PITCH / 2)] = (w0.x & 0xffffu) | (w1.x << 16); dst[1 * (PITCH / 2)] = (w0.x >> 16) | (w1.x & 0xffff0000u);
    dst[2 * (PITCH / 2)] = (w0.y & 0xffffu) | (w1.y << 16); dst[3 * (PITCH / 2)] = (w0.y >> 16) | (w1.y & 0xffff0000u);
    dst[4 * (PITCH / 2)] = (w0.z & 0xffffu) | (w1.z << 16); dst[5 * (PITCH / 2)] = (w0.z >> 16) | (w1.z & 0xffff0000u);
    dst[6 * (PITCH / 2)] = (w0.w & 0xffffu) | (w1.w << 16); dst[7 * (PITCH / 2)] = (w0.w >> 16) | (w1.w & 0xffff0000u);
}
#define GLA_BAR() do { asm volatile("s_waitcnt lgkmcnt(0)" ::: "memory"); __builtin_amdgcn_s_barrier(); asm volatile("" ::: "memory"); } while (0)
#define GLA_FRAG(base, row, col) (*(const LAS bf16x8*)((base) + (row) * PITCH + (col)))

__device__ __forceinline__ void ph_g1(Frame& F) {
    const bf16* P = (const bf16*)(F.ws + WS_P); const bf16* KFg = (const bf16*)(F.ws + WS_KF); const bf16* KBg = (const bf16*)(F.ws + WS_KB); bf16* UT = (bf16*)(F.ws + WS_UT); const float* AL = (const float*)(F.ws + WS_AL);
    LAS bf16* VT = (LAS bf16*)(F.lds + RING_OFF); LAS bf16* KH0 = VT + 128 * PITCH; LAS bf16* KH1 = KH0 + 64 * PITCH;
    const int r32 = F.lane & 31, hi = F.lane >> 5, dir = F.wave >> 2, db = F.wave & 3;
    for (int u = blockIdx.x; u < NRC * 8; u += F.G) {
        const int rc = u >> 3, h = u & 7;
        __syncthreads();
        stage_vt(F, P, rc, h, VT);
        {
            const int half = F.tid >> 8, tl = F.tid & 255, tp = (tl & 31) * 2, d8 = (tl >> 5) * 8;
            const bf16* src = (half ? KBg : KFg) + (size_t)(rc * 64 + tp) * 512 + 64 * h + d8;
            const v4u w0 = *(const v4u*)src, w1 = *(const v4u*)(src + 512);
            LAS unsigned* dst = (LAS unsigned*)((half ? KH1 : KH0) + d8 * PITCH + tp);
            dst[0 * (PITCH / 2)] = (w0.x & 0xffffu) | (w1.x << 16); dst[1 * (PITCH / 2)] = (w0.x >> 16) | (w1.x & 0xffff0000u);
            dst[2 * (PITCH / 2)] = (w0.y & 0xffffu) | (w1.y << 16); dst[3 * (PITCH / 2)] = (w0.y >> 16) | (w1.y & 0xffff0000u);
            dst[4 * (PITCH / 2)] = (w0.z & 0xffffu) | (w1.z << 16); dst[5 * (PITCH / 2)] = (w0.z >> 16) | (w1.z & 0xffff0000u);
            dst[6 * (PITCH / 2)] = (w0.w & 0xffffu) | (w1.w << 16); dst[7 * (PITCH / 2)] = (w0.w >> 16) | (w1.w & 0xffff0000u); }
        __syncthreads();
        const LAS bf16* KH = dir ? KH1 : KH0;
        f32x16 acc0 = {}, acc1 = {};
#pragma unroll
        for (int ks = 0; ks < 4; ++ks) { const bf16x8 a = GLA_FRAG(VT, 32 * db + r32, 16 * ks + 8 * hi);
            acc0 = __builtin_amdgcn_mfma_f32_32x32x16_bf16(a, GLA_FRAG(KH, r32, 16 * ks + 8 * hi), acc0, 0, 0, 0);
            acc1 = __builtin_amdgcn_mfma_f32_32x32x16_bf16(a, GLA_FRAG(KH, 32 + r32, 16 * ks + 8 * hi), acc1, 0, 0, 0); }
        const int b = rc_batch(rc), chain = (b * 8 + h) * 2 + dir, slot = rc_slot(rc, dir);
        if (dir == 0) { const float a0 = AL[(size_t)rc * 512 + 64 * h + r32], a1 = AL[(size_t)rc * 512 + 64 * h + 32 + r32];
#pragma unroll
            for (int r = 0; r < 16; ++r) { acc0[r] *= a0; acc1[r] *= a1; } }
        bf16* dst = UT + ((size_t)chain * 68 + slot) * 8192;
#pragma unroll
        for (int r = 0; r < 16; ++r) { const int dv = 32 * db + crow(r, hi); const unsigned w2_ = pk2(acc0[r], acc1[r]); dst[dv * 64 + r32] = (bf16)(w2_ & 0xffffu); dst[dv * 64 + 32 + r32] = (bf16)(w2_ >> 16); }
    }
    __syncthreads();
}

__device__ __forceinline__ void ph_g2(Frame& F) {
    const int gt = F.vcu * NWAVES * 64 + F.tid, NGT = F.G * NWAVES * 64;
    const bf16* UT = (const bf16*)(F.ws + WS_UT); bf16* ST = (bf16*)(F.ws + WS_ST); const float* AL = (const float*)(F.ws + WS_AL);
    for (int it = gt; it < 64 * 128 * 16; it += NGT) {
        const int chain = it >> 11, rem = it & 2047, dv = rem >> 4, dk4 = (rem & 15) * 4;
        const int dir = chain & 1, h = (chain >> 1) & 7, b = chain >> 4;
        float S0 = 0.f, S1 = 0.f, S2 = 0.f, S3 = 0.f;
        const size_t base = (size_t)chain * 68 * 8192 + dv * 64 + dk4;
#pragma unroll 17
        for (int s = 0; s < 68; ++s) {
            const v2u uw = *(const v2u*)(UT + base + (size_t)s * 8192);
            const int rc = chain_slot_rc(b, dir, s);
            const f32x4 a = *(const f32x4*)(AL + (size_t)(dir * NRC + rc) * 512 + 64 * h + dk4);
            v2u o; if (dir) { o.x = pk2(S0 * a.x, S1 * a.y); o.y = pk2(S2 * a.z, S3 * a.w); } else { o.x = pk2(S0, S1); o.y = pk2(S2, S3); }
            *(v2u*)(ST + base + (size_t)s * 8192) = o;
            S0 = fmaf(a.x, S0, bflo(uw.x)); S1 = fmaf(a.y, S1, bfhi(uw.x)); S2 = fmaf(a.z, S2, bflo(uw.y)); S3 = fmaf(a.w, S3, bfhi(uw.y));
        }
    }
}

#define GLA_PK4(P, BASE, OUT) do { unsigned a0 = pk2(P[BASE + 0], P[BASE + 1]), a1 = pk2(P[BASE + 2], P[BASE + 3]);   \
    unsigned b0 = pk2(P[BASE + 4], P[BASE + 5]), b1 = pk2(P[BASE + 6], P[BASE + 7]);                              \
    auto r0 = __builtin_amdgcn_permlane32_swap(a0, b0, false, false); auto r1 = __builtin_amdgcn_permlane32_swap(a1, b1, false, false); \
    u32x4 w = {r0[0], r1[0], r0[1], r1[1]}; OUT = *reinterpret_cast<bf16x8*>(&w); } while (0)
template <int DIR>
__device__ __forceinline__ void g3_intra(f32x16& o, const LAS bf16* Kt, const LAS bf16* Qt, const LAS bf16* VT, int jb, int tb, int db, int r32, int hi) {
    f32x16 X = {};
#pragma unroll
    for (int ks = 0; ks < 4; ++ks) X = __builtin_amdgcn_mfma_f32_32x32x16_bf16(GLA_FRAG(Kt, 32 * jb + r32, 16 * ks + 8 * hi), GLA_FRAG(Qt, 32 * tb + r32, 16 * ks + 8 * hi), X, 0, 0, 0);
    if (jb == tb) {
#pragma unroll
        for (int r = 0; r < 16; ++r) { const int tj = crow(r, hi); const bool keep = DIR ? (tj >= r32) : (tj <= r32); X[r] = keep ? X[r] : 0.f; }
    }
    bf16x8 x0, x1; GLA_PK4(X, 0, x0); GLA_PK4(X, 8, x1);
    o = __builtin_amdgcn_mfma_f32_32x32x16_bf16(GLA_FRAG(VT, 32 * db + r32, 32 * jb + 8 * hi), x0, o, 0, 0, 0);
    o = __builtin_amdgcn_mfma_f32_32x32x16_bf16(GLA_FRAG(VT, 32 * db + r32, 32 * jb + 16 + 8 * hi), x1, o, 0, 0, 0);
}
__device__ __forceinline__ void ph_g3(Frame& F, int e, int nrc) {
    const bf16* P = (const bf16*)(F.ws + WS_P); const bf16* ST = (const bf16*)(F.ws + WS_ST); bf16* MIX = (bf16*)(F.ws + WS_MIX);
    const bf16* QFg = (const bf16*)(F.ws + WS_QF); const bf16* KFg = (const bf16*)(F.ws + WS_KF); const bf16* QBg = (const bf16*)(F.ws + WS_QB); const bf16* KBg = (const bf16*)(F.ws + WS_KB);
    const float* gg = (F.ka->in[I_GLAG]) + (size_t)e * 8 * 128;
    LAS bf16* VT = (LAS bf16*)(F.lds + RING_OFF); LAS bf16* QFl = VT + 128 * PITCH; LAS bf16* KFl = QFl + 64 * PITCH; LAS bf16* QBl = KFl + 64 * PITCH; LAS bf16* KBl = QBl + 64 * PITCH;
    LAS float* SS = (LAS float*)(KBl + 64 * PITCH);
    const int r32 = F.lane & 31, hi = F.lane >> 5, tb = F.wave & 1, db = F.wave >> 1;
    const int s_tp = (F.tid & 31) * 2, s_d8 = (F.tid >> 5) * 8, s_t = F.tid >> 3, s_c8 = (F.tid & 7) * 8;
    v4u pv0, pv1, pqf, pkf, pqb, pkb; bf16x8 nsf[4], nsb[4];
#define G3_LOAD(uu) do { const int _rc = (uu) >> 3, _h = (uu) & 7, _b = rc_batch(_rc); \
        const bf16* _vs = P + (size_t)(_rc * 64 + s_tp) * DINP + C_VB + 128 * _h + s_d8; pv0 = *(const v4u*)_vs; pv1 = *(const v4u*)(_vs + DINP); \
        const size_t _go = (size_t)(_rc * 64 + s_t) * 512 + 64 * _h + s_c8; pqf = *(const v4u*)(QFg + _go); pkf = *(const v4u*)(KFg + _go); pqb = *(const v4u*)(QBg + _go); pkb = *(const v4u*)(KBg + _go); \
        const bf16* _sf = ST + ((size_t)((_b * 8 + _h) * 2 + 0) * 68 + rc_slot(_rc, 0)) * 8192 + (size_t)(32 * db + r32) * 64 + 8 * hi; \
        const bf16* _sb = ST + ((size_t)((_b * 8 + _h) * 2 + 1) * 68 + rc_slot(_rc, 1)) * 8192 + (size_t)(32 * db + r32) * 64 + 8 * hi; \
        _Pragma("unroll") for (int ks = 0; ks < 4; ++ks) { nsf[ks] = *(const bf16x8*)(_sf + 16 * ks); nsb[ks] = *(const bf16x8*)(_sb + 16 * ks); } } while (0)
    int u = blockIdx.x;
    if (u < nrc * 8) G3_LOAD(u);
    for (; u < nrc * 8; u += F.G) {
        const int rc = u >> 3, h = u & 7;
        GLA_BAR();
        { LAS unsigned* dst = (LAS unsigned*)(VT + s_d8 * PITCH + s_tp);
            dst[0 * (PITCH / 2)] = (pv0.x & 0xffffu) | (pv1.x << 16); dst[1 * (PITCH / 2)] = (pv0.x >> 16) | (pv1.x & 0xffff0000u);
            dst[2 * (PITCH / 2)] = (pv0.y & 0xffffu) | (pv1.y << 16); dst[3 * (PITCH / 2)] = (pv0.y >> 16) | (pv1.y & 0xffff0000u);
            dst[4 * (PITCH / 2)] = (pv0.z & 0xffffu) | (pv1.z << 16); dst[5 * (PITCH / 2)] = (pv0.z >> 16) | (pv1.z & 0xffff0000u);
            dst[6 * (PITCH / 2)] = (pv0.w & 0xffffu) | (pv1.w << 16); dst[7 * (PITCH / 2)] = (pv0.w >> 16) | (pv1.w & 0xffff0000u);
            const int lo = s_t * PITCH + s_c8;
            *(LAS v4u*)(QFl + lo) = pqf; *(LAS v4u*)(KFl + lo) = pkf; *(LAS v4u*)(QBl + lo) = pqb; *(LAS v4u*)(KBl + lo) = pkb; }
        bf16x8 sf[4], sb[4];
#pragma unroll
        for (int ks = 0; ks < 4; ++ks) { sf[ks] = nsf[ks]; sb[ks] = nsb[ks]; }
        GLA_BAR();
        if (u + F.G < nrc * 8) G3_LOAD(u + F.G);
        f32x16 o = {};
#pragma unroll
        for (int ks = 0; ks < 4; ++ks) { o = __builtin_amdgcn_mfma_f32_32x32x16_bf16(sf[ks], GLA_FRAG(QFl, 32 * tb + r32, 16 * ks + 8 * hi), o, 0, 0, 0);
            o = __builtin_amdgcn_mfma_f32_32x32x16_bf16(sb[ks], GLA_FRAG(QBl, 32 * tb + r32, 16 * ks + 8 * hi), o, 0, 0, 0); }
        if (tb == 0) { g3_intra<0>(o, KFl, QFl, VT, 0, 0, db, r32, hi); g3_intra<1>(o, KBl, QBl, VT, 0, 0, db, r32, hi); g3_intra<1>(o, KBl, QBl, VT, 1, 0, db, r32, hi); }
        else         { g3_intra<0>(o, KFl, QFl, VT, 0, 1, db, r32, hi); g3_intra<0>(o, KFl, QFl, VT, 1, 1, db, r32, hi); g3_intra<1>(o, KBl, QBl, VT, 1, 1, db, r32, hi); }
        float ss = 0.f;
#pragma unroll
        for (int r = 0; r < 16; ++r) ss = fmaf(o[r], o[r], ss);
        { auto rr = __builtin_amdgcn_permlane32_swap(__float_as_uint(ss), __float_as_uint(ss), false, false); ss = __uint_as_float(rr[0]) + __uint_as_float(rr[1]); }
        if (hi == 0) SS[db * 64 + 32 * tb + r32] = ss;
        GLA_BAR();
        const int t = 32 * tb + r32;
        const float tot = (SS[t] + SS[64 + t]) + (SS[128 + t] + SS[192 + t]);
        const float rn = __builtin_amdgcn_rsqf(tot * (1.0f / 128.0f) + EPS);
        const size_t row = (size_t)rc * 64 + t;
#pragma unroll
        for (int g4 = 0; g4 < 4; ++g4) { const int dv0 = 32 * db + 8 * g4 + 4 * hi;
            const v2u gw = *(const v2u*)(P + row * DINP + C_GB + 128 * h + dv0); const f32x4 gn = *(const f32x4*)(gg + 128 * h + dv0);
            const float g0 = bflo(gw.x), g1 = bfhi(gw.x), g2 = bflo(gw.y), g3 = bfhi(gw.y);
            const float y0 = o[4 * g4 + 0] * rn * gn.x * (g0 * __builtin_amdgcn_rcpf(1.0f + __expf(-g0))), y1 = o[4 * g4 + 1] * rn * gn.y * (g1 * __builtin_amdgcn_rcpf(1.0f + __expf(-g1)));
            const float y2 = o[4 * g4 + 2] * rn * gn.z * (g2 * __builtin_amdgcn_rcpf(1.0f + __expf(-g2))), y3 = o[4 * g4 + 3] * rn * gn.w * (g3 * __builtin_amdgcn_rcpf(1.0f + __expf(-g3)));
            v2u w; w.x = pk2(y0, y1); w.y = pk2(y2, y3);
            *(v2u*)(MIX + row * D + 1024 + 128 * h + dv0) = w; }
    }
#undef G3_LOAD
    __syncthreads();
}
#undef GLA_PK4
#undef GLA_FRAG
#undef GLA_BAR
}

constexpr int N_PHASES = 54;
__host__ __device__ constexpr bool phase_active(int id) {
    if (id == 0 || id == N_PHASES - 1) return true;
    const int L = (id - 1) / 13, k = (id - 1) % 13; const bool even = (L & 1) == 0;
    if (k == 1 || k == 8) return !even;
    if (k >= 2 && k <= 7) return even;
    return true;
}

__global__ void __launch_bounds__(NWAVES * 64, 2) fwd_kernel(Args args) {
    extern __shared__ __attribute__((aligned(16))) unsigned char lds[];
    Frame F;
    F.lds = (LAS unsigned char*)lds; F.ldsg = lds;
    F.MISC = (volatile LAS unsigned*)(F.lds + MISC_OFF);
    F.tid = threadIdx.x; F.lane = F.tid & 63; F.wave = __builtin_amdgcn_readfirstlane(F.tid >> 6);
    F.G = gridDim.x; { const int bx = blockIdx.x; F.vcu = (F.G % 8 == 0) ? (bx % 8) * (F.G / 8) + bx / 8 : bx; }
    F.ka = (KArgs)__builtin_amdgcn_kernarg_segment_ptr(); F.ws = F.ka->ws;
    for (int u = F.tid; u < (LDS_BYTES - LDSCTL_OFF) / 4; u += NWAVES * 64) ((LAS unsigned*)(F.lds + LDSCTL_OFF))[u] = 0u;
    __syncthreads();
    unsigned* barw = (unsigned*)(F.ws + WS_CTL) + CW_BAR;
    XcdBarrier bar = xcd_barrier_post(barw, F.MISC + 8);
    const int lo = args.ph_lo, hi = args.ph_hi;
    bool started = false;
#ifndef PH_MASK
#define PH_MASK 0xFFFFFFFFu
#endif
#ifndef PH_REP
#define PH_REP 0u
#endif
#define PHASE_BEGIN(id, kind) if (((PH_MASK >> (kind)) & 1u) && lo <= (id) && (id) < hi) { if (started) xcd_barrier(bar); started = true; for (int _rep = 0; _rep < (((PH_REP >> (kind)) & 1u) ? 2 : 1); ++_rep) { \
    { int _t = threadIdx.x; asm volatile("" : "+v"(_t)); F.tid = _t; F.lane = _t & 63; F.wave = __builtin_amdgcn_readfirstlane(_t >> 6); KArgs _k = (KArgs)__builtin_amdgcn_kernarg_segment_ptr(); asm volatile("" : "+s"(_k)); F.ka = _k; F.ws = _k->ws; }
#define PHASE_END } }

    PHASE_BEGIN(0, 0) ph_prologue(F); PHASE_END

    const float* MOD = (const float*)(F.ws + WS_MOD);
    for (int L = 0; L < DEPTH; ++L) {
        const int base = 1 + 13 * L; const bool even = (L & 1) == 0; const int e = L >> 1;
        const float* modl = MOD + (size_t)L * 5 * MODW;
#define XRc ((const float*)(F.ws + WS_XR) + (size_t)MLAT * D)
        const int rows_mix_in = (L <= 2) ? MR : MLAT;
        const int rows_upd = (L <= 1) ? MR : MLAT;

        PHASE_BEGIN(base + 0, 1) {
            ph_norm(F, rows_mix_in, L == 0 ? (F.ka->in[I_X]) : (const float*)nullptr, L == 0 ? (F.ka->in[I_CTX]) : XRc, (F.ka->in[I_N1G]) + (size_t)L * D, modl, 0, D, 4);
            if (L == 0) {
                const f32x4* cs = (const f32x4*)(F.ka->in[I_CTX]); f32x4* xd = (f32x4*)(F.ws + WS_XR) + (size_t)MLAT * D / 4;
                for (int i = F.vcu * NWAVES * 64 + F.tid; i < MCTX * D / 4; i += F.G * NWAVES * 64) xd[i] = cs[i];
            }
        } PHASE_END
        if (!even) {
            PHASE_BEGIN(base + 1, 2) ph_pool(F, rows_upd); PHASE_END
        }
        if (even) {
            PHASE_BEGIN(base + 2, 3) {
                pg8::Gemm g{(const pg8::bf16_t*)(F.ws + WS_H), (const pg8::bf16_t*)(F.ws + WS_WIN) + (size_t)e * DINP * D, MR, DINP, D, D, D, 1, 0, 0};
                pg8::StaticOrder S; S.init(MR, DINP, D, 1, F.G, (int)blockIdx.x);
                pg8::EpiBf16 E{(pg8::bf16_t*)(F.ws + WS_P), DINP};
                pg8::gemm_phase<pg8::EpiBf16, pg8::StaticOrder, false>(F.lds + RING_OFF, g, S, E, F.tid);
            } PHASE_END
            PHASE_BEGIN(base + 3, 4) {
                gla::ph_prep(F, e);
                if (L == 0) {
                    const na::bf16* P = (const na::bf16*)(F.ws + WS_P); na::bf16* MIX = (na::bf16*)(F.ws + WS_MIX);
                    for (int q = blockIdx.x; q < 48; q += F.G) { const int uc = q - 16; if (uc < 0) continue; const int b = uc >> 3, h = uc & 7;
                        na::na_unit<DINP, D>(P, C_QA + 128 * h, C_KA + 128 * h, C_VA + 128 * h, (long)MLAT + b * CTXL, (long)MLAT + b * CTXL, 0, 0, 0, 0,
                                             MIX, 128 * h, (F.ka->in[I_RPB]), (char*)lds + RING_OFF, F.tid); }
                }
            } PHASE_END
            PHASE_BEGIN(base + 4, 5) {
                gla::ph_g1(F);
                const na::bf16* P = (const na::bf16*)(F.ws + WS_P); na::bf16* MIX = (na::bf16*)(F.ws + WS_MIX);
                for (int u = F.vcu; u < 512; u += F.G) { const int b = u >> 7, h = (u >> 4) & 7, i = u & 15;
                    const int klo = i == 0 ? 0 : (i == 15 ? 56 : 4 * i - 4), nband = (i == 0 || i == 15) ? 8 : 12;
                    na::na_unit<DINP, D>(P, C_QA + 128 * h, C_KA + 128 * h, C_VA + 128 * h, (long)b * SEQ + 256 * i, (long)MLAT + b * CTXL, (long)b * SEQ + 64 * klo, nband, klo, 4 * i,
                                         MIX, 128 * h, (F.ka->in[I_RPB]) + ((size_t)e * 8 + h) * 15 * 31, (char*)lds + RING_OFF, F.tid); }
            } PHASE_END
            PHASE_BEGIN(base + 5, 6) {
                gla::ph_g2(F);
            } PHASE_END
            PHASE_BEGIN(base + 6, 7) gla::ph_g3(F, e, L == 0 ? MR / 64 : MLAT / 64); PHASE_END
            PHASE_BEGIN(base + 7, 8) {
                const int M = rows_upd;
                pg8::Gemm g{(const pg8::bf16_t*)(F.ws + WS_MIX), (const pg8::bf16_t*)(F.ws + WS_WOUT) + (size_t)e * D * D, M, D, D, D, D, 1, 0, 0};
                pg8::SplitTailOrder S; S.init(MLAT, M - MLAT, D, D, 4, F.G, (int)blockIdx.x);
                pg8::EpiResid E{(float*)(F.ws + WS_PART), (pg8::bf16_t*)(F.ws + WS_X16), D, modl + 2 * D, MODW, nullptr, 0, MLAT, MCTX};
                pg8::gemm_phase<pg8::EpiResid, pg8::SplitTailOrder, true>(F.lds + RING_OFF, g, S, E, F.tid);
            } PHASE_END
        } else {
            PHASE_BEGIN(base + 8, 9) {
                const int M = rows_upd;
                pg8::Gemm g{(const pg8::bf16_t*)(F.ws + WS_MIX), (const pg8::bf16_t*)(F.ws + WS_WPOOL) + (size_t)e * 4 * 512 * 512, M, 512, 512, D, 512, 4, (size_t)512 * 2, (size_t)512 * 512 * 2};
                pg8::StaticOrder S; S.init(M, 512, 512, 4, F.G, (int)blockIdx.x);
                pg8::EpiResid E{(float*)(F.ws + WS_PART), (pg8::bf16_t*)(F.ws + WS_X16), D, modl + 2 * D, MODW, (F.ka->in[I_POOLS]) + (size_t)e * D, 512, MLAT, MCTX};
                pg8::gemm_phase<pg8::EpiResid, pg8::StaticOrder, true>(F.lds + RING_OFF, g, S, E, F.tid);
            } PHASE_END
        }
        PHASE_BEGIN(base + 9, 10) ph_norm(F, rows_upd, (const float*)nullptr, XRc, (F.ka->in[I_N2G]) + (size_t)L * D, modl, 3 * D, 4 * D, even ? 4 : 1); PHASE_END
        PHASE_BEGIN(base + 10, 11) {
            const int M = rows_upd;
            pg8::Gemm g{(const pg8::bf16_t*)(F.ws + WS_H), (const pg8::bf16_t*)(F.ws + WS_WUP) + (size_t)L * DUP * D, M, DUP, D, D, D, 1, 0, 0};
            pg8::StaticOrder S; S.init(M, DUP, D, 1, F.G, (int)blockIdx.x);
            pg8::EpiGlu E{(pg8::bf16_t*)(F.ws + WS_ACT), LDF, (F.ka->in[I_CONVW]) + (size_t)L * 3 * DFF, (F.ka->in[I_CONVB]) + (size_t)L * DFF, (float*)(F.ws + WS_SB), DFF, (PG8_LAS float*)(F.lds + RING_OFF + 131072)};
            pg8::gemm_phase<pg8::EpiGlu, pg8::StaticOrder, true>(F.lds + RING_OFF, g, S, E, F.tid);
        } PHASE_END
        PHASE_BEGIN(base + 11, 12) ph_glufix(F, rows_upd, (F.ka->in[I_CONVW]) + (size_t)L * 3 * DFF, (F.ka->in[I_CONVB]) + (size_t)L * DFF); PHASE_END
        PHASE_BEGIN(base + 12, 13) {
            const int M = rows_upd;
            pg8::Gemm g{(const pg8::bf16_t*)(F.ws + WS_ACT), (const pg8::bf16_t*)(F.ws + WS_WDOWN) + (size_t)L * D * LDF, M, D, DFF, LDF, LDF, 1, 0, 0};
            pg8::SplitTailOrder S; S.init(MLAT, M - MLAT, D, DFF, 4, F.G, (int)blockIdx.x);
            pg8::EpiResid E{(float*)(F.ws + WS_PART), (pg8::bf16_t*)(F.ws + WS_X16), D, modl + 5 * D, MODW, nullptr, 0, MLAT, MCTX};
            pg8::gemm_phase<pg8::EpiResid, pg8::SplitTailOrder, true>(F.lds + RING_OFF, g, S, E, F.tid);
        } PHASE_END
    }
#ifdef XTRA_BARRIERS
    for (int xb = 0; xb < XTRA_BARRIERS; ++xb) xcd_barrier(bar);
#endif
    PHASE_BEGIN(N_PHASES - 1, 14) ph_final(F); PHASE_END
#undef PHASE_BEGIN
#undef PHASE_END
#undef XRc
}

#ifndef MK_PER_PHASE
#define MK_PER_PHASE 0
#endif
extern "C" void kernel_launch(void* const* d_in, const int* in_sizes, int n_in, void* d_out, int out_size, void* d_ws, size_t ws_size, hipStream_t stream) {
    static int grid = 0;
    if (grid == 0) {
        if (n_in != 21 || in_sizes[0] != MLAT * D || out_size != MLAT * D || ws_size < WS_END) {
            fprintf(stderr, "kernel_launch: shape mismatch: n_in %d in0 %d out %d ws %zu (need %zu); nothing launched\n", n_in, n_in > 0 ? in_sizes[0] : -1, out_size, ws_size, (size_t)WS_END); grid = -1; return; }
        int dev = 0, cus = 0, per_cu = 0;
        if (hipGetDevice(&dev) != hipSuccess || hipDeviceGetAttribute(&cus, hipDeviceAttributeMultiprocessorCount, dev) != hipSuccess) { fprintf(stderr, "kernel_launch: device query failed\n"); grid = -1; return; }
        if (hipFuncSetAttribute((const void*)fwd_kernel, hipFuncAttributeMaxDynamicSharedMemorySize, LDS_BYTES) != hipSuccess) { fprintf(stderr, "kernel_launch: hipFuncSetAttribute failed\n"); grid = -1; return; }
        if (hipOccupancyMaxActiveBlocksPerMultiprocessor(&per_cu, (const void*)fwd_kernel, NWAVES * 64, LDS_BYTES) != hipSuccess || per_cu < 1) {
            fprintf(stderr, "kernel_launch: occupancy query reports %d workgroups per CU\n", per_cu); }
        (void)hipGetLastError();
        grid = cus;
    }
    if (grid < 0) return;
    if (hipMemsetAsync((char*)d_ws + WS_CTL, 0, CTL_ZERO_BYTES, stream) != hipSuccess) { fprintf(stderr, "kernel_launch: memset failed\n"); return; }
    Args a{};
    for (int i = 0; i < 21; ++i) a.in[i] = (const float*)d_in[i];
    a.out = (float*)d_out; a.ws = (unsigned char*)d_ws;
#if MK_PER_PHASE
    for (int p = 0; p < N_PHASES; ++p) { if (!phase_active(p)) continue; a.ph_lo = p; a.ph_hi = p + 1;
        hipLaunchKernelGGL(fwd_kernel, dim3(grid), dim3(NWAVES * 64), LDS_BYTES, stream, a); }
#else
    a.ph_lo = 0; a.ph_hi = N_PHASES;
    hipLaunchKernelGGL(fwd_kernel, dim3(grid), dim3(NWAVES * 64), LDS_BYTES, stream, a);
#endif
    const hipError_t le = hipPeekAtLastError();
    if (le != hipSuccess) fprintf(stderr, "kernel_launch: launch failed: %s\n", hipGetErrorName(le));
}
```

```cpp
#include <hip/hip_runtime.h>
#include <cstdio>
#include <cstdint>

namespace pg8 {
#define PG8_LAS __attribute__((address_space(3)))
typedef unsigned short bf16_t;
typedef short bf16x8 __attribute__((ext_vector_type(8)));
typedef float f32x4 __attribute__((ext_vector_type(4)));
typedef float f32x2 __attribute__((ext_vector_type(2)));
typedef unsigned u32x4 __attribute__((ext_vector_type(4)));
constexpr int BM = 256, BK = 64, HALF = 128, HTB = HALF * BK * 2  , STAGE_BYTES = 8 * HTB, NXCD = 8;

__host__ __device__ __forceinline__ int lds_byte(int r, int c) { const int st = (r >> 4) * 2 + (c >> 5), rr = r & 15, cc = c & 31, ob = rr * 64 + cc * 2; return st * 1024 + (ob ^ (((ob >> 9) & 1) << 5)); }
__host__ __device__ __forceinline__ void stage_rc(int b, int& R, int& C) { const int st = b / 1024, sb = b % 1024, swz = sb ^ (((sb >> 9) & 1) << 5); R = (st >> 1) * 16 + swz / 64; C = (st & 1) * 32 + (swz % 64) / 2; }
__host__ __device__ __forceinline__ int perm32(int rho) { const int n = rho >> 4, i = rho & 15; return 8 * (i >> 2) + 4 * n + (i & 3); }

struct Unit { int pm, pn, grp, kt0, nkt, atomic; };
struct Gemm { const bf16_t* A; const bf16_t* Bt; int M, N, K, lda, ldb, ngrp; size_t gsA, gsB; };

struct StaticOrder {
    int nM, nN, nNr, nwg, G, c, nktK, WGM = 4;
    __host__ __device__ void init(int M, int N, int K, int ngrp, int G_, int c_) { nM = M / BM; nNr = N / BM; nN = nNr * ngrp; nwg = nM * nN; G = G_; c = c_; nktK = K / BK; }
    __host__ __device__ bool next(int i, Unit& u) const {
        const long L = (long)i * G + c; if (L >= nwg) return false;
        int wgid = (int)L; { const int q = nwg / NXCD, r = nwg % NXCD, xcd = wgid % NXCD, off = wgid / NXCD; wgid = (xcd < r ? xcd * (q + 1) : r * (q + 1) + (xcd - r) * q) + off; }
        int nig = WGM * nN, nr = nNr;
#if defined(__HIP_DEVICE_COMPILE__)
        asm volatile("" : "+s"(nig), "+s"(nr));
#endif
        const int gid = wgid / nig, fm = gid * WGM, gsz = (nM - fm) < WGM ? (nM - fm) : WGM;
        u.pm = fm + ((wgid % nig) % gsz); const int vn = (wgid % nig) / gsz; u.pn = vn % nr; u.grp = vn / nr; u.kt0 = 0; u.nkt = nktK; u.atomic = 0; return true;
    }
    __device__ __forceinline__ void a_ready(const Unit&) const {}
    __device__ __forceinline__ void done(const Unit&) const {}
};
struct SplitTailOrder {
    StaticOrder main; int nA, nB, nNr, SK, nks, pmB, G, c;
    __host__ __device__ void init(int MA, int MB, int N, int K, int SK_, int G_, int c_) { main.init(MA, N, K, 1, G_, c_); nA = main.nwg; nNr = N / BM; SK = SK_; nks = (K / BK) / SK_; pmB = MA / BM; nB = (MB / BM) * nNr * SK_; G = G_; c = c_; }
    __host__ __device__ bool next(int i, Unit& u) const {
        const long L = (long)i * G + c;
        if (L < nA) return main.next(i, u);
        const int Lb = (int)(L - nA); if (Lb >= nB) return false;
        const int ks = Lb % SK, tile = Lb / SK; u.pn = tile % nNr; u.pm = pmB + tile / nNr; u.grp = 0; u.kt0 = ks * nks; u.nkt = nks; u.atomic = 1 + ks; return true;
    }
    __device__ __forceinline__ void a_ready(const Unit&) const {}
    __device__ __forceinline__ void done(const Unit&) const {}
};

__device__ __forceinline__ unsigned cvt_pk_bf16(float lo, float hi) { unsigned r; asm volatile("v_cvt_pk_bf16_f32 %0, %1, %2" : "=v"(r) : "v"(lo), "v"(hi)); return r; }
typedef float cf32x2 __attribute__((ext_vector_type(2)));
typedef __bf16 cbf16x2 __attribute__((ext_vector_type(2)));
__device__ __forceinline__ unsigned pkc(float lo, float hi) { return __builtin_bit_cast(unsigned, __builtin_convertvector((cf32x2){lo, hi}, cbf16x2)); }
__device__ __forceinline__ unsigned f2bfc(float f) { return pkc(f, f) & 0xffffu; }
typedef _Float16 f16x2 __attribute__((ext_vector_type(2)));
__device__ __forceinline__ unsigned pk_h2(float lo, float hi) { f16x2 p; p.x = (_Float16)__builtin_amdgcn_fmed3f(lo, -65504.0f, 65504.0f); p.y = (_Float16)__builtin_amdgcn_fmed3f(hi, -65504.0f, 65504.0f); return __builtin_bit_cast(unsigned, p); }
__device__ __forceinline__ float h_lo(unsigned w) { return (float)__builtin_bit_cast(f16x2, w).x; }
__device__ __forceinline__ float h_hi(unsigned w) { return (float)__builtin_bit_cast(f16x2, w).y; }
template <unsigned BITS> __device__ __forceinline__ float kc() { float r; asm volatile("s_mov_b32 %0, %1" : "=s"(r) : "n"(BITS)); return r; }
__device__ __forceinline__ void gelu4(const f32x2 (&v)[4], f32x2 (&o)[4]) {
    f32x2 c[4], w[4], q[4];
#pragma unroll
    for (int p = 0; p < 4; ++p) { c[p].x = __builtin_amdgcn_fmed3f(v[p].x, -5.0f, 5.0f); c[p].y = __builtin_amdgcn_fmed3f(v[p].y, -5.0f, 5.0f); w[p] = (c[p] * c[p]) * 0.08f + (-1.0f); }
    { const float ka = kc<0x3a40c646u>(), kb = kc<0xbadbc5c1u>();
#pragma unroll
      for (int p = 0; p < 4; ++p) q[p] = w[p] * ka + kb; }
    { const float kk = kc<0x3ab42bcbu>();
#pragma unroll
      for (int p = 0; p < 4; ++p) q[p] = q[p] * w[p] + kk; }
    { const float kk = kc<0xbb259aa1u>();
#pragma unroll
      for (int p = 0; p < 4; ++p) q[p] = q[p] * w[p] + kk; }
    { const float kk = kc<0x3bddb9bfu>();
#pragma unroll
      for (int p = 0; p < 4; ++p) q[p] = q[p] * w[p] + kk; }
    { const float kk = kc<0xbc394185u>();
#pragma unroll
      for (int p = 0; p < 4; ++p) q[p] = q[p] * w[p] + kk; }
    { const float kk = kc<0x3c85018cu>();
#pragma unroll
      for (int p = 0; p < 4; ++p) q[p] = q[p] * w[p] + kk; }
    { const float kk = kc<0xbcbe2975u>();
#pragma unroll
      for (int p = 0; p < 4; ++p) q[p] = q[p] * w[p] + kk; }
    { const float kk = kc<0x3d00edc6u>();
#pragma unroll
      for (int p = 0; p < 4; ++p) q[p] = q[p] * w[p] + kk; }
    { const float kk = kc<0xbd25b03eu>();
#pragma unroll
      for (int p = 0; p < 4; ++p) q[p] = q[p] * w[p] + kk; }
    { const float kk = kc<0x3d530477u>();
#pragma unroll
      for (int p = 0; p < 4; ++p) q[p] = q[p] * w[p] + kk; }
    { const float kk = kc<0xbd8ff74du>();
#pragma unroll
      for (int p = 0; p < 4; ++p) q[p] = q[p] * w[p] + kk; }
    { const float kk = kc<0x3e10c1adu>();
#pragma unroll
      for (int p = 0; p < 4; ++p) q[p] = q[p] * w[p] + kk; }
#pragma unroll
    for (int p = 0; p < 4; ++p) o[p] = v[p] * (q[p] * c[p] + 0.5f);
}

__device__ __forceinline__ f32x2 gelu_pk(f32x2 v) {
    f32x2 c; c.x = __builtin_amdgcn_fmed3f(v.x, -5.0f, 5.0f); c.y = __builtin_amdgcn_fmed3f(v.y, -5.0f, 5.0f);
    const f32x2 w = (c * c) * 0.08f + (-1.0f);
    f32x2 q = w * 7.353763795e-04f + (-1.676730928e-03f);
    q = q * w + 1.374596148e-03f; q = q * w + (-2.526916796e-03f); q = q * w + 6.766527425e-03f; q = q * w + (-1.130712498e-02f); q = q * w + 1.623608917e-02f;
    q = q * w + (-2.321312763e-02f); q = q * w + 3.147675842e-02f; q = q * w + (-4.045128077e-02f); q = q * w + 5.151792988e-02f; q = q * w + (-7.029590756e-02f); q = q * w + 1.413638145e-01f;
    return v * (q * c + 0.5f);
}

struct EpiBf16 {
    static constexpr bool PERM = true;
    bf16_t* O; int ldc;
    __device__ __forceinline__ void operator()(const f32x4 (&acc)[2][2][4][2], const Unit& u, int wr, int wc, int fr, int fq) const {
        const int row0 = u.pm * BM + wr * 64 + fr; const int col0 = u.pn * BM + wc * 32 + 8 * fq;
#pragma unroll
        for (int ai = 0; ai < 2; ++ai)
#pragma unroll
            for (int m = 0; m < 4; ++m) { bf16_t* rowp = O + (size_t)(row0 + ai * HALF + m * 16) * ldc + col0;
#pragma unroll
                for (int bj = 0; bj < 2; ++bj) { const f32x4 v0 = acc[ai][bj][m][0], v1 = acc[ai][bj][m][1];
                    u32x4 w; w.x = cvt_pk_bf16(v0[0], v0[1]); w.y = cvt_pk_bf16(v0[2], v0[3]); w.z = cvt_pk_bf16(v1[0], v1[1]); w.w = cvt_pk_bf16(v1[2], v1[3]);
                    *(u32x4*)(rowp + bj * HALF) = w; } }
    }
};
struct EpiGlu {
    static constexpr bool PERM = true;
    bf16_t* ACT; int ldc; const float* cw; const float* cb; float* SB; int dff; PG8_LAS float* XB;
    static __device__ __forceinline__ float ror1(float v)  { return __builtin_bit_cast(float, __builtin_amdgcn_update_dpp(0, __builtin_bit_cast(int, v), 0x121, 0xf, 0xf, true)); }
    static __device__ __forceinline__ float ror15(float v) { return __builtin_bit_cast(float, __builtin_amdgcn_update_dpp(0, __builtin_bit_cast(int, v), 0x12f, 0xf, 0xf, true)); }
    __device__ __forceinline__ void operator()(const f32x4 (&acc)[2][2][4][2], const Unit& u, int wr, int wc, int fr, int fq) const {
        const int ch0 = u.pn * HALF + wc * 32 + 8 * fq; const bool l0 = (fr == 0), l15 = (fr == 15);
        PG8_LAS float* xme = XB + ((wr * 4 + wc) * 4) * 32 + fq * 8;
#pragma unroll
        for (int ai = 0; ai < 2; ++ai) {
            if (fr == 0)  { *(PG8_LAS f32x4*)(xme + (ai * 2 + 0) * 32) = acc[ai][1][0][0]; *(PG8_LAS f32x4*)(xme + (ai * 2 + 0) * 32 + 4) = acc[ai][1][0][1]; }
            if (fr == 15) { *(PG8_LAS f32x4*)(xme + (ai * 2 + 1) * 32) = acc[ai][1][3][0]; *(PG8_LAS f32x4*)(xme + (ai * 2 + 1) * 32 + 4) = acc[ai][1][3][1]; }
        }
        asm volatile("s_waitcnt lgkmcnt(0)" ::: "memory"); __builtin_amdgcn_s_barrier(); asm volatile("" ::: "memory");
        f32x4 w0[2], w1[2], w2[2], bb[2];
#pragma unroll
        for (int n = 0; n < 2; ++n) { w0[n] = *(const f32x4*)(cw + ch0 + 4 * n); w1[n] = *(const f32x4*)(cw + dff + ch0 + 4 * n); w2[n] = *(const f32x4*)(cw + 2 * dff + ch0 + 4 * n); bb[n] = *(const f32x4*)(cb + ch0 + 4 * n); }
#pragma unroll
        for (int ai = 0; ai < 2; ++ai) {
            const int rp = 128 * ai + 64 * wr - 1, rn = 128 * ai + 64 * wr + 64;
            f32x4 xp[2], xn[2];
#pragma unroll
            for (int n = 0; n < 2; ++n) { xp[n] = (f32x4){0.f, 0.f, 0.f, 0.f}; xn[n] = (f32x4){0.f, 0.f, 0.f, 0.f}; }
            if (rp >= 0)  { const PG8_LAS float* s = XB + ((((rp >> 6) & 1) * 4 + wc) * 4 + (rp >> 7) * 2 + 1) * 32 + fq * 8; xp[0] = *(const PG8_LAS f32x4*)s; xp[1] = *(const PG8_LAS f32x4*)(s + 4); }
            if (rn < 256) { const PG8_LAS float* s = XB + ((((rn >> 6) & 1) * 4 + wc) * 4 + (rn >> 7) * 2 + 0) * 32 + fq * 8; xn[0] = *(const PG8_LAS f32x4*)s; xn[1] = *(const PG8_LAS f32x4*)(s + 4); }
#pragma unroll
            for (int m = 0; m < 4; ++m) {
                const int row = u.pm * BM + ai * HALF + wr * 64 + m * 16 + fr;
                u32x4 ow; float cv[8];
#pragma unroll
                for (int n = 0; n < 2; ++n)
#pragma unroll
                    for (int j = 0; j < 4; ++j) {
                        const float g = acc[ai][1][m][n][j];
                        const float tp = l15 ? ((m > 0) ? acc[ai][1][m > 0 ? m - 1 : 0][n][j] : xp[n][j]) : g;
                        const float tn = l0  ? ((m < 3) ? acc[ai][1][m < 3 ? m + 1 : 3][n][j] : xn[n][j]) : g;
                        const float gp = ror1(tp), gn = ror15(tn);
                        cv[4 * n + j] = fmaf(w0[n][j], gp, fmaf(w1[n][j], g, fmaf(w2[n][j], gn, bb[n][j])));
                    }
                const int tr = ai * HALF + wr * 64 + m * 16 + fr;
                if (tr == 0 || tr == 255) { float* sb = SB + ((size_t)(u.pm * 2 + (tr ? 1 : 0)) * 3) * dff + ch0;
#pragma unroll
                    for (int n = 0; n < 2; ++n) { *(f32x4*)(sb + 4 * n) = (f32x4){cv[4 * n], cv[4 * n + 1], cv[4 * n + 2], cv[4 * n + 3]}; *(f32x4*)(sb + dff + 4 * n) = acc[ai][0][m][n]; *(f32x4*)(sb + 2 * dff + 4 * n) = acc[ai][1][m][n]; } }
                f32x2 gv[4], go[4]; float a[8];
#pragma unroll
                for (int p = 0; p < 4; ++p) gv[p] = (f32x2){cv[2 * p], cv[2 * p + 1]};
                gelu4(gv, go);
#pragma unroll
                for (int e = 0; e < 8; e += 2) { a[e] = go[e >> 1].x * acc[ai][0][m][e >> 2][e & 3]; a[e + 1] = go[e >> 1].y * acc[ai][0][m][(e + 1) >> 2][(e + 1) & 3]; }
                ow.x = cvt_pk_bf16(a[0], a[1]); ow.y = cvt_pk_bf16(a[2], a[3]); ow.z = cvt_pk_bf16(a[4], a[5]); ow.w = cvt_pk_bf16(a[6], a[7]);
                *(u32x4*)(ACT + (size_t)row * ldc + ch0) = ow;
            }
        }
    }
};
struct EpiResid {
    static constexpr bool PERM = true;
    float* PART; bf16_t* X16; int ldx; const float* gate; int gstride; const float* cscale; int gcols; int mlat; int mctx;
    __device__ __forceinline__ void operator()(const f32x4 (&acc)[2][2][4][2], const Unit& u, int wr, int wc, int fr_, int fq_) const {
        int fr = fr_, fq = fq_; asm volatile("" : "+v"(fr), "+v"(fq));
        const int row0 = u.pm * BM + wr * 64 + fr, col0 = u.grp * gcols + u.pn * BM + wc * 32 + 8 * fq;
        const int rowt = u.pm * BM; const int bidx = rowt < mlat ? (rowt >> 12) : 4;
        const float* gp = gate + (size_t)bidx * gstride + col0;
        f32x4 gv[2][2];
#pragma unroll
        for (int bj = 0; bj < 2; ++bj)
#pragma unroll
            for (int n = 0; n < 2; ++n) { gv[bj][n] = *(const f32x4*)(gp + bj * HALF + n * 4); if (cscale) gv[bj][n] = gv[bj][n] * *(const f32x4*)(cscale + col0 + bj * HALF + n * 4); }
        if (rowt >= mlat) {
            float* base = PART + ((size_t)(u.atomic ? u.atomic - 1 : 0) * mctx + (size_t)(row0 - mlat)) * ldx + col0;
            f32x4 gc[2][2] = {{gv[0][0], gv[0][1]}, {gv[1][0], gv[1][1]}}; asm volatile("" : "+v"(gc[0][0]), "+v"(gc[0][1]), "+v"(gc[1][0]), "+v"(gc[1][1]));
#pragma unroll
            for (int ai = 0; ai < 2; ++ai)
#pragma unroll
                for (int m = 0; m < 4; ++m) { float* rowp = base + (size_t)(ai * HALF + m * 16) * ldx;
#pragma unroll
                    for (int bj = 0; bj < 2; ++bj)
#pragma unroll
                        for (int n = 0; n < 2; ++n) *(f32x4*)(rowp + bj * HALF + n * 4) = acc[ai][bj][m][n] * gc[bj][n]; }
        } else {
            u32x4 xin[2][4][2];
#pragma unroll
            for (int ai = 0; ai < 2; ++ai)
#pragma unroll
                for (int m = 0; m < 4; ++m)
#pragma unroll
                    for (int bj = 0; bj < 2; ++bj) xin[ai][m][bj] = *(const u32x4*)(X16 + (size_t)(row0 + ai * HALF + m * 16) * ldx + col0 + bj * HALF);
            asm volatile("" ::: "memory");
#pragma unroll
            for (int ai = 0; ai < 2; ++ai)
#pragma unroll
                for (int m = 0; m < 4; ++m)
#pragma unroll
                    for (int bj = 0; bj < 2; ++bj) { const u32x4 h = xin[ai][m][bj]; const f32x4 a0 = acc[ai][bj][m][0] * gv[bj][0], a1 = acc[ai][bj][m][1] * gv[bj][1];
                        u32x4 w;
                        w.x = pk_h2(h_lo(h.x) + a0[0], h_hi(h.x) + a0[1]); w.y = pk_h2(h_lo(h.y) + a0[2], h_hi(h.y) + a0[3]);
                        w.z = pk_h2(h_lo(h.z) + a1[0], h_hi(h.z) + a1[1]); w.w = pk_h2(h_lo(h.w) + a1[2], h_hi(h.w) + a1[3]);
                        *(u32x4*)(X16 + (size_t)(row0 + ai * HALF + m * 16) * ldx + col0 + bj * HALF) = w; }
        }
    }
};

template <class Epi, class Sched, bool ALIGN_EPI = true>
__device__ __forceinline__ void gemm_phase(PG8_LAS unsigned char* lds, const Gemm g, const Sched& S, const Epi& E, const int tid) {
    const int wid = __builtin_amdgcn_readfirstlane(tid >> 6), lane = tid & 63, wr = wid >> 2, wc = wid & 3, fr = lane & 15, fq = lane >> 4;
    unsigned voffA[2], voffB[2];
#pragma unroll
    for (int i = 0; i < 2; ++i) { int R, C; stage_rc(tid * 16 + i * 8192, R, C); const int Rb = Epi::PERM ? ((R & ~31) + perm32(R & 31)) : R;
        voffA[i] = (unsigned)(R * g.lda + C) * 2u; voffB[i] = (unsigned)(Rb * g.ldb + C) * 2u; }
    const size_t kstep = (size_t)(BK * 2);
    const size_t hstepA = (size_t)HALF * g.lda * 2, hstepB = (size_t)HALF * g.ldb * 2;
    const size_t tstepA = 2 * hstepA, tstepB = 2 * hstepB;
    const unsigned ldsw = (unsigned)wid * 1024u;
    const int aoff = lds_byte(wr * 64 + fr, fq * 8), boff = lds_byte(wc * 32 + fr, fq * 8);
#define PG8_SA(b, h) (((b) * 2 + (h)) * HTB)
#define PG8_SB(b, h) ((4 + (b) * 2 + (h)) * HTB)
#define PG8_STAGE(bufoff, gbase, voff) do { _Pragma("unroll") for (int _i = 0; _i < 2; ++_i) \
        __builtin_amdgcn_global_load_lds((const unsigned*)((const char*)(gbase) + (voff)[_i]), (PG8_LAS unsigned*)(lds + (bufoff) + ldsw + _i * 8192), 16, 0, 0); } while (0)
#define PG8_LDA(dst, b, h) do { _Pragma("unroll") for (int m = 0; m < 4; ++m) _Pragma("unroll") for (int k = 0; k < 2; ++k) dst[m][k] = *(const PG8_LAS bf16x8*)(lds + PG8_SA(b, h) + aoff + m * 2048 + k * 1024); } while (0)
#define PG8_LDB(dst, b, h) do { _Pragma("unroll") for (int n = 0; n < 2; ++n) _Pragma("unroll") for (int k = 0; k < 2; ++k) dst[n][k] = *(const PG8_LAS bf16x8*)(lds + PG8_SB(b, h) + boff + n * 2048 + k * 1024); } while (0)
#define PG8_MMA(ai, bj, At, Bt) do { __builtin_amdgcn_s_setprio(1); _Pragma("unroll") for (int m = 0; m < 4; ++m) _Pragma("unroll") for (int n = 0; n < 2; ++n) _Pragma("unroll") for (int k = 0; k < 2; ++k) \
        acc[ai][bj][m][n] = __builtin_amdgcn_mfma_f32_16x16x32_bf16(Bt[n][k], At[m][k], acc[ai][bj][m][n], 0, 0, 0); __builtin_amdgcn_s_setprio(0); } while (0)
#define PG8_WAIT_V(n) asm volatile("s_waitcnt vmcnt(" #n ")" ::: "memory")
#define PG8_WAIT_L(n) asm volatile("s_waitcnt lgkmcnt(" #n ")" ::: "memory")
#define PG8_BAR __builtin_amdgcn_s_barrier()
#define PG8_SCHED __builtin_amdgcn_sched_barrier(0)
    Unit cur, nxt; int ui = 0;
    if (!S.next(0, cur)) return;
    f32x4 acc[2][2][4][2];
#pragma unroll
    for (int a = 0; a < 2; ++a)
#pragma unroll
        for (int b = 0; b < 2; ++b)
#pragma unroll
            for (int m = 0; m < 4; ++m)
#pragma unroll
                for (int n = 0; n < 2; ++n) acc[a][b][m][n] = (f32x4){0.f, 0.f, 0.f, 0.f};
    bf16x8 At[4][2], B0[2][2], B1[2][2];
    const char* cA = (const char*)g.A + (size_t)cur.pm * tstepA + (size_t)cur.grp * g.gsA + (size_t)cur.kt0 * kstep; const char* cB = (const char*)g.Bt + (size_t)cur.pn * tstepB + (size_t)cur.grp * g.gsB + (size_t)cur.kt0 * kstep;
    S.a_ready(cur);
    PG8_STAGE(PG8_SB(0, 0), cB, voffB); PG8_STAGE(PG8_SB(0, 1), cB + hstepB, voffB); PG8_STAGE(PG8_SA(0, 0), cA, voffA); PG8_STAGE(PG8_SA(0, 1), cA + hstepA, voffA);
    if (wr == 1) PG8_BAR;
    PG8_WAIT_V(2); PG8_BAR;
    PG8_STAGE(PG8_SB(1, 0), cB + kstep, voffB); PG8_STAGE(PG8_SA(1, 0), cA + kstep, voffA); PG8_STAGE(PG8_SB(1, 1), cB + hstepB + kstep, voffB);
    PG8_WAIT_V(6); PG8_BAR;
    for (;;) {
        const bool has_next = S.next(ui + 1, nxt);
        const char* nA = has_next ? (const char*)g.A + (size_t)nxt.pm * tstepA + (size_t)nxt.grp * g.gsA + (size_t)nxt.kt0 * kstep : cA;
        const char* nB = has_next ? (const char*)g.Bt + (size_t)nxt.pn * tstepB + (size_t)nxt.grp * g.gsB + (size_t)nxt.kt0 * kstep : cB;
        const int nt = cur.nkt;
        for (int t = 0; t < nt; t += 2) {
            const bool last = (t == nt - 2);
            const char* a1 = cA + (size_t)(t + 1) * kstep;
            const char* a2 = last ? nA : cA + (size_t)(t + 2) * kstep; const char* b2 = last ? nB : cB + (size_t)(t + 2) * kstep;
            const char* a3 = a2 + kstep; const char* b3 = b2 + kstep;
            if (last && has_next) S.a_ready(nxt);
            PG8_LDB(B0, 0, 0); PG8_LDB(B1, 0, 1); PG8_SCHED; PG8_LDA(At, 0, 0); PG8_STAGE(PG8_SA(1, 1), a1 + hstepA, voffA);
            PG8_WAIT_V(8); PG8_WAIT_L(0); PG8_BAR; PG8_MMA(0, 0, At, B0); PG8_MMA(0, 1, At, B1); PG8_BAR; PG8_SCHED;
            PG8_LDA(At, 0, 1); PG8_STAGE(PG8_SB(0, 0), b2, voffB); PG8_STAGE(PG8_SB(0, 1), b2 + hstepB, voffB); PG8_STAGE(PG8_SA(0, 0), a2, voffA);
            PG8_WAIT_V(8); PG8_WAIT_L(0); PG8_BAR; PG8_MMA(1, 0, At, B0); PG8_MMA(1, 1, At, B1); PG8_BAR; PG8_SCHED;
            PG8_LDB(B0, 1, 0); PG8_LDB(B1, 1, 1); PG8_SCHED; PG8_LDA(At, 1, 0); PG8_STAGE(PG8_SA(0, 1), a2 + hstepA, voffA);
            PG8_WAIT_V(8); PG8_WAIT_L(0); PG8_BAR; PG8_MMA(0, 0, At, B0); PG8_MMA(0, 1, At, B1); PG8_BAR; PG8_SCHED;
            PG8_LDA(At, 1, 1); PG8_STAGE(PG8_SB(1, 0), b3, voffB); PG8_STAGE(PG8_SB(1, 1), b3 + hstepB, voffB); PG8_STAGE(PG8_SA(1, 0), a3, voffA);
            PG8_WAIT_V(8); PG8_WAIT_L(0); PG8_BAR; PG8_MMA(1, 0, At, B0); PG8_MMA(1, 1, At, B1); PG8_BAR; PG8_SCHED;
        }
        if constexpr (ALIGN_EPI) { if (wr == 0) PG8_BAR; }
        E(acc, cur, wr, wc, fr, fq); S.done(cur);
        if (!has_next) break;
#pragma unroll
        for (int a = 0; a < 2; ++a)
#pragma unroll
            for (int b = 0; b < 2; ++b)
#pragma unroll
                for (int m = 0; m < 4; ++m)
#pragma unroll
                    for (int n = 0; n < 2; ++n) acc[a][b][m][n] = (f32x4){0.f, 0.f, 0.f, 0.f};
        cur = nxt; cA = nA; cB = nB; ++ui;
        if constexpr (ALIGN_EPI) { if (wr == 1) PG8_BAR; }
    }
    PG8_WAIT_V(0);
    if constexpr (!ALIGN_EPI) { if (wr == 0) PG8_BAR; }
    PG8_BAR;
#undef PG8_SA
#undef PG8_SB
#undef PG8_STAGE
#undef PG8_LDA
#undef PG8_LDB
#undef PG8_MMA
#undef PG8_WAIT_V
#undef PG8_WAIT_L
#undef PG8_BAR
#undef PG8_SCHED
}
}

namespace na {
typedef unsigned short bf16;
using bf16x8 = __attribute__((ext_vector_type(8))) short;
using s16x4  = __attribute__((ext_vector_type(4))) short;
using f32x16 = __attribute__((ext_vector_type(16))) float;
using u32x4  = __attribute__((ext_vector_type(4))) unsigned;
constexpr int   D = 128, NW = 8, QBLK = 32, KVBLK = 64;
constexpr float SCALE = 0.088388347648318440f;
constexpr float THR = 8.f;
constexpr float NEG = -1.0e30f;
constexpr size_t SHM_V = KVBLK * D * 2, SHM_K = KVBLK * D * 2, SHM_ATTN = 2 * SHM_V + 2 * SHM_K + NW * 64 * 4;
constexpr size_t BIAS_OFF = 69632;
constexpr size_t PEN_OFF = BIAS_OFF + 640 * 4;
constexpr size_t QS_OFF = 73728;
constexpr size_t LDS_END = QS_OFF + NW * 8192;
#define NA_KSWZ(row, colB) ((row) * 256 + ((colB) ^ (((row) & 7) << 4)))
#define NA_SBAR() __builtin_amdgcn_sched_barrier(0)
__device__ __forceinline__ int crow(int r, int hi) { return (r & 3) + 8 * (r >> 2) + 4 * hi; }
__device__ __forceinline__ unsigned cvtpk(float lo, float hi) { unsigned r; asm volatile("v_cvt_pk_bf16_f32 %0, %1, %2" : "=v"(r) : "v"(lo), "v"(hi)); return r; }

__device__ __forceinline__ void partialSM(f32x16& p0, f32x16& p1, float& m_reg, float& mn, float& alpha) {
  constexpr float C = SCALE * 1.4426950408889634f;
  float pmax = p0[0];
#pragma unroll
  for (int r = 1; r < 16; ++r) pmax = fmaxf(pmax, p0[r]);
#pragma unroll
  for (int r = 0; r < 16; ++r) pmax = fmaxf(pmax, p1[r]);
  { auto rr = __builtin_amdgcn_permlane32_swap(__float_as_uint(pmax), __float_as_uint(pmax), false, false);
    pmax = fmaxf(__uint_as_float(rr[0]), __uint_as_float(rr[1])); }
  if (__builtin_expect(__all(pmax - m_reg <= THR / SCALE), 1)) { mn = m_reg; alpha = 1.f; }
  else { mn = fmaxf(m_reg, pmax); alpha = __builtin_amdgcn_exp2f((m_reg - mn) * C); m_reg = mn; }
  float mnC = -mn * C;
#pragma unroll
  for (int r = 0; r < 16; ++r) p0[r] = fmaf(p0[r], C, mnC);
#pragma unroll
  for (int r = 0; r < 16; ++r) p1[r] = fmaf(p1[r], C, mnC);
#pragma unroll
  for (int r = 0; r < 16; ++r) p0[r] = __builtin_amdgcn_exp2f(p0[r]);
}
__device__ __forceinline__ void finishSM(f32x16& p0, f32x16& p1, float alpha, float& l_reg, bf16x8& pa0, bf16x8& pa1, bf16x8& pa2, bf16x8& pa3) {
#pragma unroll
  for (int r = 0; r < 16; ++r) p1[r] = __builtin_amdgcn_exp2f(p1[r]);
  float ps = 0;
#pragma unroll
  for (int r = 0; r < 16; ++r) ps += p0[r];
#pragma unroll
  for (int r = 0; r < 16; ++r) ps += p1[r];
  { auto rr = __builtin_amdgcn_permlane32_swap(__float_as_uint(ps), __float_as_uint(ps), false, false);
    ps = __uint_as_float(rr[0]) + __uint_as_float(rr[1]); }
  l_reg = l_reg * alpha + ps;
#define NA_PK4(P, BASE, OUT) do { unsigned a0 = cvtpk(P[BASE + 0], P[BASE + 1]), a1 = cvtpk(P[BASE + 2], P[BASE + 3]);   \
    unsigned b0 = cvtpk(P[BASE + 4], P[BASE + 5]), b1 = cvtpk(P[BASE + 6], P[BASE + 7]);                              \
    auto r0 = __builtin_amdgcn_permlane32_swap(a0, b0, false, false); auto r1 = __builtin_amdgcn_permlane32_swap(a1, b1, false, false); \
    u32x4 w = {r0[0], r1[0], r0[1], r1[1]}; OUT = *reinterpret_cast<bf16x8*>(&w); } while (0)
  NA_PK4(p0, 0, pa0); NA_PK4(p0, 8, pa1); NA_PK4(p1, 0, pa2); NA_PK4(p1, 8, pa3);
#undef NA_PK4
}
__device__ __forceinline__ void qkt(f32x16& p0, f32x16& p1, const bf16* Ks, const bf16x8* qs, int r32, int hi) {
#pragma unroll
  for (int d0 = 0; d0 < 8; ++d0) { int cb = (d0 * 16 + hi * 8) * 2; const bf16x8 q = qs[d0 * 64];
    bf16x8 b0 = *reinterpret_cast<const bf16x8*>((const char*)Ks + NA_KSWZ(r32, cb));
    bf16x8 b1 = *reinterpret_cast<const bf16x8*>((const char*)Ks + NA_KSWZ(32 + r32, cb));
    p0 = __builtin_amdgcn_mfma_f32_32x32x16_bf16(b0, q, p0, 0, 0, 0);
    p1 = __builtin_amdgcn_mfma_f32_32x32x16_bf16(b1, q, p1, 0, 0, 0); }
}
__device__ __forceinline__ int v_st(int k, int c) { const int kk = (k & ~0xC) | ((k & 4) << 1) | ((k & 8) >> 1); return ((kk >> 3) * 4 + (c >> 5)) * 512 + ((kk & 7) * 32 + (c & 31)) * 2; }
__device__ __forceinline__ int v_rd_base(int lane) { return ((lane & 3) << 3) | (((lane >> 2) & 3) << 6) | (((lane >> 4) & 1) << 5) | (((lane >> 5) & 1) << 8); }
constexpr int v_rd_off(int d0, int ks, int half) { return d0 * 512 + ks * 4096 + half * 2048; }
template <int OFF> __device__ __forceinline__ s16x4 tr_read(int vb) {
  s16x4 r; asm volatile("ds_read_b64_tr_b16 %0, %1 offset:%2" : "=&v"(r) : "v"(vb), "i"(OFF) : "memory"); return r;
}
template <int D0> __device__ __forceinline__ void pv_one(f32x16& od, int vb, bf16x8 pa0, bf16x8 pa1, bf16x8 pa2, bf16x8 pa3) {
  const s16x4 l0 = tr_read<v_rd_off(D0, 0, 0)>(vb), h0 = tr_read<v_rd_off(D0, 0, 1)>(vb), l1 = tr_read<v_rd_off(D0, 1, 0)>(vb), h1 = tr_read<v_rd_off(D0, 1, 1)>(vb);
  const s16x4 l2 = tr_read<v_rd_off(D0, 2, 0)>(vb), h2 = tr_read<v_rd_off(D0, 2, 1)>(vb), l3 = tr_read<v_rd_off(D0, 3, 0)>(vb), h3 = tr_read<v_rd_off(D0, 3, 1)>(vb);
  asm volatile("s_waitcnt lgkmcnt(0)" ::: "memory"); NA_SBAR();
#define NA_PK(L, H) (bf16x8){L[0], L[1], L[2], L[3], H[0], H[1], H[2], H[3]}
  od = __builtin_amdgcn_mfma_f32_32x32x16_bf16(pa0, NA_PK(l0, h0), od, 0, 0, 0);
  od = __builtin_amdgcn_mfma_f32_32x32x16_bf16(pa1, NA_PK(l1, h1), od, 0, 0, 0);
  od = __builtin_amdgcn_mfma_f32_32x32x16_bf16(pa2, NA_PK(l2, h2), od, 0, 0, 0);
  od = __builtin_amdgcn_mfma_f32_32x32x16_bf16(pa3, NA_PK(l3, h3), od, 0, 0, 0);
#undef NA_PK
}
__device__ __forceinline__ void pv_d0(f32x16* o, int vb, bf16x8 pa0, bf16x8 pa1, bf16x8 pa2, bf16x8 pa3) {
  pv_one<0>(o[0], vb, pa0, pa1, pa2, pa3); pv_one<1>(o[1], vb, pa0, pa1, pa2, pa3); pv_one<2>(o[2], vb, pa0, pa1, pa2, pa3); pv_one<3>(o[3], vb, pa0, pa1, pa2, pa3);
}

__device__ __forceinline__ void init_scores(f32x16& p0, f32x16& p1, int j, int klo, int qrow, const float* bt_l, const float* pen_l) {
  if (j < 4) { p0 = f32x16{}; p1 = f32x16{}; return; }
  const int kr = klo + j - 4, rs = min(max(qrow - 4, 0), 56);
  if (kr < rs || kr >= rs + 8) {
#pragma unroll
    for (int r = 0; r < 16; ++r) { p0[r] = NEG; p1[r] = NEG; }
    return;
  }
  int zo; asm volatile("v_mov_b32 %0, 0" : "=v"(zo));
  const float* bl = bt_l + (kr - qrow + 7) * 32; pen_l += zo;
#pragma unroll
  for (int r = 0; r < 16; ++r) { const int c = (r & 3) + 8 * (r >> 2); p0[r] = bl[c] + pen_l[c]; p1[r] = bl[32 + c] + pen_l[32 + c]; }
}

template <int LDP, int LDO>
__device__ __forceinline__ void na_unit(const bf16* __restrict__ P, int qcol, int kcol, int vcol, long qrow0, long crow0, long brow0, int nband, int klo, int qg0,
                                        bf16* __restrict__ O, int ocol, const float* __restrict__ rpbh, char* lds, const int tid) {
  const int wid = tid >> 6, lane = tid & 63, r32 = lane & 31, hi = lane >> 5;
  bf16* V_lds = (bf16*)lds; bf16* K_lds = (bf16*)(lds + 2 * SHM_V);
  float* ws = (float*)(lds + 2 * SHM_V + 2 * SHM_K) + wid * 64; float* li_l = ws; float* al_l = ws + 32;
  float* blds = (float*)(lds + BIAS_OFF); float* pens = (float*)(lds + PEN_OFF);
  __syncthreads();
  if (nband > 0) {
    for (int i = tid; i < 640; i += 512) { const int t2 = i - 64, dri = t2 >> 5, dci = t2 & 31; blds[i] = (t2 >= 0 && t2 < 480 && dci < 31) ? rpbh[dri * 31 + dci] * (1.0f / SCALE) : 0.f; }
    if (tid < 128) pens[tid] = (tid >= 48 && tid < 64) ? 0.f : NEG;
  }
  float m_reg = -1e30f, l_reg = 0; f32x16 o[4] = {};
  bf16x8* qs = (bf16x8*)(lds + QS_OFF + wid * 8192) + lane;
  { const bf16* Qw = P + (qrow0 + wid * QBLK + r32) * LDP + qcol + hi * 8;
#pragma unroll
    for (int d0 = 0; d0 < 8; ++d0) qs[d0 * 64] = *reinterpret_cast<const bf16x8*>(Qw + d0 * 16); }
  const int sr = tid >> 4, sc = (tid & 15) * 8, vst0 = v_st(sr, sc), vst1 = v_st(32 + sr, sc);
  const int vb0 = (int)(uintptr_t)V_lds + v_rd_base(lane);
  const int qrow = qg0 + (wid >> 1), qc = (wid & 1) * 32 + r32;
  const float* bt_l = blds + 64 + 15 - qc + 4 * hi; const float* pen_l = pens + 48 - min(max(qc - 8, 0), 48) + 4 * hi;
  const bf16* Kh = P + kcol; const bf16* Vh = P + vcol;
  bf16x8 vs0, vs1, ks0, ks1;
#define NA_TROW(j) ((j) < 4 ? crow0 + (long)(j) * 64 : brow0 + (long)((j) - 4) * 64)
#define NA_SLOAD(j) do { const long _k0 = NA_TROW(j); vs0 = *reinterpret_cast<const bf16x8*>(&Vh[(_k0 + sr) * LDP + sc]); vs1 = *reinterpret_cast<const bf16x8*>(&Vh[(_k0 + 32 + sr) * LDP + sc]); \
    ks0 = *reinterpret_cast<const bf16x8*>(&Kh[(_k0 + sr) * LDP + sc]); ks1 = *reinterpret_cast<const bf16x8*>(&Kh[(_k0 + 32 + sr) * LDP + sc]); } while (0)
#define NA_SWRITE(b) do { *(bf16x8*)((char*)V_lds + (b) * SHM_V + vst0) = vs0; *(bf16x8*)((char*)V_lds + (b) * SHM_V + vst1) = vs1; const int kc = sc * 2; \
    *(bf16x8*)((char*)K_lds + (b) * SHM_K + NA_KSWZ(sr, kc)) = ks0; *(bf16x8*)((char*)K_lds + (b) * SHM_K + NA_KSWZ(32 + sr, kc)) = ks1; } while (0)
#define NA_RESC(a) do { if (__any((a) < 1.f)) { if (hi == 0) al_l[r32] = (a); asm volatile("s_waitcnt lgkmcnt(0)" ::: "memory"); \
    _Pragma("unroll") for (int d = 0; d < 4; ++d) _Pragma("unroll") for (int r = 0; r < 16; ++r) o[d][r] *= al_l[crow(r, hi)]; } } while (0)
  f32x16 p0, p1; float mn, al; bf16x8 pa0, pa1, pa2, pa3; const int NT = 4 + nband; const int rs_ = min(max(qrow - 4, 0), 56);
  NA_SLOAD(0);
  for (int j = 0; j < NT; ++j) {
    const int b = j & 1;
    NA_SWRITE(b);
    if (j + 1 < NT) NA_SLOAD(j + 1);
    __syncthreads();
    const int kr_ = klo + j - 4;
    if (j < 4 || (kr_ >= rs_ && kr_ < rs_ + 8)) {
      init_scores(p0, p1, j, klo, qrow, bt_l, pen_l);
      qkt(p0, p1, (const bf16*)((const char*)K_lds + b * SHM_K), qs, r32, hi);
      partialSM(p0, p1, m_reg, mn, al);
      NA_RESC(al);
      finishSM(p0, p1, al, l_reg, pa0, pa1, pa2, pa3); NA_SBAR();
      pv_d0(o, vb0 + b * (int)SHM_V, pa0, pa1, pa2, pa3);
    }
  }
  if (hi == 0) li_l[r32] = l_reg; asm volatile("s_waitcnt lgkmcnt(0)" ::: "memory");
  float rli[16];
#pragma unroll
  for (int r = 0; r < 16; ++r) rli[r] = __builtin_amdgcn_rcpf(li_l[crow(r, hi)]);
  bf16* Ow = O + (qrow0 + wid * QBLK) * LDO + ocol;
#pragma unroll
  for (int r = 0; r < 16; ++r) { const int orow = crow(r, hi);
#pragma unroll
    for (int d0 = 0; d0 < 4; ++d0) { const float v = o[d0][r] * rli[r]; Ow[(long)orow * LDO + d0 * 32 + r32] = (bf16)pg8::f2bfc(v); } }
#undef NA_TROW
#undef NA_SLOAD
#undef NA_SWRITE
#undef NA_RESC
}
}

constexpr int NWAVES = 8;
constexpr int D = 2048, NBATCH = 4, SEQ = 4096, MLAT = NBATCH * SEQ, CTXL = 256, MCTX = NBATCH * CTXL, MR = MLAT + MCTX;
#ifndef PADF
#define PADF 128
#endif
constexpr int DFF = 5632, DUP = 2 * DFF, DIN = 6176, DINP = 6400, DEPTH = 4, LDF = DFF + PADF;
constexpr int MODW = 6 * D;
constexpr float EPS = 1e-6f;
constexpr int C_QA = 0, C_KA = 1024, C_VA = 2048, C_QB = 3072, C_KB = 3584, C_VB = 4096, C_GB = 5120, C_AB = 6144;

constexpr size_t MiB = 1u << 20;
constexpr size_t WS_CTL = 0, CTL_ZERO_BYTES = 32768;
constexpr size_t WS_MOD = 1 * MiB;
constexpr size_t WS_ROPE = WS_MOD + (size_t)DEPTH * 5 * MODW * 4;
constexpr size_t WS_WIN = 2 * MiB;
constexpr size_t WS_WOUT = WS_WIN + (size_t)2 * DINP * D * 2;
constexpr size_t WS_WPOOL = WS_WOUT + (size_t)2 * D * D * 2;
constexpr size_t WS_WUP = WS_WPOOL + (size_t)2 * 4 * 512 * 512 * 2;
constexpr size_t WS_WDOWN = WS_WUP + (size_t)DEPTH * DUP * D * 2;
constexpr size_t WS_XR = WS_WDOWN + (size_t)DEPTH * D * LDF * 2;
constexpr size_t WS_X16 = WS_XR;
constexpr size_t WS_PART = WS_XR + (size_t)MLAT * D * 2;
constexpr size_t WS_H = WS_XR + (size_t)MR * D * 4;
constexpr size_t WS_MIX = WS_H + (size_t)MR * D * 2;
constexpr size_t WS_BIG = WS_MIX + (size_t)MR * D * 2;
constexpr size_t WS_U = WS_BIG;
constexpr size_t WS_ACT = WS_U + (size_t)MR * DUP * 2;
constexpr size_t WS_P = WS_BIG;
constexpr size_t WS_QF = WS_P + (size_t)MR * DINP * 2;
constexpr size_t WS_KF = WS_QF + (size_t)MR * 512 * 2;
constexpr size_t WS_QB = WS_KF + (size_t)MR * 512 * 2;
constexpr size_t WS_KB = WS_QB + (size_t)MR * 512 * 2;
constexpr size_t WS_KHT = WS_KB + (size_t)MR * 512 * 2;
constexpr size_t WS_AL = WS_KHT + (size_t)2 * MR * 512 * 2;
constexpr size_t WS_UT = WS_AL + (size_t)2 * (MR / 64) * 512 * 4;
constexpr size_t WS_ST = WS_UT + (size_t)64 * 68 * 8192 * 2;
constexpr size_t WS_MIXEND = WS_ST + (size_t)64 * 68 * 8192 * 2;
constexpr size_t WS_SB = WS_ACT + (size_t)MR * LDF * 2;
constexpr size_t WS_END = WS_SB + (size_t)(MR / 256) * 2 * 3 * DFF * 4;
static_assert(WS_MIXEND <= WS_END, "even-mixer view fits inside the FFN view");
static_assert(WS_ROPE + 2 * 64 * 16 * 4 <= WS_WIN, "small tables fit below the weights");
constexpr int CW_BAR = 4096;

constexpr int RING_OFF = 0, RING_BYTES = 143360;
constexpr int LDSCTL_OFF = RING_BYTES, MISC_OFF = LDSCTL_OFF + 320;
constexpr int LDS_BYTES = 147456;
static_assert(na::LDS_END <= RING_BYTES, "attention LDS fits the ring");

#define GAS __attribute__((address_space(1)))
#define LAS __attribute__((address_space(3)))
typedef unsigned short bf16;
typedef unsigned v4u __attribute__((ext_vector_type(4)));
typedef unsigned v2u __attribute__((ext_vector_type(2)));
typedef float f32x4 __attribute__((ext_vector_type(4)));
#define LDS_WAIT() asm volatile("s_waitcnt lgkmcnt(0)" ::: "memory")
__device__ __forceinline__ unsigned f2bf(float f) { return pg8::f2bfc(f); }
__device__ __forceinline__ unsigned pk2(float lo, float hi) { return pg8::pkc(lo, hi); }
__device__ __forceinline__ unsigned pk2h(float lo, float hi) { return pg8::cvt_pk_bf16(lo, hi); }
__device__ __forceinline__ float bflo(unsigned w) { return __builtin_bit_cast(float, w << 16); }
__device__ __forceinline__ float bfhi(unsigned w) { return __builtin_bit_cast(float, w & 0xffff0000u); }
__device__ __forceinline__ float bf2f(bf16 b) { return __builtin_bit_cast(float, (unsigned)b << 16); }

#define XB_TMO      128
#define XB_XCNT(j)  (256  + 64 * (j))
#define XB_XSUB(j)  (1280 + 64 * (j))
#define XB_XGEN(j)  (2304 + 64 * (j))
#define XB_TOP      3328
#define XB_TOPGEN   3392
#define XCD_BAR_WORDS 3456
#define XB_SPIN_CAP (1u << 18)
__device__ __forceinline__ unsigned xb_ld(unsigned* p)              { return __hip_atomic_load(p, __ATOMIC_RELAXED, __HIP_MEMORY_SCOPE_AGENT); }
__device__ __forceinline__ unsigned xb_add(unsigned* p, unsigned v) { return __hip_atomic_fetch_add(p, v, __ATOMIC_RELAXED, __HIP_MEMORY_SCOPE_AGENT); }
__device__ __forceinline__ unsigned xb_xcc_id() { return (unsigned)__builtin_amdgcn_s_getreg((3 << 11) | 20) & 0xFu; }
#define XB_SPIN(cond, bar) do { unsigned _sp = 0; while (cond) { __builtin_amdgcn_s_sleep(1); \
    if ((++_sp & 255u) == 0u) { if (xb_ld(&(bar)[XB_TMO])) break; if (_sp > XB_SPIN_CAP) { atomicAdd(&(bar)[XB_TMO], 1u); break; } } } } while (0)
struct XcdBarrier { unsigned* bar; unsigned x; volatile LAS unsigned* st; };
__device__ __forceinline__ XcdBarrier xcd_barrier_post(unsigned* bar, volatile LAS unsigned* st) {
    XcdBarrier b; b.bar = bar; b.x = xb_xcc_id(); b.st = st;
    if (threadIdx.x == 0) (void)xb_add(&bar[XB_XCNT(b.x)], 1u);
    return b;
}
__device__ __forceinline__ void xcd_barrier_complete(unsigned* bar, unsigned x, unsigned& nloc, unsigned& nx) {
    const unsigned G = gridDim.x * gridDim.y * gridDim.z;
    unsigned sum, cnt, mine, sp = 0u;
    for (;;) {
        sum = 0u; cnt = 0u; mine = 0u;
#pragma unroll
        for (unsigned j = 0; j < 16; ++j) { const unsigned c = xb_ld(&bar[XB_XCNT(j)]); sum += c; cnt += (c > 0u) ? 1u : 0u; mine = (j == x) ? c : mine; }
        if (sum == G) break;
        __builtin_amdgcn_s_sleep(1);
        if ((++sp & 255u) == 0u) { if (xb_ld(&bar[XB_TMO])) break; if (sp > XB_SPIN_CAP) { atomicAdd(&bar[XB_TMO], 1u); break; } }
    }
    nloc = mine > 0u ? mine : 1u; nx = cnt > 0u ? cnt : 1u;
}
__device__ __forceinline__ void xcd_barrier(const XcdBarrier& b) {
    asm volatile("s_waitcnt vmcnt(0)" ::: "memory");
    __syncthreads();
    if (threadIdx.x == 0) {
        unsigned* bar = b.bar;
        __builtin_amdgcn_s_waitcnt(0);
        unsigned nloc = b.st[0], nx = b.st[1];
        if (nloc == 0u) { xcd_barrier_complete(bar, b.x, nloc, nx); b.st[0] = nloc; b.st[1] = nx; }
        const unsigned old = xb_add(&bar[XB_XSUB(b.x)], 1u);
        const unsigned gen = old / nloc;
        if (old + 1u == (gen + 1u) * nloc) {
            __builtin_amdgcn_fence(__ATOMIC_RELEASE, "agent");
            asm volatile("s_waitcnt vmcnt(0)" ::: "memory");
            const unsigned og = xb_add(&bar[XB_TOP], 1u);
            const unsigned tg = og / nx;
            if (og + 1u == (tg + 1u) * nx) xb_add(&bar[XB_TOPGEN], 1u);
            else XB_SPIN(xb_ld(&bar[XB_TOPGEN]) == tg, bar);
            __builtin_amdgcn_fence(__ATOMIC_ACQUIRE, "agent");
            xb_add(&bar[XB_XGEN(b.x)], 1u);
            asm volatile("s_waitcnt vmcnt(0)" ::: "memory");
        } else {
            XB_SPIN(xb_ld(&bar[XB_XGEN(b.x)]) == gen, bar);
            __builtin_amdgcn_fence(__ATOMIC_ACQUIRE, "agent");
            asm volatile("s_waitcnt vmcnt(0)" ::: "memory");
        }
    }
    __syncthreads();
}

struct Args { const float* in[21]; float* out; unsigned char* ws; int ph_lo, ph_hi; };
static_assert(sizeof(Args) == 23 * 8 + 8, "Args has no padding bytes");
typedef const __attribute__((address_space(4))) Args* KArgs;
enum { I_X = 0, I_C, I_CTX, I_CCTX, I_WMOD, I_BMOD, I_N1G, I_N2G, I_WIN, I_WG2, I_BG, I_RPB, I_GLAG, I_WOUT, I_POOLW, I_POOLS, I_WUP, I_CONVW, I_CONVB, I_WDOWN, I_FING };
struct Frame {
    LAS unsigned char* lds; unsigned char* ldsg;
    volatile LAS unsigned* MISC;
    int tid, lane, wave, vcu, G;
    KArgs ka; unsigned char* ws;
};
__device__ __forceinline__ float wave_sum(float v) {
#pragma unroll
    for (int o = 1; o < 64; o <<= 1) v += __shfl_xor(v, o);
    return v;
}

__device__ __forceinline__ void p0_transpose_item(const float* W, int K, int N, bf16* WT, LAS float* scr, int item, int lane, int ldt = 0) {
    if (ldt == 0) ldt = K;
    const int nblk = N / 32, kb = item / nblk, nb = item % nblk, k0 = 64 * kb, n0 = 32 * nb;
#pragma unroll 8
    for (int i = 0; i < 32; ++i) { const int kk = 2 * i + (lane >> 5); scr[kk * 33 + (lane & 31)] = W[(size_t)(k0 + kk) * N + n0 + (lane & 31)]; }
    LDS_WAIT(); asm volatile("" ::: "memory");
    const int c = lane & 7;
#pragma unroll
    for (int j = 0; j < 4; ++j) { const int n = (lane >> 3) + 8 * j; const LAS float* s = scr + (8 * c) * 33 + n;
        v4u o; o.x = pk2(s[0 * 33], s[1 * 33]); o.y = pk2(s[2 * 33], s[3 * 33]); o.z = pk2(s[4 * 33], s[5 * 33]); o.w = pk2(s[6 * 33], s[7 * 33]);
        *(GAS v4u*)(WT + (size_t)(n0 + n) * ldt + k0 + 8 * c) = o; }
    LDS_WAIT(); asm volatile("" ::: "memory");
}
__device__ __forceinline__ void p0_transpose_item_up(const float* W, bf16* WT, LAS float* scr, int item, int lane) {
    constexpr int K = D, N = DUP;
    const int nblk = N / 32, kb = item / nblk, nb = item % nblk, k0 = 64 * kb, n0 = 32 * nb;
    const int isg = n0 >= DFF, c0 = isg ? n0 - DFF : n0, d0 = 256 * (c0 >> 7) + (isg ? 128 : 0) + (c0 & 127);
#pragma unroll 8
    for (int i = 0; i < 32; ++i) { const int kk = 2 * i + (lane >> 5); scr[kk * 33 + (lane & 31)] = W[(size_t)(k0 + kk) * N + n0 + (lane & 31)]; }
    LDS_WAIT(); asm volatile("" ::: "memory");
    const int c = lane & 7;
#pragma unroll
    for (int j = 0; j < 4; ++j) { const int n = (lane >> 3) + 8 * j; const LAS float* s = scr + (8 * c) * 33 + n;
        v4u o; o.x = pk2(s[0 * 33], s[1 * 33]); o.y = pk2(s[2 * 33], s[3 * 33]); o.z = pk2(s[4 * 33], s[5 * 33]); o.w = pk2(s[6 * 33], s[7 * 33]);
        *(GAS v4u*)(WT + (size_t)(d0 + n) * K + k0 + 8 * c) = o; }
    LDS_WAIT(); asm volatile("" ::: "memory");
}
__device__ __forceinline__ void ph_prologue(Frame& F) {
    const int gw = F.vcu * NWAVES + F.wave, NGW = F.G * NWAVES;
    const int gt = F.vcu * NWAVES * 64 + F.tid, NGT = F.G * NWAVES * 64;
    {
        LAS float* scr = (LAS float*)(F.lds + RING_OFF + F.wave * 16384);
        constexpr int I_IN = (D / 64) * (DIN / 32), I_OUT = (D / 64) * (D / 32), I_POOL = (512 / 64) * (512 / 32), I_UP = (D / 64) * (DUP / 32), I_DOWN = (DFF / 64) * (D / 32);
        constexpr int NITEMS = 2 * I_IN + 2 * I_OUT + 8 * I_POOL + 4 * I_UP + 4 * I_DOWN;
        bf16* WIN = (bf16*)(F.ws + WS_WIN); bf16* WOUT = (bf16*)(F.ws + WS_WOUT); bf16* WPOOL = (bf16*)(F.ws + WS_WPOOL); bf16* WUP = (bf16*)(F.ws + WS_WUP); bf16* WDOWN = (bf16*)(F.ws + WS_WDOWN);
        for (int it = gw; it < NITEMS; it += NGW) {
            int r = it;
            if (r < 4 * I_UP) { const int l = r / I_UP; p0_transpose_item_up((F.ka->in[I_WUP]) + (size_t)l * D * DUP, WUP + (size_t)l * DUP * D, scr, r % I_UP, F.lane); continue; } r -= 4 * I_UP;
            if (r < 4 * I_DOWN) { const int l = r / I_DOWN; p0_transpose_item((F.ka->in[I_WDOWN]) + (size_t)l * DFF * D, DFF, D, WDOWN + (size_t)l * D * LDF, scr, r % I_DOWN, F.lane, LDF); continue; } r -= 4 * I_DOWN;
            if (r < 2 * I_IN) { const int l = r / I_IN; p0_transpose_item((F.ka->in[I_WIN]) + (size_t)l * D * DIN, D, DIN, WIN + (size_t)l * DINP * D, scr, r % I_IN, F.lane); continue; } r -= 2 * I_IN;
            if (r < 2 * I_OUT) { const int l = r / I_OUT; p0_transpose_item((F.ka->in[I_WOUT]) + (size_t)l * D * D, D, D, WOUT + (size_t)l * D * D, scr, r % I_OUT, F.lane); continue; } r -= 2 * I_OUT;
            { const int l = r / I_POOL; p0_transpose_item((F.ka->in[I_POOLW]) + (size_t)l * 512 * 512, 512, 512, WPOOL + (size_t)l * 512 * 512, scr, r % I_POOL, F.lane); }
        }
        constexpr int ZV = (DINP - DIN) * D / 8;
        for (int i = gt; i < 2 * ZV; i += NGT) { const int l = i / ZV, j = i % ZV; *(GAS v4u*)(WIN + (size_t)l * DINP * D + (size_t)DIN * D + (size_t)j * 8) = (v4u){0u, 0u, 0u, 0u}; }
    }
    if (blockIdx.x == 0) {
        float* rc = (float*)(F.ws + WS_ROPE); float* rs = rc + 64 * 16;
        for (int i = F.tid; i < 64 * 16; i += NWAVES * 64) { const int pos = i >> 4, f = i & 15; const float inv = powf(10000.0f, -(float)f / 16.0f); const float ang = (float)pos * inv; rc[i] = cosf(ang); rs[i] = sinf(ang); }
    }
    __syncthreads();
    {
        LAS float* S = (LAS float*)(F.lds + RING_OFF);
        LAS float* RED = (LAS float*)(F.lds + RING_OFF + 40960);
        float* MOD = (float*)(F.ws + WS_MOD);
        constexpr int NTASK = DEPTH * (MODW / 256);
        if ((int)blockIdx.x < NTASK) {
            for (int i = F.tid; i < 5 * D; i += NWAVES * 64) { const int r = i / D, k = i % D; const float v = r < 4 ? (F.ka->in[I_C])[r * D + k] : (F.ka->in[I_CCTX])[k]; S[i] = v / (1.0f + __expf(-v)); }
            __syncthreads();
            for (int t = blockIdx.x; t < NTASK; t += F.G) {
                const int l = t / (MODW / 256), n0 = (t % (MODW / 256)) * 256, k0 = F.wave * 256;
                float acc[5][4];
#pragma unroll
                for (int r = 0; r < 5; ++r)
#pragma unroll
                    for (int cc = 0; cc < 4; ++cc) acc[r][cc] = 0.f;
                const float* Wp = (F.ka->in[I_WMOD]) + ((size_t)l * D + k0) * MODW + n0 + 4 * F.lane;
                for (int kk = 0; kk < 256; kk += 8) {
                    f32x4 wv[8];
#pragma unroll
                    for (int u = 0; u < 8; ++u) wv[u] = *(const f32x4*)(Wp + (size_t)(kk + u) * MODW);
#pragma unroll
                    for (int u = 0; u < 8; ++u)
#pragma unroll
                        for (int r = 0; r < 5; ++r) { const float s = S[r * D + k0 + kk + u];
#pragma unroll
                            for (int cc = 0; cc < 4; ++cc) acc[r][cc] = fmaf(s, wv[u][cc], acc[r][cc]); }
                }
#pragma unroll
                for (int r = 0; r < 5; ++r)
#pragma unroll
                    for (int cc = 0; cc < 4; ++cc) RED[(F.wave * 5 + r) * 256 + 4 * F.lane + cc] = acc[r][cc];
                __syncthreads();
                for (int o = F.tid; o < 5 * 256; o += NWAVES * 64) { const int r = o >> 8, ci = o & 255; float s = (F.ka->in[I_BMOD])[l * MODW + n0 + ci];
#pragma unroll
                    for (int w = 0; w < 8; ++w) s += RED[(w * 5 + r) * 256 + ci];
                    MOD[((size_t)l * 5 + r) * MODW + n0 + ci] = s; }
                __syncthreads();
            }
        }
    }
}

__device__ __forceinline__ f32x4 bf4_unpack(v2u h) { f32x4 r; r.x = pg8::h_lo(h.x); r.y = pg8::h_hi(h.x); r.z = pg8::h_lo(h.y); r.w = pg8::h_hi(h.y); return r; }
template <bool L16, bool CPY, bool CI>
__device__ __forceinline__ void norm_rows(Frame& F, const int ra, const int rb, const void* src, const int rbase, const float* g, const float* modl, const int off_sh, const int off_sc, const int nparts) {
    if (ra >= rb) return;
    bf16* H = (bf16*)(F.ws + WS_H);
    f32x4 gm[8], sh[8]; int cb = -1;
    f32x4 v[8], w[8]; v2u hv[8], hw[8];
#define NORM_P32(m) ((const f32x4*)((const float*)src + (size_t)((m) - rbase) * D) + F.lane)
#define NORM_P16(m) ((const v2u*)((const bf16*)src + (size_t)((m) - rbase) * D) + F.lane)
    if constexpr (L16) { const v2u* xr = NORM_P16(ra);
#pragma unroll
        for (int j = 0; j < 8; ++j) hv[j] = xr[64 * j];
    } else { const f32x4* xr = NORM_P32(ra);
#pragma unroll
        for (int j = 0; j < 8; ++j) v[j] = xr[64 * j]; }
    for (int m = ra; m < rb; ++m) {
        if (m + 1 < rb) {
            if constexpr (L16) { const v2u* xn = NORM_P16(m + 1);
#pragma unroll
                for (int j = 0; j < 8; ++j) hw[j] = xn[64 * j];
            } else { const f32x4* xn = NORM_P32(m + 1);
#pragma unroll
                for (int j = 0; j < 8; ++j) w[j] = xn[64 * j]; } }
        const int bidx = m < MLAT ? (m >> 12) : 4;
        if (bidx != cb) { cb = bidx;
            const f32x4* gp = (const f32x4*)g + F.lane; const f32x4* shp = (const f32x4*)(modl + (size_t)bidx * MODW + off_sh) + F.lane; const f32x4* scp = (const f32x4*)(modl + (size_t)bidx * MODW + off_sc) + F.lane;
#pragma unroll
            for (int j = 0; j < 8; ++j) { gm[j] = gp[64 * j] * (scp[64 * j] + 1.0f); sh[j] = shp[64 * j]; } }
        if constexpr (L16) {
#pragma unroll
            for (int j = 0; j < 8; ++j) v[j] = bf4_unpack(hv[j]); }
        if constexpr (CI) {
            for (int k = 0; k < nparts; ++k) { const f32x4* pp = (const f32x4*)((const float*)(F.ws + WS_PART) + ((size_t)k * MCTX + (size_t)(m - rbase)) * D) + F.lane;
#pragma unroll
                for (int j = 0; j < 8; ++j) v[j] = v[j] + pp[64 * j]; }
            f32x4* xw = (f32x4*)((float*)(F.ws + WS_XR) + (size_t)m * D) + F.lane;
#pragma unroll
            for (int j = 0; j < 8; ++j) xw[64 * j] = v[j]; }
        float s = 0.f;
#pragma unroll
        for (int j = 0; j < 8; ++j) s += (v[j].x * v[j].x + v[j].y * v[j].y) + (v[j].z * v[j].z + v[j].w * v[j].w);
        const float r = 1.0f / sqrtf(wave_sum(s) * (1.0f / D) + EPS);
        v2u* o8 = (v2u*)(H + (size_t)m * D) + F.lane;
#pragma unroll
        for (int j = 0; j < 8; ++j) { const f32x4 y = v[j] * r * gm[j] + sh[j]; v2u ww; ww.x = pk2h(y.x, y.y); ww.y = pk2h(y.z, y.w); o8[64 * j] = ww; }
        if constexpr (CPY) { v2u* c8 = (v2u*)((bf16*)(F.ws + WS_X16) + (size_t)m * D) + F.lane;
#pragma unroll
            for (int j = 0; j < 8; ++j) { v2u ww; ww.x = pg8::pk_h2(v[j].x, v[j].y); ww.y = pg8::pk_h2(v[j].z, v[j].w); c8[64 * j] = ww; } }
        if constexpr (L16) {
#pragma unroll
            for (int j = 0; j < 8; ++j) hv[j] = hw[j];
        } else {
#pragma unroll
            for (int j = 0; j < 8; ++j) v[j] = w[j]; }
    }
#undef NORM_P32
#undef NORM_P16
}
__device__ __forceinline__ void ph_norm(Frame& F, int nrows, const float* xl32, const float* xc, const float* g, const float* modl, int off_sh, int off_sc, int nparts) {
    const int gw = F.vcu * NWAVES + F.wave; int NGW = F.G * NWAVES; asm volatile("" : "+s"(NGW));
    const int nctx = nrows - MLAT;
    const int r0 = (int)((unsigned)gw * (unsigned)MLAT / (unsigned)NGW), r1 = (int)((unsigned)(gw + 1) * (unsigned)MLAT / (unsigned)NGW);
    const int c0 = MLAT + (int)((unsigned)gw * (unsigned)nctx / (unsigned)NGW), c1 = MLAT + (int)((unsigned)(gw + 1) * (unsigned)nctx / (unsigned)NGW);
    if (xl32) { norm_rows<false, true, false>(F, r0, r1, xl32, 0, g, modl, off_sh, off_sc, 0); norm_rows<false, false, false>(F, c0, c1, xc, MLAT, g, modl, off_sh, off_sc, 0); }
    else      { norm_rows<true, false, false>(F, r0, r1, F.ws + WS_X16, 0, g, modl, off_sh, off_sc, 0); norm_rows<false, false, true>(F, c0, c1, xc, MLAT, g, modl, off_sh, off_sc, nparts); }
}
__device__ __forceinline__ void ph_final(Frame& F) {
    const int gw = F.vcu * NWAVES + F.wave, NGW = F.G * NWAVES;
    const bf16* X16 = (const bf16*)(F.ws + WS_X16);
    const int r0 = (int)((long)gw * MLAT / NGW), r1 = (int)((long)(gw + 1) * MLAT / NGW);
    if (r0 >= r1) return;
    f32x4 gf[8], v[8]; v2u hv[8], hw[8];
    { const f32x4* gp = (const f32x4*)(F.ka->in[I_FING]) + F.lane; const v2u* xr = (const v2u*)(X16 + (size_t)r0 * D) + F.lane;
#pragma unroll
      for (int j = 0; j < 8; ++j) { gf[j] = gp[64 * j]; hv[j] = xr[64 * j]; } }
    for (int m = r0; m < r1; ++m) {
        if (m + 1 < r1) { const v2u* xn = (const v2u*)(X16 + (size_t)(m + 1) * D) + F.lane;
#pragma unroll
            for (int j = 0; j < 8; ++j) hw[j] = xn[64 * j]; }
#pragma unroll
        for (int j = 0; j < 8; ++j) v[j] = bf4_unpack(hv[j]);
        float s = 0.f;
#pragma unroll
        for (int j = 0; j < 8; ++j) s += (v[j].x * v[j].x + v[j].y * v[j].y) + (v[j].z * v[j].z + v[j].w * v[j].w);
        const float r = 1.0f / sqrtf(wave_sum(s) * (1.0f / D) + EPS);
        f32x4* op = (f32x4*)((F.ka->out) + (size_t)m * D) + F.lane;
#pragma unroll
        for (int j = 0; j < 8; ++j) __builtin_nontemporal_store(v[j] * r * gf[j], op + 64 * j);
#pragma unroll
        for (int j = 0; j < 8; ++j) hv[j] = hw[j];
    }
}
template <int HW>
__device__ __forceinline__ void pool_strip(const bf16* H, bf16* HP, int m0, int t0, int L, int c8) {
    constexpr int NR = 8 + 2 * HW - 1;
    v4u R[NR];
#pragma unroll
    for (int j = 0; j < NR; ++j) { const int tr = t0 - HW + j; R[j] = (v4u){0u, 0u, 0u, 0u}; if (tr >= 0 && tr < L) R[j] = *(const v4u*)(H + (size_t)(m0 - HW + j) * D + c8); }
    float s[8];
#pragma unroll
    for (int e = 0; e < 8; ++e) s[e] = 0.f;
#pragma unroll
    for (int j = 0; j < 2 * HW; ++j) { s[0] += bflo(R[j].x); s[1] += bfhi(R[j].x); s[2] += bflo(R[j].y); s[3] += bfhi(R[j].y); s[4] += bflo(R[j].z); s[5] += bfhi(R[j].z); s[6] += bflo(R[j].w); s[7] += bfhi(R[j].w); }
#pragma unroll
    for (int r = 0; r < 8; ++r) {
        const int t = t0 + r; const float inv = __builtin_amdgcn_rcpf((float)(min(t + HW, L) - max(t - HW, 0)));
        const v4u w = R[r + HW];
        v4u o; o.x = pk2h(s[0] * inv - bflo(w.x), s[1] * inv - bfhi(w.x)); o.y = pk2h(s[2] * inv - bflo(w.y), s[3] * inv - bfhi(w.y));
        o.z = pk2h(s[4] * inv - bflo(w.z), s[5] * inv - bfhi(w.z)); o.w = pk2h(s[6] * inv - bflo(w.w), s[7] * inv - bfhi(w.w));
        *(v4u*)(HP + (size_t)(m0 + r) * D + c8) = o;
        if (r < 7) { const v4u a = R[r + 2 * HW], b = R[r];
            s[0] += bflo(a.x) - bflo(b.x); s[1] += bfhi(a.x) - bfhi(b.x); s[2] += bflo(a.y) - bflo(b.y); s[3] += bfhi(a.y) - bfhi(b.y);
            s[4] += bflo(a.z) - bflo(b.z); s[5] += bfhi(a.z) - bfhi(b.z); s[6] += bflo(a.w) - bflo(b.w); s[7] += bfhi(a.w) - bfhi(b.w); }
    }
}
__device__ __forceinline__ void ph_pool(Frame& F, int nrows) {
    const int gt = F.vcu * NWAVES * 64 + F.tid, NGT = F.G * NWAVES * 64;
    const bf16* H = (const bf16*)(F.ws + WS_H); bf16* HP = (bf16*)(F.ws + WS_MIX);
    const int nitems = (nrows / 8) * (D / 8);
    for (int it = gt; it < nitems; it += NGT) {
        const int strip = it >> 8, c8 = (it & 255) * 8, gi = __builtin_amdgcn_readfirstlane(c8 >> 9), m0 = strip * 8;
        int t0, L;
        if (m0 < MLAT) { t0 = m0 & (SEQ - 1); L = SEQ; } else { t0 = (m0 - MLAT) & (CTXL - 1); L = CTXL; }
        if (gi == 0) pool_strip<1>(H, HP, m0, t0, L, c8); else if (gi == 1) pool_strip<2>(H, HP, m0, t0, L, c8); else if (gi == 2) pool_strip<4>(H, HP, m0, t0, L, c8); else pool_strip<8>(H, HP, m0, t0, L, c8);
    }
}
__device__ __forceinline__ void ph_glufix(Frame& F, int nrows, const float* cw, const float* cb) {
    const int gt = F.vcu * NWAVES * 64 + F.tid, NGT = F.G * NWAVES * 64;
    const float* SB = (const float*)(F.ws + WS_SB); bf16* ACT = (bf16*)(F.ws + WS_ACT);
    constexpr int C4 = DFF / 4;
    const int nitems = (nrows / 256) * 2 * C4;
    for (int it = gt; it < nitems; it += NGT) {
        const int c4 = (it % C4) * 4, pw = it / C4, which = pw & 1, pm = pw >> 1, row = 256 * pm + (which ? 255 : 0);
        int t, L;
        if (row < MLAT) { t = row & (SEQ - 1); L = SEQ; } else { t = (row - MLAT) & (CTXL - 1); L = CTXL; }
        const float* sb = SB + ((size_t)(pm * 2 + which) * 3) * DFF + c4;
        f32x4 cv = *(const f32x4*)sb; const f32x4 vl = *(const f32x4*)(sb + DFF);
        if (which == 0 && t > 0)     cv = cv + *(const f32x4*)(cw + c4) * *(const f32x4*)(SB + ((size_t)((pm - 1) * 2 + 1) * 3 + 2) * DFF + c4);
        if (which == 1 && t < L - 1) cv = cv + *(const f32x4*)(cw + 2 * DFF + c4) * *(const f32x4*)(SB + ((size_t)((pm + 1) * 2 + 0) * 3 + 2) * DFF + c4);
        const pg8::f32x2 g0 = pg8::gelu_pk((pg8::f32x2){cv.x, cv.y}), g1 = pg8::gelu_pk((pg8::f32x2){cv.z, cv.w});
        v2u o; o.x = pk2h(g0.x * vl.x, g0.y * vl.y); o.y = pk2h(g1.x * vl.z, g1.y * vl.w);
        *(v2u*)(ACT + (size_t)row * LDF + c4) = o;
    }
}

namespace gla {
typedef short bf16x8 __attribute__((ext_vector_type(8)));
typedef float f32x16 __attribute__((ext_vector_type(16)));
typedef unsigned u32x4 __attribute__((ext_vector_type(4)));
constexpr int NRC = MR / 64;
constexpr int PITCH = 72;
__device__ __forceinline__ int crow(int r, int hi) { return (r & 3) + 8 * (r >> 2) + 4 * hi; }
__device__ __forceinline__ unsigned cvtpk(float lo, float hi) { unsigned r; asm volatile("v_cvt_pk_bf16_f32 %0, %1, %2" : "=v"(r) : "v"(lo), "v"(hi)); return r; }
__device__ __forceinline__ int chain_slot_rc(int b, int dir, int s) { return s < 4 ? 256 + 4 * b + (dir ? 3 - s : s) : 64 * b + (dir ? 63 - (s - 4) : s - 4); }
__device__ __forceinline__ int rc_slot(int rc, int dir) { return rc < 256 ? 4 + (dir ? 63 - (rc & 63) : (rc & 63)) : (dir ? 3 - (rc & 3) : (rc & 3)); }
__device__ __forceinline__ int rc_batch(int rc) { return rc < 256 ? rc >> 6 : (rc - 256) >> 2; }
__device__ __forceinline__ float logsig16(float z2) { return (fminf(z2, 0.f) - __builtin_amdgcn_logf(1.0f + __builtin_amdgcn_exp2f(-fabsf(z2)))) * (1.0f / 16.0f); }

__device__ __forceinline__ void ph_prep(Frame& F, int e) {
    const bf16* P = (const bf16*)(F.ws + WS_P);
    bf16* QF = (bf16*)(F.ws + WS_QF); bf16* KF = (bf16*)(F.ws + WS_KF); bf16* QB = (bf16*)(F.ws + WS_QB); bf16* KB = (bf16*)(F.ws + WS_KB);
    float* AL = (float*)(F.ws + WS_AL);
    const float* ropec = (const float*)(F.ws + WS_ROPE); const float* ropes = ropec + 64 * 16;
    const float* w2 = (F.ka->in[I_WG2]) + (size_t)e * 2 * 16 * 512; const float* bg = (F.ka->in[I_BG]) + (size_t)e * 2 * 512;
    LAS float* ABf = (LAS float*)(F.lds + RING_OFF);
    LAS float* RTc = (LAS float*)(F.lds + RING_OFF + 8192); LAS float* RTs = RTc + 64 * 16;
    for (int i = F.tid; i < 2 * 64 * 16; i += NWAVES * 64) RTc[i] = ropec[i];
    const int dk = F.lane;
    pg8::f32x2 wfb[16], bfb; int col;
    const int hf = dk >> 5, f = dk & 15; const float sgn = ((dk >> 4) & 1) ? 1.0f : -1.0f;
#define GLA_Z(t, zf, zb) do { const LAS f32x4* ap = (const LAS f32x4*)(ABf + (t) * 32); pg8::f32x2 z2 = bfb; \
        _Pragma("unroll") for (int i = 0; i < 8; ++i) { const f32x4 a = ap[i]; z2 = (pg8::f32x2){a.x, a.y} * wfb[2 * i] + z2; z2 = (pg8::f32x2){a.z, a.w} * wfb[2 * i + 1] + z2; } \
        zf = z2.x; zb = z2.y; } while (0)
    const int NT = 256 + (NRC - 256) * 8;
    for (int task = blockIdx.x; task < NT; task += F.G) {
        const int rc = task < 256 ? task : 256 + ((task - 256) >> 3), h = task < 256 ? F.wave : ((task - 256) & 7);
        const bool active = task < 256 || F.wave == 0;
        const bool lat = rc < 256;
        const bf16* Prow0 = P + (size_t)rc * 64 * DINP;
        col = 64 * h + dk;
#pragma unroll
        for (int i = 0; i < 16; ++i) wfb[i] = (pg8::f32x2){w2[i * 512 + col], w2[(16 + i) * 512 + col]} * 1.4426950408889634f;
        bfb = (pg8::f32x2){bg[col], bg[512 + col]} * 1.4426950408889634f;
        __syncthreads();
        if (F.tid < 256) { const int row = F.tid >> 2, part = F.tid & 3; const v4u w = *(const v4u*)(Prow0 + (size_t)row * DINP + C_AB + 8 * part);
            LAS float* d = ABf + row * 32 + 16 * (part & 1) + (part >> 1);
            d[0] = bflo(w.x); d[2] = bfhi(w.x); d[4] = bflo(w.y); d[6] = bfhi(w.y); d[8] = bflo(w.z); d[10] = bfhi(w.z); d[12] = bflo(w.w); d[14] = bfhi(w.w); }
        __syncthreads();
        if (!active) continue;
        const int prw = rc & 63;
        float pf = 0.f, pbx = 0.f;
        for (int t8 = 0; t8 < 64; t8 += 8) {
            float qv[8], kv[8];
#pragma unroll
            for (int tt = 0; tt < 8; ++tt) { const bf16* prow = Prow0 + (size_t)(t8 + tt) * DINP; qv[tt] = bf2f(prow[C_QB + col]); kv[tt] = bf2f(prow[C_KB + col]); }
#pragma unroll
            for (int tt = 0; tt < 8; ++tt) {
                const int t = t8 + tt;
                float zf, zb; GLA_Z(t, zf, zb);
                const float gf = logsig16(zf), gb = logsig16(zb);
                pf += gf; const float cumf = pf, pbe = pbx; pbx += gb;
                float q = qv[tt], k = kv[tt];
                float qp, kp;
                { const unsigned uq = __builtin_bit_cast(unsigned, q), uk = __builtin_bit_cast(unsigned, k);
                  const auto rq = __builtin_amdgcn_permlane16_swap(uq, uq, false, false); const auto rk = __builtin_amdgcn_permlane16_swap(uk, uk, false, false);
                  qp = __builtin_bit_cast(float, (dk & 16) ? rq[0] : rq[1]); kp = __builtin_bit_cast(float, (dk & 16) ? rk[0] : rk[1]); }
                if (lat) { const int ri = (hf ? t : prw) * 16 + f; const float c = RTc[ri], s = RTs[ri];
                    const float ss = s * sgn; q = fmaf(qp, ss, q * c); k = fmaf(kp, ss, k * c); }
                q *= 0.125f;
                const unsigned o = (unsigned)((rc * 64 + t) * 512 + col);
                const unsigned wq = pg8::cvt_pk_bf16(q * __builtin_amdgcn_exp2f(cumf), q * __builtin_amdgcn_exp2f(fminf(-pbe, 115.f))), wk = pg8::cvt_pk_bf16(k * __builtin_amdgcn_exp2f(fminf(-cumf, 115.f)), k * __builtin_amdgcn_exp2f(pbe));
                QF[o] = (bf16)(wq & 0xffffu); QB[o] = (bf16)(wq >> 16); KF[o] = (bf16)(wk & 0xffffu); KB[o] = (bf16)(wk >> 16);
            }
        }
        AL[(size_t)(0 * NRC + rc) * 512 + col] = __builtin_amdgcn_exp2f(pf); AL[(size_t)(1 * NRC + rc) * 512 + col] = __builtin_amdgcn_exp2f(pbx);
    }
#undef GLA_Z
    __syncthreads();
}

__device__ __forceinline__ void stage_vt(Frame& F, const bf16* P, int rc, int h, LAS bf16* VT) {
    const int tp = (F.tid & 31) * 2, d8 = (F.tid >> 5) * 8;
    const bf16* src = P + (size_t)(rc * 64 + tp) * DINP + C_VB + 128 * h + d8;
    const v4u w0 = *(const v4u*)src, w1 = *(const v4u*)(src + DINP);
    LAS unsigned* dst = (LAS unsigned*)(VT + d8 * PITCH + tp);
    dst[0 * (PITCH / 2)] = (w0.x & 0xffffu) | (w1.x << 16); dst[1 * (PITCH / 2)] = (w0.x >> 16) | (w1.x & 0xffff0000u);
    dst[2 * (PITCH / 2)] = (w0.y & 0xffffu) | (w1.y << 16); dst[3 * (PITCH / 2)] = (w0.y >> 16) | (w1.y & 0xffff0000u);
    dst[4 * (PITCH / 2)] = (w0.z & 0xffffu) | (w1.z << 16); dst[5 * (PITCH / 2)] = (w0.z >> 16) | (w1.z & 0xffff0000u);
    dst[6 * (PITCH / 2)] = (w0.w & 0xffffu) | (w1.w << 16); dst[7 * (PITCH / 2)] = (w0.w >> 16) | (w1.w & 0xffff0000u);
}
#define GLA_BAR() do { asm volatile("s_waitcnt lgkmcnt(0)" ::: "memory"); __builtin_amdgcn_s_barrier(); asm volatile("" ::: "memory"); } while (0)
#define GLA_FRAG(base, row, col) (*(const LAS bf16x8*)((base) + (row) * PITCH + (col)))

__device__ __forceinline__ void ph_g1(Frame& F) {
    const bf16* P = (const bf16*)(F.ws + WS_P); const bf16* KFg = (const bf16*)(F.ws + WS_KF); const bf16* KBg = (const bf16*)(F.ws + WS_KB); bf16* UT = (bf16*)(F.ws + WS_UT); const float* AL = (const float*)(F.ws + WS_AL);
    LAS bf16* VT = (LAS bf16*)(F.lds + RING_OFF); LAS bf16* KH0 = VT + 128 * PITCH; LAS bf16* KH1 = KH0 + 64 * PITCH;
    const int r32 = F.lane & 31, hi = F.lane >> 5, dir = F.wave >> 2, db = F.wave & 3;
    for (int u = blockIdx.x; u < NRC * 8; u += F.G) {
        const int rc = u >> 3, h = u & 7;
        __syncthreads();
        stage_vt(F, P, rc, h, VT);
        {
            const int half = F.tid >> 8, tl = F.tid & 255, tp = (tl & 31) * 2, d8 = (tl >> 5) * 8;
            const bf16* src = (half ? KBg : KFg) + (size_t)(rc * 64 + tp) * 512 + 64 * h + d8;
            const v4u w0 = *(const v4u*)src, w1 = *(const v4u*)(src + 512);
            LAS unsigned* dst = (LAS unsigned*)((half ? KH1 : KH0) + d8 * PITCH + tp);
            dst[0 * (PITCH / 2)] = (w0.x & 0xffffu) | (w1.x << 16); dst[1 * (PITCH / 2)] = (w0.x >> 16) | (w1.x & 0xffff0000u);
            dst[2 * (PITCH / 2)] = (w0.y & 0xffffu) | (w1.y << 16); dst[3 * (PITCH / 2)] = (w0.y >> 16) | (w1.y & 0xffff0000u);
            dst[4 * (PITCH / 2)] = (w0.z & 0xffffu) | (w1.z << 16); dst[5 * (PITCH / 2)] = (w0.z >> 16) | (w1.z & 0xffff0000u);
            dst[6 * (PITCH / 2)] = (w0.w & 0xffffu) | (w1.w << 16); dst[7 * (PITCH / 2)] = (w0.w >> 16) | (w1.w & 0xffff0000u); }
        __syncthreads();
        const LAS bf16* KH = dir ? KH1 : KH0;
        f32x16 acc0 = {}, acc1 = {};
#pragma unroll
        for (int ks = 0; ks < 4; ++ks) { const bf16x8 a = GLA_FRAG(VT, 32 * db + r32, 16 * ks + 8 * hi);
            acc0 = __builtin_amdgcn_mfma_f32_32x32x16_bf16(a, GLA_FRAG(KH, r32, 16 * ks + 8 * hi), acc0, 0, 0, 0);
            acc1 = __builtin_amdgcn_mfma_f32_32x32x16_bf16(a, GLA_FRAG(KH, 32 + r32, 16 * ks + 8 * hi), acc1, 0, 0, 0); }
        const int b = rc_batch(rc), chain = (b * 8 + h) * 2 + dir, slot = rc_slot(rc, dir);
        if (dir == 0) { const float a0 = AL[(size_t)rc * 512 + 64 * h + r32], a1 = AL[(size_t)rc * 512 + 64 * h + 32 + r32];
#pragma unroll
            for (int r = 0; r < 16; ++r) { acc0[r] *= a0; acc1[r] *= a1; } }
        bf16* dst = UT + ((size_t)chain * 68 + slot) * 8192;
#pragma unroll
        for (int r = 0; r < 16; ++r) { const int dv = 32 * db + crow(r, hi); const unsigned w2_ = pk2(acc0[r], acc1[r]); dst[dv * 64 + r32] = (bf16)(w2_ & 0xffffu); dst[dv * 64 + 32 + r32] = (bf16)(w2_ >> 16); }
    }
    __syncthreads();
}

__device__ __forceinline__ void ph_g2(Frame& F) {
    const int gt = F.vcu * NWAVES * 64 + F.tid, NGT = F.G * NWAVES * 64;
    const bf16* UT = (const bf16*)(F.ws + WS_UT); bf16* ST = (bf16*)(F.ws + WS_ST); const float* AL = (const float*)(F.ws + WS_AL);
    for (int it = gt; it < 64 * 128 * 16; it += NGT) {
        const int chain = it >> 11, rem = it & 2047, dv = rem >> 4, dk4 = (rem & 15) * 4;
        const int dir = chain & 1, h = (chain >> 1) & 7, b = chain >> 4;
        float S0 = 0.f, S1 = 0.f, S2 = 0.f, S3 = 0.f;
        const size_t base = (size_t)chain * 68 * 8192 + dv * 64 + dk4;
#pragma unroll 17
        for (int s = 0; s < 68; ++s) {
            const v2u uw = *(const v2u*)(UT + base + (size_t)s * 8192);
            const int rc = chain_slot_rc(b, dir, s);
            const f32x4 a = *(const f32x4*)(AL + (size_t)(dir * NRC + rc) * 512 + 64 * h + dk4);
            v2u o; if (dir) { o.x = pk2(S0 * a.x, S1 * a.y); o.y = pk2(S2 * a.z, S3 * a.w); } else { o.x = pk2(S0, S1); o.y = pk2(S2, S3); }
            *(v2u*)(ST + base + (size_t)s * 8192) = o;
            S0 = fmaf(a.x, S0, bflo(uw.x)); S1 = fmaf(a.y, S1, bfhi(uw.x)); S2 = fmaf(a.z, S2, bflo(uw.y)); S3 = fmaf(a.w, S3, bfhi(uw.y));
        }
    }
}

#define GLA_PK4(P, BASE, OUT) do { unsigned a0 = pk2(P[BASE + 0], P[BASE + 1]), a1 = pk2(P[BASE + 2], P[BASE + 3]);   \
    unsigned b0 = pk2(P[BASE + 4], P[BASE + 5]), b1 = pk2(P[BASE + 6], P[BASE + 7]);                              \
    auto r0 = __builtin_amdgcn_permlane32_swap(a0, b0, false, false); auto r1 = __builtin_amdgcn_permlane32_swap(a1, b1, false, false); \
    u32x4 w = {r0[0], r1[0], r0[1], r1[1]}; OUT = *reinterpret_cast<bf16x8*>(&w); } while (0)
template <int DIR>
__device__ __forceinline__ void g3_intra(f32x16& o, const LAS bf16* Kt, const LAS bf16* Qt, const LAS bf16* VT, int jb, int tb, int db, int r32, int hi) {
    f32x16 X = {};
#pragma unroll
    for (int ks = 0; ks < 4; ++ks) X = __builtin_amdgcn_mfma_f32_32x32x16_bf16(GLA_FRAG(Kt, 32 * jb + r32, 16 * ks + 8 * hi), GLA_FRAG(Qt, 32 * tb + r32, 16 * ks + 8 * hi), X, 0, 0, 0);
    if (jb == tb) {
#pragma unroll
        for (int r = 0; r < 16; ++r) { const int tj = crow(r, hi); const bool keep = DIR ? (tj >= r32) : (tj <= r32); X[r] = keep ? X[r] : 0.f; }
    }
    bf16x8 x0, x1; GLA_PK4(X, 0, x0); GLA_PK4(X, 8, x1);
    o = __builtin_amdgcn_mfma_f32_32x32x16_bf16(GLA_FRAG(VT, 32 * db + r32, 32 * jb + 8 * hi), x0, o, 0, 0, 0);
    o = __builtin_amdgcn_mfma_f32_32x32x16_bf16(GLA_FRAG(VT, 32 * db + r32, 32 * jb + 16 + 8 * hi), x1, o, 0, 0, 0);
}
__device__ __forceinline__ void ph_g3(Frame& F, int e, int nrc) {
    const bf16* P = (const bf16*)(F.ws + WS_P); const bf16* ST = (const bf16*)(F.ws + WS_ST); bf16* MIX = (bf16*)(F.ws + WS_MIX);
    const bf16* QFg = (const bf16*)(F.ws + WS_QF); const bf16* KFg = (const bf16*)(F.ws + WS_KF); const bf16* QBg = (const bf16*)(F.ws + WS_QB); const bf16* KBg = (const bf16*)(F.ws + WS_KB);
    const float* gg = (F.ka->in[I_GLAG]) + (size_t)e * 8 * 128;
    LAS bf16* VT = (LAS bf16*)(F.lds + RING_OFF); LAS bf16* QFl = VT + 128 * PITCH; LAS bf16* KFl = QFl + 64 * PITCH; LAS bf16* QBl = KFl + 64 * PITCH; LAS bf16* KBl = QBl + 64 * PITCH;
    LAS float* SS = (LAS float*)(KBl + 64 * PITCH);
    const int r32 = F.lane & 31, hi = F.lane >> 5, tb = F.wave & 1, db = F.wave >> 1;
    const int s_tp = (F.tid & 31) * 2, s_d8 = (F.tid >> 5) * 8, s_t = F.tid >> 3, s_c8 = (F.tid & 7) * 8;
    v4u pv0, pv1, pqf, pkf, pqb, pkb; bf16x8 nsf[4], nsb[4];
#define G3_LOAD(uu) do { const int _rc = (uu) >> 3, _h = (uu) & 7, _b = rc_batch(_rc); \
        const bf16* _vs = P + (size_t)(_rc * 64 + s_tp) * DINP + C_VB + 128 * _h + s_d8; pv0 = *(const v4u*)_vs; pv1 = *(const v4u*)(_vs + DINP); \
        const size_t _go = (size_t)(_rc * 64 + s_t) * 512 + 64 * _h + s_c8; pqf = *(const v4u*)(QFg + _go); pkf = *(const v4u*)(KFg + _go); pqb = *(const v4u*)(QBg + _go); pkb = *(const v4u*)(KBg + _go); \
        const bf16* _sf = ST + ((size_t)((_b * 8 + _h) * 2 + 0) * 68 + rc_slot(_rc, 0)) * 8192 + (size_t)(32 * db + r32) * 64 + 8 * hi; \
        const bf16* _sb = ST + ((size_t)((_b * 8 + _h) * 2 + 1) * 68 + rc_slot(_rc, 1)) * 8192 + (size_t)(32 * db + r32) * 64 + 8 * hi; \
        _Pragma("unroll") for (int ks = 0; ks < 4; ++ks) { nsf[ks] = *(const bf16x8*)(_sf + 16 * ks); nsb[ks] = *(const bf16x8*)(_sb + 16 * ks); } } while (0)
    int u = blockIdx.x;
    if (u < nrc * 8) G3_LOAD(u);
    for (; u < nrc * 8; u += F.G) {
        const int rc = u >> 3, h = u & 7;
        GLA_BAR();
        { LAS unsigned* dst = (LAS unsigned*)(VT + s_d8 * PITCH + s_tp);
            dst[0 * (PITCH / 2)] = (pv0.x & 0xffffu) | (pv1.x << 16); dst[1 * (PITCH / 2)] = (pv0.x >> 16) | (pv1.x & 0xffff0000u);
            dst[2 * (PITCH / 2)] = (pv0.y & 0xffffu) | (pv1.y << 16); dst[3 * (PITCH / 2)] = (pv0.y >> 16) | (pv1.y & 0xffff0000u);
            dst[4 * (PITCH / 2)] = (pv0.z & 0xffffu) | (pv1.z << 16); dst[5 * (PITCH / 2)] = (pv0.z >> 16) | (pv1.z & 0xffff0000u);
            dst[6 * (PITCH / 2)] = (pv0.w & 0xffffu) | (pv1.w << 16); dst[7 * (PITCH / 2)] = (pv0.w >> 16) | (pv1.w & 0xffff0000u);
            const int lo = s_t * PITCH + s_c8;
            *(LAS v4u*)(QFl + lo) = pqf; *(LAS v4u*)(KFl + lo) = pkf; *(LAS v4u*)(QBl + lo) = pqb; *(LAS v4u*)(KBl + lo) = pkb; }
        bf16x8 sf[4], sb[4];
#pragma unroll
        for (int ks = 0; ks < 4; ++ks) { sf[ks] = nsf[ks]; sb[ks] = nsb[ks]; }
        GLA_BAR();
        if (u + F.G < nrc * 8) G3_LOAD(u + F.G);
        f32x16 o = {};
#pragma unroll
        for (int ks = 0; ks < 4; ++ks) { o = __builtin_amdgcn_mfma_f32_32x32x16_bf16(sf[ks], GLA_FRAG(QFl, 32 * tb + r32, 16 * ks + 8 * hi), o, 0, 0, 0);
            o = __builtin_amdgcn_mfma_f32_32x32x16_bf16(sb[ks], GLA_FRAG(QBl, 32 * tb + r32, 16 * ks + 8 * hi), o, 0, 0, 0); }
        if (tb == 0) { g3_intra<0>(o, KFl, QFl, VT, 0, 0, db, r32, hi); g3_intra<1>(o, KBl, QBl, VT, 0, 0, db, r32, hi); g3_intra<1>(o, KBl, QBl, VT, 1, 0, db, r32, hi); }
        else         { g3_intra<0>(o, KFl, QFl, VT, 0, 1, db, r32, hi); g3_intra<0>(o, KFl, QFl, VT, 1, 1, db, r32, hi); g3_intra<1>(o, KBl, QBl, VT, 1, 1, db, r32, hi); }
        float ss = 0.f;
#pragma unroll
        for (int r = 0; r < 16; ++r) ss = fmaf(o[r], o[r], ss);
        { auto rr = __builtin_amdgcn_permlane32_swap(__float_as_uint(ss), __float_as_uint(ss), false, false); ss = __uint_as_float(rr[0]) + __uint_as_float(rr[1]); }
        if (hi == 0) SS[db * 64 + 32 * tb + r32] = ss;
        GLA_BAR();
        const int t = 32 * tb + r32;
        const float tot = (SS[t] + SS[64 + t]) + (SS[128 + t] + SS[192 + t]);
        const float rn = __builtin_amdgcn_rsqf(tot * (1.0f / 128.0f) + EPS);
        const size_t row = (size_t)rc * 64 + t;
#pragma unroll
        for (int g4 = 0; g4 < 4; ++g4) { const int dv0 = 32 * db + 8 * g4 + 4 * hi;
            const v2u gw = *(const v2u*)(P + row * DINP + C_GB + 128 * h + dv0); const f32x4 gn = *(const f32x4*)(gg + 128 * h + dv0);
            const float g0 = bflo(gw.x), g1 = bfhi(gw.x), g2 = bflo(gw.y), g3 = bfhi(gw.y);
            const float y0 = o[4 * g4 + 0] * rn * gn.x * (g0 * __builtin_amdgcn_rcpf(1.0f + __expf(-g0))), y1 = o[4 * g4 + 1] * rn * gn.y * (g1 * __builtin_amdgcn_rcpf(1.0f + __expf(-g1)));
            const float y2 = o[4 * g4 + 2] * rn * gn.z * (g2 * __builtin_amdgcn_rcpf(1.0f + __expf(-g2))), y3 = o[4 * g4 + 3] * rn * gn.w * (g3 * __builtin_amdgcn_rcpf(1.0f + __expf(-g3)));
            v2u w; w.x = pk2(y0, y1); w.y = pk2(y2, y3);
            *(v2u*)(MIX + row * D + 1024 + 128 * h + dv0) = w; }
    }
#undef G3_LOAD
    __syncthreads();
}
#undef GLA_PK4
#undef GLA_FRAG
#undef GLA_BAR
}

constexpr int N_PHASES = 54;
__host__ __device__ constexpr bool phase_active(int id) {
    if (id == 0 || id == N_PHASES - 1) return true;
    const int L = (id - 1) / 13, k = (id - 1) % 13; const bool even = (L & 1) == 0;
    if (k == 1 || k == 8) return !even;
    if (k >= 2 && k <= 7) return even;
    return true;
}

__global__ void __launch_bounds__(NWAVES * 64, 2) fwd_kernel(Args args) {
    extern __shared__ __attribute__((aligned(16))) unsigned char lds[];
    Frame F;
    F.lds = (LAS unsigned char*)lds; F.ldsg = lds;
    F.MISC = (volatile LAS unsigned*)(F.lds + MISC_OFF);
    F.tid = threadIdx.x; F.lane = F.tid & 63; F.wave = __builtin_amdgcn_readfirstlane(F.tid >> 6);
    F.G = gridDim.x; { const int bx = blockIdx.x; F.vcu = (F.G % 8 == 0) ? (bx % 8) * (F.G / 8) + bx / 8 : bx; }
    F.ka = (KArgs)__builtin_amdgcn_kernarg_segment_ptr(); F.ws = F.ka->ws;
    for (int u = F.tid; u < (LDS_BYTES - LDSCTL_OFF) / 4; u += NWAVES * 64) ((LAS unsigned*)(F.lds + LDSCTL_OFF))[u] = 0u;
    __syncthreads();
    unsigned* barw = (unsigned*)(F.ws + WS_CTL) + CW_BAR;
    XcdBarrier bar = xcd_barrier_post(barw, F.MISC + 8);
    const int lo = args.ph_lo, hi = args.ph_hi;
    bool started = false;
#ifndef PH_MASK
#define PH_MASK 0xFFFFFFFFu
#endif
#ifndef PH_REP
#define PH_REP 0u
#endif
#define PHASE_BEGIN(id, kind) if (((PH_MASK >> (kind)) & 1u) && lo <= (id) && (id) < hi) { if (started) xcd_barrier(bar); started = true; for (int _rep = 0; _rep < (((PH_REP >> (kind)) & 1u) ? 2 : 1); ++_rep) { \
    { int _t = threadIdx.x; asm volatile("" : "+v"(_t)); F.tid = _t; F.lane = _t & 63; F.wave = __builtin_amdgcn_readfirstlane(_t >> 6); KArgs _k = (KArgs)__builtin_amdgcn_kernarg_segment_ptr(); asm volatile("" : "+s"(_k)); F.ka = _k; F.ws = _k->ws; }
#define PHASE_END } }

    PHASE_BEGIN(0, 0) ph_prologue(F); PHASE_END

    const float* MOD = (const float*)(F.ws + WS_MOD);
    for (int L = 0; L < DEPTH; ++L) {
        const int base = 1 + 13 * L; const bool even = (L & 1) == 0; const int e = L >> 1;
        const float* modl = MOD + (size_t)L * 5 * MODW;
#define XRc ((const float*)(F.ws + WS_XR) + (size_t)MLAT * D)
        const int rows_mix_in = (L <= 2) ? MR : MLAT;
        const int rows_upd = (L <= 1) ? MR : MLAT;

        PHASE_BEGIN(base + 0, 1) {
            ph_norm(F, rows_mix_in, L == 0 ? (F.ka->in[I_X]) : (const float*)nullptr, L == 0 ? (F.ka->in[I_CTX]) : XRc, (F.ka->in[I_N1G]) + (size_t)L * D, modl, 0, D, 4);
            if (L == 0) {
                const f32x4* cs = (const f32x4*)(F.ka->in[I_CTX]); f32x4* xd = (f32x4*)(F.ws + WS_XR) + (size_t)MLAT * D / 4;
                for (int i = F.vcu * NWAVES * 64 + F.tid; i < MCTX * D / 4; i += F.G * NWAVES * 64) xd[i] = cs[i];
            }
        } PHASE_END
        if (!even) {
            PHASE_BEGIN(base + 1, 2) ph_pool(F, rows_upd); PHASE_END
        }
        if (even) {
            PHASE_BEGIN(base + 2, 3) {
                pg8::Gemm g{(const pg8::bf16_t*)(F.ws + WS_H), (const pg8::bf16_t*)(F.ws + WS_WIN) + (size_t)e * DINP * D, MR, DINP, D, D, D, 1, 0, 0};
                pg8::StaticOrder S; S.init(MR, DINP, D, 1, F.G, (int)blockIdx.x);
                pg8::EpiBf16 E{(pg8::bf16_t*)(F.ws + WS_P), DINP};
                pg8::gemm_phase<pg8::EpiBf16, pg8::StaticOrder, false>(F.lds + RING_OFF, g, S, E, F.tid);
            } PHASE_END
            PHASE_BEGIN(base + 3, 4) {
                gla::ph_prep(F, e);
                if (L == 0) {
                    const na::bf16* P = (const na::bf16*)(F.ws + WS_P); na::bf16* MIX = (na::bf16*)(F.ws + WS_MIX);
                    for (int q = blockIdx.x; q < 48; q += F.G) { const int uc = q - 16; if (uc < 0) continue; const int b = uc >> 3, h = uc & 7;
                        na::na_unit<DINP, D>(P, C_QA + 128 * h, C_KA + 128 * h, C_VA + 128 * h, (long)MLAT + b * CTXL, (long)MLAT + b * CTXL, 0, 0, 0, 0,
                                             MIX, 128 * h, (F.ka->in[I_RPB]), (char*)lds + RING_OFF, F.tid); }
                }
            } PHASE_END
            PHASE_BEGIN(base + 4, 5) {
                gla::ph_g1(F);
                const na::bf16* P = (const na::bf16*)(F.ws + WS_P); na::bf16* MIX = (na::bf16*)(F.ws + WS_MIX);
                for (int u = F.vcu; u < 512; u += F.G) { const int b = u >> 7, h = (u >> 4) & 7, i = u & 15;
                    const int klo = i == 0 ? 0 : (i == 15 ? 56 : 4 * i - 4), nband = (i == 0 || i == 15) ? 8 : 12;
                    na::na_unit<DINP, D>(P, C_QA + 128 * h, C_KA + 128 * h, C_VA + 128 * h, (long)b * SEQ + 256 * i, (long)MLAT + b * CTXL, (long)b * SEQ + 64 * klo, nband, klo, 4 * i,
                                         MIX, 128 * h, (F.ka->in[I_RPB]) + ((size_t)e * 8 + h) * 15 * 31, (char*)lds + RING_OFF, F.tid); }
            } PHASE_END
            PHASE_BEGIN(base + 5, 6) {
                gla::ph_g2(F);
            } PHASE_END
            PHASE_BEGIN(base + 6, 7) gla::ph_g3(F, e, L == 0 ? MR / 64 : MLAT / 64); PHASE_END
            PHASE_BEGIN(base + 7, 8) {
                const int M = rows_upd;
                pg8::Gemm g{(const pg8::bf16_t*)(F.ws + WS_MIX), (const pg8::bf16_t*)(F.ws + WS_WOUT) + (size_t)e * D * D, M, D, D, D, D, 1, 0, 0};
                pg8::SplitTailOrder S; S.init(MLAT, M - MLAT, D, D, 4, F.G, (int)blockIdx.x);
                pg8::EpiResid E{(float*)(F.ws + WS_PART), (pg8::bf16_t*)(F.ws + WS_X16), D, modl + 2 * D, MODW, nullptr, 0, MLAT, MCTX};
                pg8::gemm_phase<pg8::EpiResid, pg8::SplitTailOrder, true>(F.lds + RING_OFF, g, S, E, F.tid);
            } PHASE_END
        } else {
            PHASE_BEGIN(base + 8, 9) {
                const int M = rows_upd;
                pg8::Gemm g{(const pg8::bf16_t*)(F.ws + WS_MIX), (const pg8::bf16_t*)(F.ws + WS_WPOOL) + (size_t)e * 4 * 512 * 512, M, 512, 512, D, 512, 4, (size_t)512 * 2, (size_t)512 * 512 * 2};
                pg8::StaticOrder S; S.init(M, 512, 512, 4, F.G, (int)blockIdx.x);
                pg8::EpiResid E{(float*)(F.ws + WS_PART), (pg8::bf16_t*)(F.ws + WS_X16), D, modl + 2 * D, MODW, (F.ka->in[I_POOLS]) + (size_t)e * D, 512, MLAT, MCTX};
                pg8::gemm_phase<pg8::EpiResid, pg8::StaticOrder, true>(F.lds + RING_OFF, g, S, E, F.tid);
            } PHASE_END
        }
        PHASE_BEGIN(base + 9, 10) ph_norm(F, rows_upd, (const float*)nullptr, XRc, (F.ka->in[I_N2G]) + (size_t)L * D, modl, 3 * D, 4 * D, even ? 4 : 1); PHASE_END
        PHASE_BEGIN(base + 10, 11) {
            const int M = rows_upd;
            pg8::Gemm g{(const pg8::bf16_t*)(F.ws + WS_H), (const pg8::bf16_t*)(F.ws + WS_WUP) + (size_t)L * DUP * D, M, DUP, D, D, D, 1, 0, 0};
            pg8::StaticOrder S; S.init(M, DUP, D, 1, F.G, (int)blockIdx.x);
            pg8::EpiGlu E{(pg8::bf16_t*)(F.ws + WS_ACT), LDF, (F.ka->in[I_CONVW]) + (size_t)L * 3 * DFF, (F.ka->in[I_CONVB]) + (size_t)L * DFF, (float*)(F.ws + WS_SB), DFF, (PG8_LAS float*)(F.lds + RING_OFF + 131072)};
            pg8::gemm_phase<pg8::EpiGlu, pg8::StaticOrder, true>(F.lds + RING_OFF, g, S, E, F.tid);
        } PHASE_END
        PHASE_BEGIN(base + 11, 12) ph_glufix(F, rows_upd, (F.ka->in[I_CONVW]) + (size_t)L * 3 * DFF, (F.ka->in[I_CONVB]) + (size_t)L * DFF); PHASE_END
        PHASE_BEGIN(base + 12, 13) {
            const int M = rows_upd;
            pg8::Gemm g{(const pg8::bf16_t*)(F.ws + WS_ACT), (const pg8::bf16_t*)(F.ws + WS_WDOWN) + (size_t)L * D * LDF, M, D, DFF, LDF, LDF, 1, 0, 0};
            pg8::SplitTailOrder S; S.init(MLAT, M - MLAT, D, DFF, 4, F.G, (int)blockIdx.x);
            pg8::EpiResid E{(float*)(F.ws + WS_PART), (pg8::bf16_t*)(F.ws + WS_X16), D, modl + 5 * D, MODW, nullptr, 0, MLAT, MCTX};
            pg8::gemm_phase<pg8::EpiResid, pg8::SplitTailOrder, true>(F.lds + RING_OFF, g, S, E, F.tid);
        } PHASE_END
    }
#ifdef XTRA_BARRIERS
    for (int xb = 0; xb < XTRA_BARRIERS; ++xb) xcd_barrier(bar);
#endif
    PHASE_BEGIN(N_PHASES - 1, 14) ph_final(F); PHASE_END
#undef PHASE_BEGIN
#undef PHASE_END
#undef XRc
}

#ifndef MK_PER_PHASE
#define MK_PER_PHASE 0
#endif
extern "C" void kernel_launch(void* const* d_in, const int* in_sizes, int n_in, void* d_out, int out_size, void* d_ws, size_t ws_size, hipStream_t stream) {
    static int grid = 0;
    if (grid == 0) {
        if (n_in != 21 || in_sizes[0] != MLAT * D || out_size != MLAT * D || ws_size < WS_END) {
            fprintf(stderr, "kernel_launch: shape mismatch: n_in %d in0 %d out %d ws %zu (need %zu); nothing launched\n", n_in, n_in > 0 ? in_sizes[0] : -1, out_size, ws_size, (size_t)WS_END); grid = -1; return; }
        int dev = 0, cus = 0, per_cu = 0;
        if (hipGetDevice(&dev) != hipSuccess || hipDeviceGetAttribute(&cus, hipDeviceAttributeMultiprocessorCount, dev) != hipSuccess) { fprintf(stderr, "kernel_launch: device query failed\n"); grid = -1; return; }
        if (hipFuncSetAttribute((const void*)fwd_kernel, hipFuncAttributeMaxDynamicSharedMemorySize, LDS_BYTES) != hipSuccess) { fprintf(stderr, "kernel_launch: hipFuncSetAttribute failed\n"); grid = -1; return; }
        if (hipOccupancyMaxActiveBlocksPerMultiprocessor(&per_cu, (const void*)fwd_kernel, NWAVES * 64, LDS_BYTES) != hipSuccess || per_cu < 1) {
            fprintf(stderr, "kernel_launch: occupancy query reports %d workgroups per CU\n", per_cu); }
        (void)hipGetLastError();
        grid = cus;
    }
    if (grid < 0) return;
    if (hipMemsetAsync((char*)d_ws + WS_CTL, 0, CTL_ZERO_BYTES, stream) != hipSuccess) { fprintf(stderr, "kernel_launch: memset failed\n"); return; }
    Args a{};
    for (int i = 0; i < 21; ++i) a.in[i] = (const float*)d_in[i];
    a.out = (float*)d_out; a.ws = (unsigned char*)d_ws;
#if MK_PER_PHASE
    for (int p = 0; p < N_PHASES; ++p) { if (!phase_active(p)) continue; a.ph_lo = p; a.ph_hi = p + 1;
        hipLaunchKernelGGL(fwd_kernel, dim3(grid), dim3(NWAVES * 64), LDS_BYTES, stream, a); }
#else
    a.ph_lo = 0; a.ph_hi = N_PHASES;
    hipLaunchKernelGGL(fwd_kernel, dim3(grid), dim3(NWAVES * 64), LDS_BYTES, stream, a);
#endif
    const hipError_t le = hipPeekAtLastError();
    if (le != hipSuccess) fprintf(stderr, "kernel_launch: launch failed: %s\n", hipGetErrorName(le));
}
```

```cpp
#include <hip/hip_runtime.h>
#include <cstdio>
#include <cstdint>

namespace pg8 {
#define PG8_LAS __attribute__((address_space(3)))
typedef unsigned short bf16_t;
typedef short bf16x8 __attribute__((ext_vector_type(8)));
typedef float f32x4 __attribute__((ext_vector_type(4)));
typedef float f32x2 __attribute__((ext_vector_type(2)));
typedef unsigned u32x4 __attribute__((ext_vector_type(4)));
constexpr int BM = 256, BK = 64, HALF = 128, HTB = HALF * BK * 2  , STAGE_BYTES = 8 * HTB, NXCD = 8;

__host__ __device__ __forceinline__ int lds_byte(int r, int c) { const int st = (r >> 4) * 2 + (c >> 5), rr = r & 15, cc = c & 31, ob = rr * 64 + cc * 2; return st * 1024 + (ob ^ (((ob >> 9) & 1) << 5)); }
__host__ __device__ __forceinline__ void stage_rc(int b, int& R, int& C) { const int st = b / 1024, sb = b % 1024, swz = sb ^ (((sb >> 9) & 1) << 5); R = (st >> 1) * 16 + swz / 64; C = (st & 1) * 32 + (swz % 64) / 2; }
__host__ __device__ __forceinline__ int perm32(int rho) { const int n = rho >> 4, i = rho & 15; return 8 * (i >> 2) + 4 * n + (i & 3); }

struct Unit { int pm, pn, grp, kt0, nkt, atomic; };
struct Gemm { const bf16_t* A; const bf16_t* Bt; int M, N, K, lda, ldb, ngrp; size_t gsA, gsB; };

struct StaticOrder {
    int nM, nN, nNr, nwg, G, c, nktK, WGM = 4;
    __host__ __device__ void init(int M, int N, int K, int ngrp, int G_, int c_) { nM = M / BM; nNr = N / BM; nN = nNr * ngrp; nwg = nM * nN; G = G_; c = c_; nktK = K / BK; }
    __host__ __device__ bool next(int i, Unit& u) const {
        const long L = (long)i * G + c; if (L >= nwg) return false;
        int wgid = (int)L; { const int q = nwg / NXCD, r = nwg % NXCD, xcd = wgid % NXCD, off = wgid / NXCD; wgid = (xcd < r ? xcd * (q + 1) : r * (q + 1) + (xcd - r) * q) + off; }
        int nig = WGM * nN, nr = nNr;
#if defined(__HIP_DEVICE_COMPILE__)
        asm volatile("" : "+s"(nig), "+s"(nr));
#endif
        const int gid = wgid / nig, fm = gid * WGM, gsz = (nM - fm) < WGM ? (nM - fm) : WGM;
        u.pm = fm + ((wgid % nig) % gsz); const int vn = (wgid % nig) / gsz; u.pn = vn % nr; u.grp = vn / nr; u.kt0 = 0; u.nkt = nktK; u.atomic = 0; return true;
    }
    __device__ __forceinline__ void a_ready(const Unit&) const {}
    __device__ __forceinline__ void done(const Unit&) const {}
};
struct SplitTailOrder {
    StaticOrder main; int nA, nB, nNr, SK, nks, pmB, G, c;
    __host__ __device__ void init(int MA, int MB, int N, int K, int SK_, int G_, int c_) { main.init(MA, N, K, 1, G_, c_); nA = main.nwg; nNr = N / BM; SK = SK_; nks = (K / BK) / SK_; pmB = MA / BM; nB = (MB / BM) * nNr * SK_; G = G_; c = c_; }
    __host__ __device__ bool next(int i, Unit& u) const {
        const long L = (long)i * G + c;
        if (L < nA) return main.next(i, u);
        const int Lb = (int)(L - nA); if (Lb >= nB) return false;
        const int ks = Lb % SK, tile = Lb / SK; u.pn = tile % nNr; u.pm = pmB + tile / nNr; u.grp = 0; u.kt0 = ks * nks; u.nkt = nks; u.atomic = 1 + ks; return true;
    }
    __device__ __forceinline__ void a_ready(const Unit&) const {}
    __device__ __forceinline__ void done(const Unit&) const {}
};

__device__ __forceinline__ unsigned cvt_pk_bf16(float lo, float hi) { unsigned r; asm volatile("v_cvt_pk_bf16_f32 %0, %1, %2" : "=v"(r) : "v"(lo), "v"(hi)); return r; }
typedef float cf32x2 __attribute__((ext_vector_type(2)));
typedef __bf16 cbf16x2 __attribute__((ext_vector_type(2)));
__device__ __forceinline__ unsigned pkc(float lo, float hi) { return __builtin_bit_cast(unsigned, __builtin_convertvector((cf32x2){lo, hi}, cbf16x2)); }
__device__ __forceinline__ unsigned f2bfc(float f) { return pkc(f, f) & 0xffffu; }
typedef _Float16 f16x2 __attribute__((ext_vector_type(2)));
__device__ __forceinline__ unsigned pk_h2(float lo, float hi) { f16x2 p; p.x = (_Float16)__builtin_amdgcn_fmed3f(lo, -65504.0f, 65504.0f); p.y = (_Float16)__builtin_amdgcn_fmed3f(hi, -65504.0f, 65504.0f); return __builtin_bit_cast(unsigned, p); }
__device__ __forceinline__ float h_lo(unsigned w) { return (float)__builtin_bit_cast(f16x2, w).x; }
__device__ __forceinline__ float h_hi(unsigned w) { return (float)__builtin_bit_cast(f16x2, w).y; }
template <unsigned BITS> __device__ __forceinline__ float kc() { float r; asm volatile("s_mov_b32 %0, %1" : "=s"(r) : "n"(BITS)); return r; }
__device__ __forceinline__ void gelu4(const f32x2 (&v)[4], f32x2 (&o)[4]) {
    f32x2 c[4], w[4], q[4];
#pragma unroll
    for (int p = 0; p < 4; ++p) { c[p].x = __builtin_amdgcn_fmed3f(v[p].x, -5.0f, 5.0f); c[p].y = __builtin_amdgcn_fmed3f(v[p].y, -5.0f, 5.0f); w[p] = (c[p] * c[p]) * 0.08f + (-1.0f); }
    { const float ka = kc<0x3a40c646u>(), kb = kc<0xbadbc5c1u>();
#pragma unroll
      for (int p = 0; p < 4; ++p) q[p] = w[p] * ka + kb; }
    { const float kk = kc<0x3ab42bcbu>();
#pragma unroll
      for (int p = 0; p < 4; ++p) q[p] = q[p] * w[p] + kk; }
    { const float kk = kc<0xbb259aa1u>();
#pragma unroll
      for (int p = 0; p < 4; ++p) q[p] = q[p] * w[p] + kk; }
    { const float kk = kc<0x3bddb9bfu>();
#pragma unroll
      for (int p = 0; p < 4; ++p) q[p] = q[p] * w[p] + kk; }
    { const float kk = kc<0xbc394185u>();
#pragma unroll
      for (int p = 0; p < 4; ++p) q[p] = q[p] * w[p] + kk; }
    { const float kk = kc<0x3c85018cu>();
#pragma unroll
      for (int p = 0; p < 4; ++p) q[p] = q[p] * w[p] + kk; }
    { const float kk = kc<0xbcbe2975u>();
#pragma unroll
      for (int p = 0; p < 4; ++p) q[p] = q[p] * w[p] + kk; }
    { const float kk = kc<0x3d00edc6u>();
#pragma unroll
      for (int p = 0; p < 4; ++p) q[p] = q[p] * w[p] + kk; }
    { const float kk = kc<0xbd25b03eu>();
#pragma unroll
      for (int p = 0; p < 4; ++p) q[p] = q[p] * w[p] + kk; }
    { const float kk = kc<0x3d530477u>();
#pragma unroll
      for (int p = 0; p < 4; ++p) q[p] = q[p] * w[p] + kk; }
    { const float kk = kc<0xbd8ff74du>();
#pragma unroll
      for (int p = 0; p < 4; ++p) q[p] = q[p] * w[p] + kk; }
    { const float kk = kc<0x3e10c1adu>();
#pragma unroll
      for (int p = 0; p < 4; ++p) q[p] = q[p] * w[p] + kk; }
#pragma unroll
    for (int p = 0; p < 4; ++p) o[p] = v[p] * (q[p] * c[p] + 0.5f);
}

__device__ __forceinline__ f32x2 gelu_pk(f32x2 v) {
    f32x2 c; c.x = __builtin_amdgcn_fmed3f(v.x, -5.0f, 5.0f); c.y = __builtin_amdgcn_fmed3f(v.y, -5.0f, 5.0f);
    const f32x2 w = (c * c) * 0.08f + (-1.0f);
    f32x2 q = w * 7.353763795e-04f + (-1.676730928e-03f);
    q = q * w + 1.374596148e-03f; q = q * w + (-2.526916796e-03f); q = q * w + 6.766527425e-03f; q = q * w + (-1.130712498e-02f); q = q * w + 1.623608917e-02f;
    q = q * w + (-2.321312763e-02f); q = q * w + 3.147675842e-02f; q = q * w + (-4.045128077e-02f); q = q * w + 5.151792988e-02f; q = q * w + (-7.029590756e-02f); q = q * w + 1.413638145e-01f;
    return v * (q * c + 0.5f);
}

struct EpiBf16 {
    static constexpr bool PERM = true;
    bf16_t* O; int ldc;
    __device__ __forceinline__ void operator()(const f32x4 (&acc)[2][2][4][2], const Unit& u, int wr, int wc, int fr, int fq) const {
        const int row0 = u.pm * BM + wr * 64 + fr; const int col0 = u.pn * BM + wc * 32 + 8 * fq;
#pragma unroll
        for (int ai = 0; ai < 2; ++ai)
#pragma unroll
            for (int m = 0; m < 4; ++m) { bf16_t* rowp = O + (size_t)(row0 + ai * HALF + m * 16) * ldc + col0;
#pragma unroll
                for (int bj = 0; bj < 2; ++bj) { const f32x4 v0 = acc[ai][bj][m][0], v1 = acc[ai][bj][m][1];
                    u32x4 w; w.x = cvt_pk_bf16(v0[0], v0[1]); w.y = cvt_pk_bf16(v0[2], v0[3]); w.z = cvt_pk_bf16(v1[0], v1[1]); w.w = cvt_pk_bf16(v1[2], v1[3]);
                    *(u32x4*)(rowp + bj * HALF) = w; } }
    }
};
struct EpiGlu {
    static constexpr bool PERM = true;
    bf16_t* ACT; int ldc; const float* cw; const float* cb; float* SB; int dff; PG8_LAS float* XB;
    static __device__ __forceinline__ float ror1(float v)  { return __builtin_bit_cast(float, __builtin_amdgcn_update_dpp(0, __builtin_bit_cast(int, v), 0x121, 0xf, 0xf, true)); }
    static __device__ __forceinline__ float ror15(float v) { return __builtin_bit_cast(float, __builtin_amdgcn_update_dpp(0, __builtin_bit_cast(int, v), 0x12f, 0xf, 0xf, true)); }
    __device__ __forceinline__ void operator()(const f32x4 (&acc)[2][2][4][2], const Unit& u, int wr, int wc, int fr, int fq) const {
        const int ch0 = u.pn * HALF + wc * 32 + 8 * fq; const bool l0 = (fr == 0), l15 = (fr == 15);
        PG8_LAS float* xme = XB + ((wr * 4 + wc) * 4) * 32 + fq * 8;
#pragma unroll
        for (int ai = 0; ai < 2; ++ai) {
            if (fr == 0)  { *(PG8_LAS f32x4*)(xme + (ai * 2 + 0) * 32) = acc[ai][1][0][0]; *(PG8_LAS f32x4*)(xme + (ai * 2 + 0) * 32 + 4) = acc[ai][1][0][1]; }
            if (fr == 15) { *(PG8_LAS f32x4*)(xme + (ai * 2 + 1) * 32) = acc[ai][1][3][0]; *(PG8_LAS f32x4*)(xme + (ai * 2 + 1) * 32 + 4) = acc[ai][1][3][1]; }
        }
        asm volatile("s_waitcnt lgkmcnt(0)" ::: "memory"); __builtin_amdgcn_s_barrier(); asm volatile("" ::: "memory");
        f32x4 w0[2], w1[2], w2[2], bb[2];
#pragma unroll
        for (int n = 0; n < 2; ++n) { w0[n] = *(const f32x4*)(cw + ch0 + 4 * n); w1[n] = *(const f32x4*)(cw + dff + ch0 + 4 * n); w2[n] = *(const f32x4*)(cw + 2 * dff + ch0 + 4 * n); bb[n] = *(const f32x4*)(cb + ch0 + 4 * n); }
#pragma unroll
        for (int ai = 0; ai < 2; ++ai) {
            const int rp = 128 * ai + 64 * wr - 1, rn = 128 * ai + 64 * wr + 64;
            f32x4 xp[2], xn[2];
#pragma unroll
            for (int n = 0; n < 2; ++n) { xp[n] = (f32x4){0.f, 0.f, 0.f, 0.f}; xn[n] = (f32x4){0.f, 0.f, 0.f, 0.f}; }
            if (rp >= 0)  { const PG8_LAS float* s = XB + ((((rp >> 6) & 1) * 4 + wc) * 4 + (rp >> 7) * 2 + 1) * 32 + fq * 8; xp[0] = *(const PG8_LAS f32x4*)s; xp[1] = *(const PG8_LAS f32x4*)(s + 4); }
            if (rn < 256) { const PG8_LAS float* s = XB + ((((rn >> 6) & 1) * 4 + wc) * 4 + (rn >> 7) * 2 + 0) * 32 + fq * 8; xn[0] = *(const PG8_LAS f32x4*)s; xn[1] = *(const PG8_LAS f32x4*)(s + 4); }
#pragma unroll
            for (int m = 0; m < 4; ++m) {
                const int row = u.pm * BM + ai * HALF + wr * 64 + m * 16 + fr;
                u32x4 ow; float cv[8];
#pragma unroll
                for (int n = 0; n < 2; ++n)
#pragma unroll
                    for (int j = 0; j < 4; ++j) {
                        const float g = acc[ai][1][m][n][j];
                        const float tp = l15 ? ((m > 0) ? acc[ai][1][m > 0 ? m - 1 : 0][n][j] : xp[n][j]) : g;
                        const float tn = l0  ? ((m < 3) ? acc[ai][1][m < 3 ? m + 1 : 3][n][j] : xn[n][j]) : g;
                        const float gp = ror1(tp), gn = ror15(tn);
                        cv[4 * n + j] = fmaf(w0[n][j], gp, fmaf(w1[n][j], g, fmaf(w2[n][j], gn, bb[n][j])));
                    }
                const int tr = ai * HALF + wr * 64 + m * 16 + fr;
                if (tr == 0 || tr == 255) { float* sb = SB + ((size_t)(u.pm * 2 + (tr ? 1 : 0)) * 3) * dff + ch0;
#pragma unroll
                    for (int n = 0; n < 2; ++n) { *(f32x4*)(sb + 4 * n) = (f32x4){cv[4 * n], cv[4 * n + 1], cv[4 * n + 2], cv[4 * n + 3]}; *(f32x4*)(sb + dff + 4 * n) = acc[ai][0][m][n]; *(f32x4*)(sb + 2 * dff + 4 * n) = acc[ai][1][m][n]; } }
                f32x2 gv[4], go[4]; float a[8];
#pragma unroll
                for (int p = 0; p < 4; ++p) gv[p] = (f32x2){cv[2 * p], cv[2 * p + 1]};
                gelu4(gv, go);
#pragma unroll
                for (int e = 0; e < 8; e += 2) { a[e] = go[e >> 1].x * acc[ai][0][m][e >> 2][e & 3]; a[e + 1] = go[e >> 1].y * acc[ai][0][m][(e + 1) >> 2][(e + 1) & 3]; }
                ow.x = cvt_pk_bf16(a[0], a[1]); ow.y = cvt_pk_bf16(a[2], a[3]); ow.z = cvt_pk_bf16(a[4], a[5]); ow.w = cvt_pk_bf16(a[6], a[7]);
                *(u32x4*)(ACT + (size_t)row * ldc + ch0) = ow;
            }
        }
    }
};
struct EpiResid {
    static constexpr bool PERM = true;
    float* PART; bf16_t* X16; int ldx; const float* gate; int gstride; const float* cscale; int gcols; int mlat; int mctx;
    __device__ __forceinline__ void operator()(const f32x4 (&acc)[2][2][4][2], const Unit& u, int wr, int wc, int fr_, int fq_) const {
        int fr = fr_, fq = fq_; asm volatile("" : "+v"(fr), "+v"(fq));
        const int row0 = u.pm * BM + wr * 64 + fr, col0 = u.grp * gcols + u.pn * BM + wc * 32 + 8 * fq;
        const int rowt = u.pm * BM; const int bidx = rowt < mlat ? (rowt >> 12) : 4;
        const float* gp = gate + (size_t)bidx * gstride + col0;
        f32x4 gv[2][2];
#pragma unroll
        for (int bj = 0; bj < 2; ++bj)
#pragma unroll
            for (int n = 0; n < 2; ++n) { gv[bj][n] = *(const f32x4*)(gp + bj * HALF + n * 4); if (cscale) gv[bj][n] = gv[bj][n] * *(const f32x4*)(cscale + col0 + bj * HALF + n * 4); }
        if (rowt >= mlat) {
            float* base = PART + ((size_t)(u.atomic ? u.atomic - 1 : 0) * mctx + (size_t)(row0 - mlat)) * ldx + col0;
            f32x4 gc[2][2] = {{gv[0][0], gv[0][1]}, {gv[1][0], gv[1][1]}}; asm volatile("" : "+v"(gc[0][0]), "+v"(gc[0][1]), "+v"(gc[1][0]), "+v"(gc[1][1]));
#pragma unroll
            for (int ai = 0; ai < 2; ++ai)
#pragma unroll
                for (int m = 0; m < 4; ++m) { float* rowp = base + (size_t)(ai * HALF + m * 16) * ldx;
#pragma unroll
                    for (int bj = 0; bj < 2; ++bj)
#pragma unroll
                        for (int n = 0; n < 2; ++n) *(f32x4*)(rowp + bj * HALF + n * 4) = acc[ai][bj][m][n] * gc[bj][n]; }
        } else {
            u32x4 xin[2][4][2];
#pragma unroll
            for (int ai = 0; ai < 2; ++ai)
#pragma unroll
                for (int m = 0; m < 4; ++m)
#pragma unroll
                    for (int bj = 0; bj < 2; ++bj) xin[ai][m][bj] = *(const u32x4*)(X16 + (size_t)(row0 + ai * HALF + m * 16) * ldx + col0 + bj * HALF);
            asm volatile("" ::: "memory");
#pragma unroll
            for (int ai = 0; ai < 2; ++ai)
#pragma unroll
                for (int m = 0; m < 4; ++m)
#pragma unroll
                    for (int bj = 0; bj < 2; ++bj) { const u32x4 h = xin[ai][m][bj]; const f32x4 a0 = acc[ai][bj][m][0] * gv[bj][0], a1 = acc[ai][bj][m][1] * gv[bj][1];
                        u32x4 w;
                        w.x = pk_h2(h_lo(h.x) + a0[0], h_hi(h.x) + a0[1]); w.y = pk_h2(h_lo(h.y) + a0[2], h_hi(h.y) + a0[3]);
                        w.z = pk_h2(h_lo(h.z) + a1[0], h_hi(h.z) + a1[1]); w.w = pk_h2(h_lo(h.w) + a1[2], h_hi(h.w) + a1[3]);
                        *(u32x4*)(X16 + (size_t)(row0 + ai * HALF + m * 16) * ldx + col0 + bj * HALF) = w; }
        }
    }
};

template <class Epi, class Sched, bool ALIGN_EPI = true>
__device__ __forceinline__ void gemm_phase(PG8_LAS unsigned char* lds, const Gemm g, const Sched& S, const Epi& E, const int tid) {
    const int wid = __builtin_amdgcn_readfirstlane(tid >> 6), lane = tid & 63, wr = wid >> 2, wc = wid & 3, fr = lane & 15, fq = lane >> 4;
    unsigned voffA[2], voffB[2];
#pragma unroll
    for (int i = 0; i < 2; ++i) { int R, C; stage_rc(tid * 16 + i * 8192, R, C); const int Rb = Epi::PERM ? ((R & ~31) + perm32(R & 31)) : R;
        voffA[i] = (unsigned)(R * g.lda + C) * 2u; voffB[i] = (unsigned)(Rb * g.ldb + C) * 2u; }
    const size_t kstep = (size_t)(BK * 2);
    const size_t hstepA = (size_t)HALF * g.lda * 2, hstepB = (size_t)HALF * g.ldb * 2;
    const size_t tstepA = 2 * hstepA, tstepB = 2 * hstepB;
    const unsigned ldsw = (unsigned)wid * 1024u;
    const int aoff = lds_byte(wr * 64 + fr, fq * 8), boff = lds_byte(wc * 32 + fr, fq * 8);
#define PG8_SA(b, h) (((b) * 2 + (h)) * HTB)
#define PG8_SB(b, h) ((4 + (b) * 2 + (h)) * HTB)
#define PG8_STAGE(bufoff, gbase, voff) do { _Pragma("unroll") for (int _i = 0; _i < 2; ++_i) \
        __builtin_amdgcn_global_load_lds((const unsigned*)((const char*)(gbase) + (voff)[_i]), (PG8_LAS unsigned*)(lds + (bufoff) + ldsw + _i * 8192), 16, 0, 0); } while (0)
#define PG8_LDA(dst, b, h) do { _Pragma("unroll") for (int m = 0; m < 4; ++m) _Pragma("unroll") for (int k = 0; k < 2; ++k) dst[m][k] = *(const PG8_LAS bf16x8*)(lds + PG8_SA(b, h) + aoff + m * 2048 + k * 1024); } while (0)
#define PG8_LDB(dst, b, h) do { _Pragma("unroll") for (int n = 0; n < 2; ++n) _Pragma("unroll") for (int k = 0; k < 2; ++k) dst[n][k] = *(const PG8_LAS bf16x8*)(lds + PG8_SB(b, h) + boff + n * 2048 + k * 1024); } while (0)
#define PG8_MMA(ai, bj, At, Bt) do { __builtin_amdgcn_s_setprio(1); _Pragma("unroll") for (int m = 0; m < 4; ++m) _Pragma("unroll") for (int n = 0; n < 2; ++n) _Pragma("unroll") for (int k = 0; k < 2; ++k) \
        acc[ai][bj][m][n] = __builtin_amdgcn_mfma_f32_16x16x32_bf16(Bt[n][k], At[m][k], acc[ai][bj][m][n], 0, 0, 0); __builtin_amdgcn_s_setprio(0); } while (0)
#define PG8_WAIT_V(n) asm volatile("s_waitcnt vmcnt(" #n ")" ::: "memory")
#define PG8_WAIT_L(n) asm volatile("s_waitcnt lgkmcnt(" #n ")" ::: "memory")
#define PG8_BAR __builtin_amdgcn_s_barrier()
#define PG8_SCHED __builtin_amdgcn_sched_barrier(0)
    Unit cur, nxt; int ui = 0;
    if (!S.next(0, cur)) return;
    f32x4 acc[2][2][4][2];
#pragma unroll
    for (int a = 0; a < 2; ++a)
#pragma unroll
        for (int b = 0; b < 2; ++b)
#pragma unroll
            for (int m = 0; m < 4; ++m)
#pragma unroll
                for (int n = 0; n < 2; ++n) acc[a][b][m][n] = (f32x4){0.f, 0.f, 0.f, 0.f};
    bf16x8 At[4][2], B0[2][2], B1[2][2];
    const char* cA = (const char*)g.A + (size_t)cur.pm * tstepA + (size_t)cur.grp * g.gsA + (size_t)cur.kt0 * kstep; const char* cB = (const char*)g.Bt + (size_t)cur.pn * tstepB + (size_t)cur.grp * g.gsB + (size_t)cur.kt0 * kstep;
    S.a_ready(cur);
    PG8_STAGE(PG8_SB(0, 0), cB, voffB); PG8_STAGE(PG8_SB(0, 1), cB + hstepB, voffB); PG8_STAGE(PG8_SA(0, 0), cA, voffA); PG8_STAGE(PG8_SA(0, 1), cA + hstepA, voffA);
    if (wr == 1) PG8_BAR;
    PG8_WAIT_V(2); PG8_BAR;
    PG8_STAGE(PG8_SB(1, 0), cB + kstep, voffB); PG8_STAGE(PG8_SA(1, 0), cA + kstep, voffA); PG8_STAGE(PG8_SB(1, 1), cB + hstepB + kstep, voffB);
    PG8_WAIT_V(6); PG8_BAR;
    for (;;) {
        const bool has_next = S.next(ui + 1, nxt);
        const char* nA = has_next ? (const char*)g.A + (size_t)nxt.pm * tstepA + (size_t)nxt.grp * g.gsA + (size_t)nxt.kt0 * kstep : cA;
        const char* nB = has_next ? (const char*)g.Bt + (size_t)nxt.pn * tstepB + (size_t)nxt.grp * g.gsB + (size_t)nxt.kt0 * kstep : cB;
        const int nt = cur.nkt;
        for (int t = 0; t < nt; t += 2) {
            const bool last = (t == nt - 2);
            const char* a1 = cA + (size_t)(t + 1) * kstep;
            const char* a2 = last ? nA : cA + (size_t)(t + 2) * kstep; const char* b2 = last ? nB : cB + (size_t)(t + 2) * kstep;
            const char* a3 = a2 + kstep; const char* b3 = b2 + kstep;
            if (last && has_next) S.a_ready(nxt);
            PG8_LDB(B0, 0, 0); PG8_LDB(B1, 0, 1); PG8_SCHED; PG8_LDA(At, 0, 0); PG8_STAGE(PG8_SA(1, 1), a1 + hstepA, voffA);
            PG8_WAIT_V(8); PG8_WAIT_L(0); PG8_BAR; PG8_MMA(0, 0, At, B0); PG8_MMA(0, 1, At, B1); PG8_BAR; PG8_SCHED;
            PG8_LDA(At, 0, 1); PG8_STAGE(PG8_SB(0, 0), b2, voffB); PG8_STAGE(PG8_SB(0, 1), b2 + hstepB, voffB); PG8_STAGE(PG8_SA(0, 0), a2, voffA);
            PG8_WAIT_V(8); PG8_WAIT_L(0); PG8_BAR; PG8_MMA(1, 0, At, B0); PG8_MMA(1, 1, At, B1); PG8_BAR; PG8_SCHED;
            PG8_LDB(B0, 1, 0); PG8_LDB(B1, 1, 1); PG8_SCHED; PG8_LDA(At, 1, 0); PG8_STAGE(PG8_SA(0, 1), a2 + hstepA, voffA);
            PG8_WAIT_V(8); PG8_WAIT_L(0); PG8_BAR; PG8_MMA(0, 0, At, B0); PG8_MMA(0, 1, At, B1); PG8_BAR; PG8_SCHED;
            PG8_LDA(At, 1, 1); PG8_STAGE(PG8_SB(1, 0), b3, voffB); PG8_STAGE(PG8_SB(1, 1), b3 + hstepB, voffB); PG8_STAGE(PG8_SA(1, 0), a3, voffA);
            PG8_WAIT_V(8); PG8_WAIT_L(0); PG8_BAR; PG8_MMA(1, 0, At, B0); PG8_MMA(1, 1, At, B1); PG8_BAR; PG8_SCHED;
        }
        if constexpr (ALIGN_EPI) { if (wr == 0) PG8_BAR; }
        E(acc, cur, wr, wc, fr, fq); S.done(cur);
        if (!has_next) break;
#pragma unroll
        for (int a = 0; a < 2; ++a)
#pragma unroll
            for (int b = 0; b < 2; ++b)
#pragma unroll
                for (int m = 0; m < 4; ++m)
#pragma unroll
                    for (int n = 0; n < 2; ++n) acc[a][b][m][n] = (f32x4){0.f, 0.f, 0.f, 0.f};
        cur = nxt; cA = nA; cB = nB; ++ui;
        if constexpr (ALIGN_EPI) { if (wr == 1) PG8_BAR; }
    }
    PG8_WAIT_V(0);
    if constexpr (!ALIGN_EPI) { if (wr == 0) PG8_BAR; }
    PG8_BAR;
#undef PG8_SA
#undef PG8_SB
#undef PG8_STAGE
#undef PG8_LDA
#undef PG8_LDB
#undef PG8_MMA
#undef PG8_WAIT_V
#undef PG8_WAIT_L
#undef PG8_BAR
#undef PG8_SCHED
}
}

namespace na {
typedef unsigned short bf16;
using bf16x8 = __attribute__((ext_vector_type(8))) short;
using s16x4  = __attribute__((ext_vector_type(4))) short;
using f32x16 = __attribute__((ext_vector_type(16))) float;
using u32x4  = __attribute__((ext_vector_type(4))) unsigned;
constexpr int   D = 128, NW = 8, QBLK = 32, KVBLK = 64;
constexpr float SCALE = 0.088388347648318440f;
constexpr float THR = 8.f;
constexpr float NEG = -1.0e30f;
constexpr size_t SHM_V = KVBLK * D * 2, SHM_K = KVBLK * D * 2, SHM_ATTN = 2 * SHM_V + 2 * SHM_K + NW * 64 * 4;
constexpr size_t BIAS_OFF = 69632;
constexpr size_t PEN_OFF = BIAS_OFF + 640 * 4;
constexpr size_t QS_OFF = 73728;
constexpr size_t LDS_END = QS_OFF + NW * 8192;
#define NA_KSWZ(row, colB) ((row) * 256 + ((colB) ^ (((row) & 7) << 4)))
#define NA_SBAR() __builtin_amdgcn_sched_barrier(0)
__device__ __forceinline__ int crow(int r, int hi) { return (r & 3) + 8 * (r >> 2) + 4 * hi; }
__device__ __forceinline__ unsigned cvtpk(float lo, float hi) { unsigned r; asm volatile("v_cvt_pk_bf16_f32 %0, %1, %2" : "=v"(r) : "v"(lo), "v"(hi)); return r; }

__device__ __forceinline__ void partialSM(f32x16& p0, f32x16& p1, float& m_reg, float& mn, float& alpha) {
  constexpr float C = SCALE * 1.4426950408889634f;
  float pmax = p0[0];
#pragma unroll
  for (int r = 1; r < 16; ++r) pmax = fmaxf(pmax, p0[r]);
#pragma unroll
  for (int r = 0; r < 16; ++r) pmax = fmaxf(pmax, p1[r]);
  { auto rr = __builtin_amdgcn_permlane32_swap(__float_as_uint(pmax), __float_as_uint(pmax), false, false);
    pmax = fmaxf(__uint_as_float(rr[0]), __uint_as_float(rr[1])); }
  if (__builtin_expect(__all(pmax - m_reg <= THR / SCALE), 1)) { mn = m_reg; alpha = 1.f; }
  else { mn = fmaxf(m_reg, pmax); alpha = __builtin_amdgcn_exp2f((m_reg - mn) * C); m_reg = mn; }
  float mnC = -mn * C;
#pragma unroll
  for (int r = 0; r < 16; ++r) p0[r] = fmaf(p0[r], C, mnC);
#pragma unroll
  for (int r = 0; r < 16; ++r) p1[r] = fmaf(p1[r], C, mnC);
#pragma unroll
  for (int r = 0; r < 16; ++r) p0[r] = __builtin_amdgcn_exp2f(p0[r]);
}
__device__ __forceinline__ void finishSM(f32x16& p0, f32x16& p1, float alpha, float& l_reg, bf16x8& pa0, bf16x8& pa1, bf16x8& pa2, bf16x8& pa3) {
#pragma unroll
  for (int r = 0; r < 16; ++r) p1[r] = __builtin_amdgcn_exp2f(p1[r]);
  float ps = 0;
#pragma unroll
  for (int r = 0; r < 16; ++r) ps += p0[r];
#pragma unroll
  for (int r = 0; r < 16; ++r) ps += p1[r];
  { auto rr = __builtin_amdgcn_permlane32_swap(__float_as_uint(ps), __float_as_uint(ps), false, false);
    ps = __uint_as_float(rr[0]) + __uint_as_float(rr[1]); }
  l_reg = l_reg * alpha + ps;
#define NA_PK4(P, BASE, OUT) do { unsigned a0 = cvtpk(P[BASE + 0], P[BASE + 1]), a1 = cvtpk(P[BASE + 2], P[BASE + 3]);   \
    unsigned b0 = cvtpk(P[BASE + 4], P[BASE + 5]), b1 = cvtpk(P[BASE + 6], P[BASE + 7]);                              \
    auto r0 = __builtin_amdgcn_permlane32_swap(a0, b0, false, false); auto r1 = __builtin_amdgcn_permlane32_swap(a1, b1, false, false); \
    u32x4 w = {r0[0], r1[0], r0[1], r1[1]}; OUT = *reinterpret_cast<bf16x8*>(&w); } while (0)
  NA_PK4(p0, 0, pa0); NA_PK4(p0, 8, pa1); NA_PK4(p1, 0, pa2); NA_PK4(p1, 8, pa3);
#undef NA_PK4
}
__device__ __forceinline__ void qkt(f32x16& p0, f32x16& p1, const bf16* Ks, const bf16x8* qs, int r32, int hi) {
#pragma unroll
  for (int d0 = 0; d0 < 8; ++d0) { int cb = (d0 * 16 + hi * 8) * 2; const bf16x8 q = qs[d0 * 64];
    bf16x8 b0 = *reinterpret_cast<const bf16x8*>((const char*)Ks + NA_KSWZ(r32, cb));
    bf16x8 b1 = *reinterpret_cast<const bf16x8*>((const char*)Ks + NA_KSWZ(32 + r32, cb));
    p0 = __builtin_amdgcn_mfma_f32_32x32x16_bf16(b0, q, p0, 0, 0, 0);
    p1 = __builtin_amdgcn_mfma_f32_32x32x16_bf16(b1, q, p1, 0, 0, 0); }
}
__device__ __forceinline__ int v_st(int k, int c) { const int kk = (k & ~0xC) | ((k & 4) << 1) | ((k & 8) >> 1); return ((kk >> 3) * 4 + (c >> 5)) * 512 + ((kk & 7) * 32 + (c & 31)) * 2; }
__device__ __forceinline__ int v_rd_base(int lane) { return ((lane & 3) << 3) | (((lane >> 2) & 3) << 6) | (((lane >> 4) & 1) << 5) | (((lane >> 5) & 1) << 8); }
constexpr int v_rd_off(int d0, int ks, int half) { return d0 * 512 + ks * 4096 + half * 2048; }
template <int OFF> __device__ __forceinline__ s16x4 tr_read(int vb) {
  s16x4 r; asm volatile("ds_read_b64_tr_b16 %0, %1 offset:%2" : "=&v"(r) : "v"(vb), "i"(OFF) : "memory"); return r;
}
template <int D0> __device__ __forceinline__ void pv_one(f32x16& od, int vb, bf16x8 pa0, bf16x8 pa1, bf16x8 pa2, bf16x8 pa3) {
  const s16x4 l0 = tr_read<v_rd_off(D0, 0, 0)>(vb), h0 = tr_read<v_rd_off(D0, 0, 1)>(vb), l1 = tr_read<v_rd_off(D0, 1, 0)>(vb), h1 = tr_read<v_rd_off(D0, 1, 1)>(vb);
  const s16x4 l2 = tr_read<v_rd_off(D0, 2, 0)>(vb), h2 = tr_read<v_rd_off(D0, 2, 1)>(vb), l3 = tr_read<v_rd_off(D0, 3, 0)>(vb), h3 = tr_read<v_rd_off(D0, 3, 1)>(vb);
  asm volatile("s_waitcnt lgkmcnt(0)" ::: "memory"); NA_SBAR();
#define NA_PK(L, H) (bf16x8){L[0], L[1], L[2], L[3], H[0], H[1], H[2], H[3]}
  od = __builtin_amdgcn_mfma_f32_32x32x16_bf16(pa0, NA_PK(l0, h0), od, 0, 0, 0);
  od = __builtin_amdgcn_mfma_f32_32x32x16_bf16(pa1, NA_PK(l1, h1), od, 0, 0, 0);
  od = __builtin_amdgcn_mfma_f32_32x32x16_bf16(pa2, NA_PK(l2, h2), od, 0, 0, 0);
  od = __builtin_amdgcn_mfma_f32_32x32x16_bf16(pa3, NA_PK(l3, h3), od, 0, 0, 0);
#undef NA_PK
}
__device__ __forceinline__ void pv_d0(f32x16* o, int vb, bf16x8 pa0, bf16x8 pa1, bf16x8 pa2, bf16x8 pa3) {
  pv_one<0>(o[0], vb, pa0, pa1, pa2, pa3); pv_one<1>(o[1], vb, pa0, pa1, pa2, pa3); pv_one<2>(o[2], vb, pa0, pa1, pa2, pa3); pv_one<3>(o[3], vb, pa0, pa1, pa2, pa3);
}

__device__ __forceinline__ void init_scores(f32x16& p0, f32x16& p1, int j, int klo, int qrow, const float* bt_l, const float* pen_l) {
  if (j < 4) { p0 = f32x16{}; p1 = f32x16{}; return; }
  const int kr = klo + j - 4, rs = min(max(qrow - 4, 0), 56);
  if (kr < rs || kr >= rs + 8) {
#pragma unroll
    for (int r = 0; r < 16; ++r) { p0[r] = NEG; p1[r] = NEG; }
    return;
  }
  int zo; asm volatile("v_mov_b32 %0, 0" : "=v"(zo));
  const float* bl = bt_l + (kr - qrow + 7) * 32; pen_l += zo;
#pragma unroll
  for (int r = 0; r < 16; ++r) { const int c = (r & 3) + 8 * (r >> 2); p0[r] = bl[c] + pen_l[c]; p1[r] = bl[32 + c] + pen_l[32 + c]; }
}

template <int LDP, int LDO>
__device__ __forceinline__ void na_unit(const bf16* __restrict__ P, int qcol, int kcol, int vcol, long qrow0, long crow0, long brow0, int nband, int klo, int qg0,
                                        bf16* __restrict__ O, int ocol, const float* __restrict__ rpbh, char* lds, const int tid) {
  const int wid = tid >> 6, lane = tid & 63, r32 = lane & 31, hi = lane >> 5;
  bf16* V_lds = (bf16*)lds; bf16* K_lds = (bf16*)(lds + 2 * SHM_V);
  float* ws = (float*)(lds + 2 * SHM_V + 2 * SHM_K) + wid * 64; float* li_l = ws; float* al_l = ws + 32;
  float* blds = (float*)(lds + BIAS_OFF); float* pens = (float*)(lds + PEN_OFF);
  __syncthreads();
  if (nband > 0) {
    for (int i = tid; i < 640; i += 512) { const int t2 = i - 64, dri = t2 >> 5, dci = t2 & 31; blds[i] = (t2 >= 0 && t2 < 480 && dci < 31) ? rpbh[dri * 31 + dci] * (1.0f / SCALE) : 0.f; }
    if (tid < 128) pens[tid] = (tid >= 48 && tid < 64) ? 0.f : NEG;
  }
  float m_reg = -1e30f, l_reg = 0; f32x16 o[4] = {};
  bf16x8* qs = (bf16x8*)(lds + QS_OFF + wid * 8192) + lane;
  { const bf16* Qw = P + (qrow0 + wid * QBLK + r32) * LDP + qcol + hi * 8;
#pragma unroll
    for (int d0 = 0; d0 < 8; ++d0) qs[d0 * 64] = *reinterpret_cast<const bf16x8*>(Qw + d0 * 16); }
  const int sr = tid >> 4, sc = (tid & 15) * 8, vst0 = v_st(sr, sc), vst1 = v_st(32 + sr, sc);
  const int vb0 = (int)(uintptr_t)V_lds + v_rd_base(lane);
  const int qrow = qg0 + (wid >> 1), qc = (wid & 1) * 32 + r32;
  const float* bt_l = blds + 64 + 15 - qc + 4 * hi; const float* pen_l = pens + 48 - min(max(qc - 8, 0), 48) + 4 * hi;
  const bf16* Kh = P + kcol; const bf16* Vh = P + vcol;
  bf16x8 vs0, vs1, ks0, ks1;
#define NA_TROW(j) ((j) < 4 ? crow0 + (long)(j) * 64 : brow0 + (long)((j) - 4) * 64)
#define NA_SLOAD(j) do { const long _k0 = NA_TROW(j); vs0 = *reinterpret_cast<const bf16x8*>(&Vh[(_k0 + sr) * LDP + sc]); vs1 = *reinterpret_cast<const bf16x8*>(&Vh[(_k0 + 32 + sr) * LDP + sc]); \
    ks0 = *reinterpret_cast<const bf16x8*>(&Kh[(_k0 + sr) * LDP + sc]); ks1 = *reinterpret_cast<const bf16x8*>(&Kh[(_k0 + 32 + sr) * LDP + sc]); } while (0)
#define NA_SWRITE(b) do { *(bf16x8*)((char*)V_lds + (b) * SHM_V + vst0) = vs0; *(bf16x8*)((char*)V_lds + (b) * SHM_V + vst1) = vs1; const int kc = sc * 2; \
    *(bf16x8*)((char*)K_lds + (b) * SHM_K + NA_KSWZ(sr, kc)) = ks0; *(bf16x8*)((char*)K_lds + (b) * SHM_K + NA_KSWZ(32 + sr, kc)) = ks1; } while (0)
#define NA_RESC(a) do { if (__any((a) < 1.f)) { if (hi == 0) al_l[r32] = (a); asm volatile("s_waitcnt lgkmcnt(0)" ::: "memory"); \
    _Pragma("unroll") for (int d = 0; d < 4; ++d) _Pragma("unroll") for (int r = 0; r < 16; ++r) o[d][r] *= al_l[crow(r, hi)]; } } while (0)
  f32x16 p0, p1; float mn, al; bf16x8 pa0, pa1, pa2, pa3; const int NT = 4 + nband; const int rs_ = min(max(qrow - 4, 0), 56);
  NA_SLOAD(0);
  for (int j = 0; j < NT; ++j) {
    const int b = j & 1;
    NA_SWRITE(b);
    if (j + 1 < NT) NA_SLOAD(j + 1);
    __syncthreads();
    const int kr_ = klo + j - 4;
    if (j < 4 || (kr_ >= rs_ && kr_ < rs_ + 8)) {
      init_scores(p0, p1, j, klo, qrow, bt_l, pen_l);
      qkt(p0, p1, (const bf16*)((const char*)K_lds + b * SHM_K), qs, r32, hi);
      partialSM(p0, p1, m_reg, mn, al);
      NA_RESC(al);
      finishSM(p0, p1, al, l_reg, pa0, pa1, pa2, pa3); NA_SBAR();
      pv_d0(o, vb0 + b * (int)SHM_V, pa0, pa1, pa2, pa3);
    }
  }
  if (hi == 0) li_l[r32] = l_reg; asm volatile("s_waitcnt lgkmcnt(0)" ::: "memory");
  float rli[16];
#pragma unroll
  for (int r = 0; r < 16; ++r) rli[r] = __builtin_amdgcn_rcpf(li_l[crow(r, hi)]);
  bf16* Ow = O + (qrow0 + wid * QBLK) * LDO + ocol;
#pragma unroll
  for (int r = 0; r < 16; ++r) { const int orow = crow(r, hi);
#pragma unroll
    for (int d0 = 0; d0 < 4; ++d0) { const float v = o[d0][r] * rli[r]; Ow[(long)orow * LDO + d0 * 32 + r32] = (bf16)pg8::f2bfc(v); } }
#undef NA_TROW
#undef NA_SLOAD
#undef NA_SWRITE
#undef NA_RESC
}
}

constexpr int NWAVES = 8;
constexpr int D = 2048, NBATCH = 4, SEQ = 4096, MLAT = NBATCH * SEQ, CTXL = 256, MCTX = NBATCH * CTXL, MR = MLAT + MCTX;
#ifndef PADF
#define PADF 128
#endif
constexpr int DFF = 5632, DUP = 2 * DFF, DIN = 6176, DINP = 6400, DEPTH = 4, LDF = DFF + PADF;
constexpr int MODW = 6 * D;
constexpr float EPS = 1e-6f;
constexpr int C_QA = 0, C_KA = 1024, C_VA = 2048, C_QB = 3072, C_KB = 3584, C_VB = 4096, C_GB = 5120, C_AB = 6144;

constexpr size_t MiB = 1u << 20;
constexpr size_t WS_CTL = 0, CTL_ZERO_BYTES = 32768;
constexpr size_t WS_MOD = 1 * MiB;
constexpr size_t WS_ROPE = WS_MOD + (size_t)DEPTH * 5 * MODW * 4;
constexpr size_t WS_WIN = 2 * MiB;
constexpr size_t WS_WOUT = WS_WIN + (size_t)2 * DINP * D * 2;
constexpr size_t WS_WPOOL = WS_WOUT + (size_t)2 * D * D * 2;
constexpr size_t WS_WUP = WS_WPOOL + (size_t)2 * 4 * 512 * 512 * 2;
constexpr size_t WS_WDOWN = WS_WUP + (size_t)DEPTH * DUP * D * 2;
constexpr size_t WS_XR = WS_WDOWN + (size_t)DEPTH * D * LDF * 2;
constexpr size_t WS_X16 = WS_XR;
constexpr size_t WS_PART = WS_XR + (size_t)MLAT * D * 2;
constexpr size_t WS_H = WS_XR + (size_t)MR * D * 4;
constexpr size_t WS_MIX = WS_H + (size_t)MR * D * 2;
constexpr size_t WS_BIG = WS_MIX + (size_t)MR * D * 2;
constexpr size_t WS_U = WS_BIG;
constexpr size_t WS_ACT = WS_U + (size_t)MR * DUP * 2;
constexpr size_t WS_P = WS_BIG;
constexpr size_t WS_QF = WS_P + (size_t)MR * DINP * 2;
constexpr size_t WS_KF = WS_QF + (size_t)MR * 512 * 2;
constexpr size_t WS_QB = WS_KF + (size_t)MR * 512 * 2;
constexpr size_t WS_KB = WS_QB + (size_t)MR * 512 * 2;
constexpr size_t WS_KHT = WS_KB + (size_t)MR * 512 * 2;
constexpr size_t WS_AL = WS_KHT + (size_t)2 * MR * 512 * 2;
constexpr size_t WS_UT = WS_AL + (size_t)2 * (MR / 64) * 512 * 4;
constexpr size_t WS_ST = WS_UT + (size_t)64 * 68 * 8192 * 2;
constexpr size_t WS_MIXEND = WS_ST + (size_t)64 * 68 * 8192 * 2;
constexpr size_t WS_SB = WS_ACT + (size_t)MR * LDF * 2;
constexpr size_t WS_END = WS_SB + (size_t)(MR / 256) * 2 * 3 * DFF * 4;
static_assert(WS_MIXEND <= WS_END, "even-mixer view fits inside the FFN view");
static_assert(WS_ROPE + 2 * 64 * 16 * 4 <= WS_WIN, "small tables fit below the weights");
constexpr int CW_BAR = 4096;

constexpr int RING_OFF = 0, RING_BYTES = 143360;
constexpr int LDSCTL_OFF = RING_BYTES, MISC_OFF = LDSCTL_OFF + 320;
constexpr int LDS_BYTES = 147456;
static_assert(na::LDS_END <= RING_BYTES, "attention LDS fits the ring");

#define GAS __attribute__((address_space(1)))
#define LAS __attribute__((address_space(3)))
typedef unsigned short bf16;
typedef unsigned v4u __attribute__((ext_vector_type(4)));
typedef unsigned v2u __attribute__((ext_vector_type(2)));
typedef float f32x4 __attribute__((ext_vector_type(4)));
#define LDS_WAIT() asm volatile("s_waitcnt lgkmcnt(0)" ::: "memory")
__device__ __forceinline__ unsigned f2bf(float f) { return pg8::f2bfc(f); }
__device__ __forceinline__ unsigned pk2(float lo, float hi) { return pg8::pkc(lo, hi); }
__device__ __forceinline__ unsigned pk2h(float lo, float hi) { return pg8::cvt_pk_bf16(lo, hi); }
__device__ __forceinline__ float bflo(unsigned w) { return __builtin_bit_cast(float, w << 16); }
__device__ __forceinline__ float bfhi(unsigned w) { return __builtin_bit_cast(float, w & 0xffff0000u); }
__device__ __forceinline__ float bf2f(bf16 b) { return __builtin_bit_cast(float, (unsigned)b << 16); }

#define XB_TMO      128
#define XB_XCNT(j)  (256  + 64 * (j))
#define XB_XSUB(j)  (1280 + 64 * (j))
#define XB_XGEN(j)  (2304 + 64 * (j))
#define XB_TOP      3328
#define XB_TOPGEN   3392
#define XCD_BAR_WORDS 3456
#define XB_SPIN_CAP (1u << 18)
__device__ __forceinline__ unsigned xb_ld(unsigned* p)              { return __hip_atomic_load(p, __ATOMIC_RELAXED, __HIP_MEMORY_SCOPE_AGENT); }
__device__ __forceinline__ unsigned xb_add(unsigned* p, unsigned v) { return __hip_atomic_fetch_add(p, v, __ATOMIC_RELAXED, __HIP_MEMORY_SCOPE_AGENT); }
__device__ __forceinline__ unsigned xb_xcc_id() { return (unsigned)__builtin_amdgcn_s_getreg((3 << 11) | 20) & 0xFu; }
#define XB_SPIN(cond, bar) do { unsigned _sp = 0; while (cond) { __builtin_amdgcn_s_sleep(1); \
    if ((++_sp & 255u) == 0u) { if (xb_ld(&(bar)[XB_TMO])) break; if (_sp > XB_SPIN_CAP) { atomicAdd(&(bar)[XB_TMO], 1u); break; } } } } while (0)
struct XcdBarrier { unsigned* bar; unsigned x; volatile LAS unsigned* st; };
__device__ __forceinline__ XcdBarrier xcd_barrier_post(unsigned* bar, volatile LAS unsigned* st) {
    XcdBarrier b; b.bar = bar; b.x = xb_xcc_id(); b.st = st;
    if (threadIdx.x == 0) (void)xb_add(&bar[XB_XCNT(b.x)], 1u);
    return b;
}
__device__ __forceinline__ void xcd_barrier_complete(unsigned* bar, unsigned x, unsigned& nloc, unsigned& nx) {
    const unsigned G = gridDim.x * gridDim.y * gridDim.z;
    unsigned sum, cnt, mine, sp = 0u;
    for (;;) {
        sum = 0u; cnt = 0u; mine = 0u;
#pragma unroll
        for (unsigned j = 0; j < 16; ++j) { const unsigned c = xb_ld(&bar[XB_XCNT(j)]); sum += c; cnt += (c > 0u) ? 1u : 0u; mine = (j == x) ? c : mine; }
        if (sum == G) break;
        __builtin_amdgcn_s_sleep(1);
        if ((++sp & 255u) == 0u) { if (xb_ld(&bar[XB_TMO])) break; if (sp > XB_SPIN_CAP) { atomicAdd(&bar[XB_TMO], 1u); break; } }
    }
    nloc = mine > 0u ? mine : 1u; nx = cnt > 0u ? cnt : 1u;
}
__device__ __forceinline__ void xcd_barrier(const XcdBarrier& b) {
    asm volatile("s_waitcnt vmcnt(0)" ::: "memory");
    __syncthreads();
    if (threadIdx.x == 0) {
        unsigned* bar = b.bar;
        __builtin_amdgcn_s_waitcnt(0);
        unsigned nloc = b.st[0], nx = b.st[1];
        if (nloc == 0u) { xcd_barrier_complete(bar, b.x, nloc, nx); b.st[0] = nloc; b.st[1] = nx; }
        const unsigned old = xb_add(&bar[XB_XSUB(b.x)], 1u);
        const unsigned gen = old / nloc;
        if (old + 1u == (gen + 1u) * nloc) {
            __builtin_amdgcn_fence(__ATOMIC_RELEASE, "agent");
            asm volatile("s_waitcnt vmcnt(0)" ::: "memory");
            const unsigned og = xb_add(&bar[XB_TOP], 1u);
            const unsigned tg = og / nx;
            if (og + 1u == (tg + 1u) * nx) xb_add(&bar[XB_TOPGEN], 1u);
            else XB_SPIN(xb_ld(&bar[XB_TOPGEN]) == tg, bar);
            __builtin_amdgcn_fence(__ATOMIC_ACQUIRE, "agent");
            xb_add(&bar[XB_XGEN(b.x)], 1u);
            asm volatile("s_waitcnt vmcnt(0)" ::: "memory");
        } else {
            XB_SPIN(xb_ld(&bar[XB_XGEN(b.x)]) == gen, bar);
            __builtin_amdgcn_fence(__ATOMIC_ACQUIRE, "agent");
            asm volatile("s_waitcnt vmcnt(0)" ::: "memory");
        }
    }
    __syncthreads();
}

struct Args { const float* in[21]; float* out; unsigned char* ws; int ph_lo, ph_hi; };
static_assert(sizeof(Args) == 23 * 8 + 8, "Args has no padding bytes");
typedef const __attribute__((address_space(4))) Args* KArgs;
enum { I_X = 0, I_C, I_CTX, I_CCTX, I_WMOD, I_BMOD, I_N1G, I_N2G, I_WIN, I_WG2, I_BG, I_RPB, I_GLAG, I_WOUT, I_POOLW, I_POOLS, I_WUP, I_CONVW, I_CONVB, I_WDOWN, I_FING };
struct Frame {
    LAS unsigned char* lds; unsigned char* ldsg;
    volatile LAS unsigned* MISC;
    int tid, lane, wave, vcu, G;
    KArgs ka; unsigned char* ws;
};
__device__ __forceinline__ float wave_sum(float v) {
#pragma unroll
    for (int o = 1; o < 64; o <<= 1) v += __shfl_xor(v, o);
    return v;
}

__device__ __forceinline__ void p0_transpose_item(const float* W, int K, int N, bf16* WT, LAS float* scr, int item, int lane, int ldt = 0) {
    if (ldt == 0) ldt = K;
    const int nblk = N / 32, kb = item / nblk, nb = item % nblk, k0 = 64 * kb, n0 = 32 * nb;
#pragma unroll 8
    for (int i = 0; i < 32; ++i) { const int kk = 2 * i + (lane >> 5); scr[kk * 33 + (lane & 31)] = W[(size_t)(k0 + kk) * N + n0 + (lane & 31)]; }
    LDS_WAIT(); asm volatile("" ::: "memory");
    const int c = lane & 7;
#pragma unroll
    for (int j = 0; j < 4; ++j) { const int n = (lane >> 3) + 8 * j; const LAS float* s = scr + (8 * c) * 33 + n;
        v4u o; o.x = pk2(s[0 * 33], s[1 * 33]); o.y = pk2(s[2 * 33], s[3 * 33]); o.z = pk2(s[4 * 33], s[5 * 33]); o.w = pk2(s[6 * 33], s[7 * 33]);
        *(GAS v4u*)(WT + (size_t)(n0 + n) * ldt + k0 + 8 * c) = o; }
    LDS_WAIT(); asm volatile("" ::: "memory");
}
__device__ __forceinline__ void p0_transpose_item_up(const float* W, bf16* WT, LAS float* scr, int item, int lane) {
    constexpr int K = D, N = DUP;
    const int nblk = N / 32, kb = item / nblk, nb = item % nblk, k0 = 64 * kb, n0 = 32 * nb;
    const int isg = n0 >= DFF, c0 = isg ? n0 - DFF : n0, d0 = 256 * (c0 >> 7) + (isg ? 128 : 0) + (c0 & 127);
#pragma unroll 8
    for (int i = 0; i < 32; ++i) { const int kk = 2 * i + (lane >> 5); scr[kk * 33 + (lane & 31)] = W[(size_t)(k0 + kk) * N + n0 + (lane & 31)]; }
    LDS_WAIT(); asm volatile("" ::: "memory");
    const int c = lane & 7;
#pragma unroll
    for (int j = 0; j < 4; ++j) { const int n = (lane >> 3) + 8 * j; const LAS float* s = scr + (8 * c) * 33 + n;
        v4u o; o.x = pk2(s[0 * 33], s[1 * 33]); o.y = pk2(s[2 * 33], s[3 * 33]); o.z = pk2(s[4 * 33], s[5 * 33]); o.w = pk2(s[6 * 33], s[7 * 33]);
        *(GAS v4u*)(WT + (size_t)(d0 + n) * K + k0 + 8 * c) = o; }
    LDS_WAIT(); asm volatile("" ::: "memory");
}
__device__ __forceinline__ void ph_prologue(Frame& F) {
    const int gw = F.vcu * NWAVES + F.wave, NGW = F.G * NWAVES;
    const int gt = F.vcu * NWAVES * 64 + F.tid, NGT = F.G * NWAVES * 64;
    {
        LAS float* scr = (LAS float*)(F.lds + RING_OFF + F.wave * 16384);
        constexpr int I_IN = (D / 64) * (DIN / 32), I_OUT = (D / 64) * (D / 32), I_POOL = (512 / 64) * (512 / 32), I_UP = (D / 64) * (DUP / 32), I_DOWN = (DFF / 64) * (D / 32);
        constexpr int NITEMS = 2 * I_IN + 2 * I_OUT + 8 * I_POOL + 4 * I_UP + 4 * I_DOWN;
        bf16* WIN = (bf16*)(F.ws + WS_WIN); bf16* WOUT = (bf16*)(F.ws + WS_WOUT); bf16* WPOOL = (bf16*)(F.ws + WS_WPOOL); bf16* WUP = (bf16*)(F.ws + WS_WUP); bf16* WDOWN = (bf16*)(F.ws + WS_WDOWN);
        for (int it = gw; it < NITEMS; it += NGW) {
            int r = it;
            if (r < 4 * I_UP) { const int l = r / I_UP; p0_transpose_item_up((F.ka->in[I_WUP]) + (size_t)l * D * DUP, WUP + (size_t)l * DUP * D, scr, r % I_UP, F.lane); continue; } r -= 4 * I_UP;
            if (r < 4 * I_DOWN) { const int l = r / I_DOWN; p0_transpose_item((F.ka->in[I_WDOWN]) + (size_t)l * DFF * D, DFF, D, WDOWN + (size_t)l * D * LDF, scr, r % I_DOWN, F.lane, LDF); continue; } r -= 4 * I_DOWN;
            if (r < 2 * I_IN) { const int l = r / I_IN; p0_transpose_item((F.ka->in[I_WIN]) + (size_t)l * D * DIN, D, DIN, WIN + (size_t)l * DINP * D, scr, r % I_IN, F.lane); continue; } r -= 2 * I_IN;
            if (r < 2 * I_OUT) { const int l = r / I_OUT; p0_transpose_item((F.ka->in[I_WOUT]) + (size_t)l * D * D, D, D, WOUT + (size_t)l * D * D, scr, r % I_OUT, F.lane); continue; } r -= 2 * I_OUT;
            { const int l = r / I_POOL; p0_transpose_item((F.ka->in[I_POOLW]) + (size_t)l * 512 * 512, 512, 512, WPOOL + (size_t)l * 512 * 512, scr, r % I_POOL, F.lane); }
        }
        constexpr int ZV = (DINP - DIN) * D / 8;
        for (int i = gt; i < 2 * ZV; i += NGT) { const int l = i / ZV, j = i % ZV; *(GAS v4u*)(WIN + (size_t)l * DINP * D + (size_t)DIN * D + (size_t)j * 8) = (v4u){0u, 0u, 0u, 0u}; }
    }
    if (blockIdx.x == 0) {
        float* rc = (float*)(F.ws + WS_ROPE); float* rs = rc + 64 * 16;
        for (int i = F.tid; i < 64 * 16; i += NWAVES * 64) { const int pos = i >> 4, f = i & 15; const float inv = powf(10000.0f, -(float)f / 16.0f); const float ang = (float)pos * inv; rc[i] = cosf(ang); rs[i] = sinf(ang); }
    }
    __syncthreads();
    {
        LAS float* S = (LAS float*)(F.lds + RING_OFF);
        LAS float* RED = (LAS float*)(F.lds + RING_OFF + 40960);
        float* MOD = (float*)(F.ws + WS_MOD);
        constexpr int NTASK = DEPTH * (MODW / 256);
        if ((int)blockIdx.x < NTASK) {
            for (int i = F.tid; i < 5 * D; i += NWAVES * 64) { const int r = i / D, k = i % D; const float v = r < 4 ? (F.ka->in[I_C])[r * D + k] : (F.ka->in[I_CCTX])[k]; S[i] = v / (1.0f + __expf(-v)); }
            __syncthreads();
            for (int t = blockIdx.x; t < NTASK; t += F.G) {
                const int l = t / (MODW / 256), n0 = (t % (MODW / 256)) * 256, k0 = F.wave * 256;
                float acc[5][4];
#pragma unroll
                for (int r = 0; r < 5; ++r)
#pragma unroll
                    for (int cc = 0; cc < 4; ++cc) acc[r][cc] = 0.f;
                const float* Wp = (F.ka->in[I_WMOD]) + ((size_t)l * D + k0) * MODW + n0 + 4 * F.lane;
                for (int kk = 0; kk < 256; kk += 8) {
                    f32x4 wv[8];
#pragma unroll
                    for (int u = 0; u < 8; ++u) wv[u] = *(const f32x4*)(Wp + (size_t)(kk + u) * MODW);
#pragma unroll
                    for (int u = 0; u < 8; ++u)
#pragma unroll
                        for (int r = 0; r < 5; ++r) { const float s = S[r * D + k0 + kk + u];
#pragma unroll
                            for (int cc = 0; cc < 4; ++cc) acc[r][cc] = fmaf(s, wv[u][cc], acc[r][cc]); }
                }
#pragma unroll
                for (int r = 0; r < 5; ++r)
#pragma unroll
                    for (int cc = 0; cc < 4; ++cc) RED[(F.wave * 5 + r) * 256 + 4 * F.lane + cc] = acc[r][cc];
                __syncthreads();
                for (int o = F.tid; o < 5 * 256; o += NWAVES * 64) { const int r = o >> 8, ci = o & 255; float s = (F.ka->in[I_BMOD])[l * MODW + n0 + ci];
#pragma unroll
                    for (int w = 0; w < 8; ++w) s += RED[(w * 5 + r) * 256 + ci];
                    MOD[((size_t)l * 5 + r) * MODW + n0 + ci] = s; }
                __syncthreads();
            }
        }
    }
}

__device__ __forceinline__ f32x4 bf4_unpack(v2u h) { f32x4 r; r.x = pg8::h_lo(h.x); r.y = pg8::h_hi(h.x); r.z = pg8::h_lo(h.y); r.w = pg8::h_hi(h.y); return r; }
template <bool L16, bool CPY, bool CI>
__device__ __forceinline__ void norm_rows(Frame& F, const int ra, const int rb, const void* src, const int rbase, const float* g, const float* modl, const int off_sh, const int off_sc, const int nparts) {
    if (ra >= rb) return;
    bf16* H = (bf16*)(F.ws + WS_H);
    f32x4 gm[8], sh[8]; int cb = -1;
    f32x4 v[8], w[8]; v2u hv[8], hw[8];
#define NORM_P32(m) ((const f32x4*)((const float*)src + (size_t)((m) - rbase) * D) + F.lane)
#define NORM_P16(m) ((const v2u*)((const bf16*)src + (size_t)((m) - rbase) * D) + F.lane)
    if constexpr (L16) { const v2u* xr = NORM_P16(ra);
#pragma unroll
        for (int j = 0; j < 8; ++j) hv[j] = xr[64 * j];
    } else { const f32x4* xr = NORM_P32(ra);
#pragma unroll
        for (int j = 0; j < 8; ++j) v[j] = xr[64 * j]; }
    for (int m = ra; m < rb; ++m) {
        if (m + 1 < rb) {
            if constexpr (L16) { const v2u* xn = NORM_P16(m + 1);
#pragma unroll
                for (int j = 0; j < 8; ++j) hw[j] = xn[64 * j];
            } else { const f32x4* xn = NORM_P32(m + 1);
#pragma unroll
                for (int j = 0; j < 8; ++j) w[j] = xn[64 * j]; } }
        const int bidx = m < MLAT ? (m >> 12) : 4;
        if (bidx != cb) { cb = bidx;
            const f32x4* gp = (const f32x4*)g + F.lane; const f32x4* shp = (const f32x4*)(modl + (size_t)bidx * MODW + off_sh) + F.lane; const f32x4* scp = (const f32x4*)(modl + (size_t)bidx * MODW + off_sc) + F.lane;
#pragma unroll
            for (int j = 0; j < 8; ++j) { gm[j] = gp[64 * j] * (scp[64 * j] + 1.0f); sh[j] = shp[64 * j]; } }
        if constexpr (L16) {
#pragma unroll
            for (int j = 0; j < 8; ++j) v[j] = bf4_unpack(hv[j]); }
        if constexpr (CI) {
            for (int k = 0; k < nparts; ++k) { const f32x4* pp = (const f32x4*)((const float*)(F.ws + WS_PART) + ((size_t)k * MCTX + (size_t)(m - rbase)) * D) + F.lane;
#pragma unroll
                for (int j = 0; j < 8; ++j) v[j] = v[j] + pp[64 * j]; }
            f32x4* xw = (f32x4*)((float*)(F.ws + WS_XR) + (size_t)m * D) + F.lane;
#pragma unroll
            for (int j = 0; j < 8; ++j) xw[64 * j] = v[j]; }
        float s = 0.f;
#pragma unroll
        for (int j = 0; j < 8; ++j) s += (v[j].x * v[j].x + v[j].y * v[j].y) + (v[j].z * v[j].z + v[j].w * v[j].w);
        const float r = 1.0f / sqrtf(wave_sum(s) * (1.0f / D) + EPS);
        v2u* o8 = (v2u*)(H + (size_t)m * D) + F.lane;
#pragma unroll
        for (int j = 0; j < 8; ++j) { const f32x4 y = v[j] * r * gm[j] + sh[j]; v2u ww; ww.x = pk2h(y.x, y.y); ww.y = pk2h(y.z, y.w); o8[64 * j] = ww; }
        if constexpr (CPY) { v2u* c8 = (v2u*)((bf16*)(F.ws + WS_X16) + (size_t)m * D) + F.lane;
#pragma unroll
            for (int j = 0; j < 8; ++j) { v2u ww; ww.x = pg8::pk_h2(v[j].x, v[j].y); ww.y = pg8::pk_h2(v[j].z, v[j].w); c8[64 * j] = ww; } }
        if constexpr (L16) {
#pragma unroll
            for (int j = 0; j < 8; ++j) hv[j] = hw[j];
        } else {
#pragma unroll
            for (int j = 0; j < 8; ++j) v[j] = w[j]; }
    }
#undef NORM_P32
#undef NORM_P16
}
__device__ __forceinline__ void ph_norm(Frame& F, int nrows, const float* xl32, const float* xc, const float* g, const float* modl, int off_sh, int off_sc, int nparts) {
    const int gw = F.vcu * NWAVES + F.wave; int NGW = F.G * NWAVES; asm volatile("" : "+s"(NGW));
    const int nctx = nrows - MLAT;
    const int r0 = (int)((unsigned)gw * (unsigned)MLAT / (unsigned)NGW), r1 = (int)((unsigned)(gw + 1) * (unsigned)MLAT / (unsigned)NGW);
    const int c0 = MLAT + (int)((unsigned)gw * (unsigned)nctx / (unsigned)NGW), c1 = MLAT + (int)((unsigned)(gw + 1) * (unsigned)nctx / (unsigned)NGW);
    if (xl32) { norm_rows<false, true, false>(F, r0, r1, xl32, 0, g, modl, off_sh, off_sc, 0); norm_rows<false, false, false>(F, c0, c1, xc, MLAT, g, modl, off_sh, off_sc, 0); }
    else      { norm_rows<true, false, false>(F, r0, r1, F.ws + WS_X16, 0, g, modl, off_sh, off_sc, 0); norm_rows<false, false, true>(F, c0, c1, xc, MLAT, g, modl, off_sh, off_sc, nparts); }
}
__device__ __forceinline__ void ph_final(Frame& F) {
    const int gw = F.vcu * NWAVES + F.wave, NGW = F.G * NWAVES;
    const bf16* X16 = (const bf16*)(F.ws + WS_X16);
    const int r0 = (int)((long)gw * MLAT / NGW), r1 = (int)((long)(gw + 1) * MLAT / NGW);
    if (r0 >= r1) return;
    f32x4 gf[8], v[8]; v2u hv[8], hw[8];
    { const f32x4* gp = (const f32x4*)(F.ka->in[I_FING]) + F.lane; const v2u* xr = (const v2u*)(X16 + (size_t)r0 * D) + F.lane;
#pragma unroll
      for (int j = 0; j < 8; ++j) { gf[j] = gp[64 * j]; hv[j] = xr[64 * j]; } }
    for (int m = r0; m < r1; ++m) {
        if (m + 1 < r1) { const v2u* xn = (const v2u*)(X16 + (size_t)(m + 1) * D) + F.lane;
#pragma unroll
            for (int j = 0; j < 8; ++j) hw[j] = xn[64 * j]; }
#pragma unroll
        for (int j = 0; j < 8; ++j) v[j] = bf4_unpack(hv[j]);
        float s = 0.f;
#pragma unroll
        for (int j = 0; j < 8; ++j) s += (v[j].x * v[j].x + v[j].y * v[j].y) + (v[j].z * v[j].z + v[j].w * v[j].w);
        const float r = 1.0f / sqrtf(wave_sum(s) * (1.0f / D) + EPS);
        f32x4* op = (f32x4*)((F.ka->out) + (size_t)m * D) + F.lane;
#pragma unroll
        for (int j = 0; j < 8; ++j) __builtin_nontemporal_store(v[j] * r * gf[j], op + 64 * j);
#pragma unroll
        for (int j = 0; j < 8; ++j) hv[j] = hw[j];
    }
}
template <int HW>
__device__ __forceinline__ void pool_strip(const bf16* H, bf16* HP, int m0, int t0, int L, int c8) {
    constexpr int NR = 8 + 2 * HW - 1;
    v4u R[NR];
#pragma unroll
    for (int j = 0; j < NR; ++j) { const int tr = t0 - HW + j; R[j] = (v4u){0u, 0u, 0u, 0u}; if (tr >= 0 && tr < L) R[j] = *(const v4u*)(H + (size_t)(m0 - HW + j) * D + c8); }
    float s[8];
#pragma unroll
    for (int e = 0; e < 8; ++e) s[e] = 0.f;
#pragma unroll
    for (int j = 0; j < 2 * HW; ++j) { s[0] += bflo(R[j].x); s[1] += bfhi(R[j].x); s[2] += bflo(R[j].y); s[3] += bfhi(R[j].y); s[4] += bflo(R[j].z); s[5] += bfhi(R[j].z); s[6] += bflo(R[j].w); s[7] += bfhi(R[j].w); }
#pragma unroll
    for (int r = 0; r < 8; ++r) {
        const int t = t0 + r; const float inv = __builtin_amdgcn_rcpf((float)(min(t + HW, L) - max(t - HW, 0)));
        const v4u w = R[r + HW];
        v4u o; o.x = pk2h(s[0] * inv - bflo(w.x), s[1] * inv - bfhi(w.x)); o.y = pk2h(s[2] * inv - bflo(w.y), s[3] * inv - bfhi(w.y));
        o.z = pk2h(s[4] * inv - bflo(w.z), s[5] * inv - bfhi(w.z)); o.w = pk2h(s[6] * inv - bflo(w.w), s[7] * inv - bfhi(w.w));
        *(v4u*)(HP + (size_t)(m0 + r) * D + c8) = o;
        if (r < 7) { const v4u a = R[r + 2 * HW], b = R[r];
            s[0] += bflo(a.x) - bflo(b.x); s[1] += bfhi(a.x) - bfhi(b.x); s[2] += bflo(a.y) - bflo(b.y); s[3] += bfhi(a.y) - bfhi(b.y);
            s[4] += bflo(a.z) - bflo(b.z); s[5] += bfhi(a.z) - bfhi(b.z); s[6] += bflo(a.w) - bflo(b.w); s[7] += bfhi(a.w) - bfhi(b.w); }
    }
}
__device__ __forceinline__ void ph_pool(Frame& F, int nrows) {
    const int gt = F.vcu * NWAVES * 64 + F.tid, NGT = F.G * NWAVES * 64;
    const bf16* H = (const bf16*)(F.ws + WS_H); bf16* HP = (bf16*)(F.ws + WS_MIX);
    const int nitems = (nrows / 8) * (D / 8);
    for (int it = gt; it < nitems; it += NGT) {
        const int strip = it >> 8, c8 = (it & 255) * 8, gi = __builtin_amdgcn_readfirstlane(c8 >> 9), m0 = strip * 8;
        int t0, L;
        if (m0 < MLAT) { t0 = m0 & (SEQ - 1); L = SEQ; } else { t0 = (m0 - MLAT) & (CTXL - 1); L = CTXL; }
        if (gi == 0) pool_strip<1>(H, HP, m0, t0, L, c8); else if (gi == 1) pool_strip<2>(H, HP, m0, t0, L, c8); else if (gi == 2) pool_strip<4>(H, HP, m0, t0, L, c8); else pool_strip<8>(H, HP, m0, t0, L, c8);
    }
}
__device__ __forceinline__ void ph_glufix(Frame& F, int nrows, const float* cw, const float* cb) {
    const int gt = F.vcu * NWAVES * 64 + F.tid, NGT = F.G * NWAVES * 64;
    const float* SB = (const float*)(F.ws + WS_SB); bf16* ACT = (bf16*)(F.ws + WS_ACT);
    constexpr int C4 = DFF / 4;
    const int nitems = (nrows / 256) * 2 * C4;
    for (int it = gt; it < nitems; it += NGT) {
        const int c4 = (it % C4) * 4, pw = it / C4, which = pw & 1, pm = pw >> 1, row = 256 * pm + (which ? 255 : 0);
        int t, L;
        if (row < MLAT) { t = row & (SEQ - 1); L = SEQ; } else { t = (row - MLAT) & (CTXL - 1); L = CTXL; }
        const float* sb = SB + ((size_t)(pm * 2 + which) * 3) * DFF + c4;
        f32x4 cv = *(const f32x4*)sb; const f32x4 vl = *(const f32x4*)(sb + DFF);
        if (which == 0 && t > 0)     cv = cv + *(const f32x4*)(cw + c4) * *(const f32x4*)(SB + ((size_t)((pm - 1) * 2 + 1) * 3 + 2) * DFF + c4);
        if (which == 1 && t < L - 1) cv = cv + *(const f32x4*)(cw + 2 * DFF + c4) * *(const f32x4*)(SB + ((size_t)((pm + 1) * 2 + 0) * 3 + 2) * DFF + c4);
        const pg8::f32x2 g0 = pg8::gelu_pk((pg8::f32x2){cv.x, cv.y}), g1 = pg8::gelu_pk((pg8::f32x2){cv.z, cv.w});
        v2u o; o.x = pk2h(g0.x * vl.x, g0.y * vl.y); o.y = pk2h(g1.x * vl.z, g1.y * vl.w);
        *(v2u*)(ACT + (size_t)row * LDF + c4) = o;
    }
}

namespace gla {
typedef short bf16x8 __attribute__((ext_vector_type(8)));
typedef float f32x16 __attribute__((ext_vector_type(16)));
typedef unsigned u32x4 __attribute__((ext_vector_type(4)));
constexpr int NRC = MR / 64;
constexpr int PITCH = 72;
__device__ __forceinline__ int crow(int r, int hi) { return (r & 3) + 8 * (r >> 2) + 4 * hi; }
__device__ __forceinline__ unsigned cvtpk(float lo, float hi) { unsigned r; asm volatile("v_cvt_pk_bf16_f32 %0, %1, %2" : "=v"(r) : "v"(lo), "v"(hi)); return r; }
__device__ __forceinline__ int chain_slot_rc(int b, int dir, int s) { return s < 4 ? 256 + 4 * b + (dir ? 3 - s : s) : 64 * b + (dir ? 63 - (s - 4) : s - 4); }
__device__ __forceinline__ int rc_slot(int rc, int dir) { return rc < 256 ? 4 + (dir ? 63 - (rc & 63) : (rc & 63)) : (dir ? 3 - (rc & 3) : (rc & 3)); }
__device__ __forceinline__ int rc_batch(int rc) { return rc < 256 ? rc >> 6 : (rc - 256) >> 2; }
__device__ __forceinline__ float logsig16(float z2) { return (fminf(z2, 0.f) - __builtin_amdgcn_logf(1.0f + __builtin_amdgcn_exp2f(-fabsf(z2)))) * (1.0f / 16.0f); }

__device__ __forceinline__ void ph_prep(Frame& F, int e) {
    const bf16* P = (const bf16*)(F.ws + WS_P);
    bf16* QF = (bf16*)(F.ws + WS_QF); bf16* KF = (bf16*)(F.ws + WS_KF); bf16* QB = (bf16*)(F.ws + WS_QB); bf16* KB = (bf16*)(F.ws + WS_KB);
    float* AL = (float*)(F.ws + WS_AL);
    const float* ropec = (const float*)(F.ws + WS_ROPE); const float* ropes = ropec + 64 * 16;
    const float* w2 = (F.ka->in[I_WG2]) + (size_t)e * 2 * 16 * 512; const float* bg = (F.ka->in[I_BG]) + (size_t)e * 2 * 512;
    LAS float* ABf = (LAS float*)(F.lds + RING_OFF);
    LAS float* RTc = (LAS float*)(F.lds + RING_OFF + 8192); LAS float* RTs = RTc + 64 * 16;
    for (int i = F.tid; i < 2 * 64 * 16; i += NWAVES * 64) RTc[i] = ropec[i];
    const int dk = F.lane;
    pg8::f32x2 wfb[16], bfb; int col;
    const int hf = dk >> 5, f = dk & 15; const float sgn = ((dk >> 4) & 1) ? 1.0f : -1.0f;
#define GLA_Z(t, zf, zb) do { const LAS f32x4* ap = (const LAS f32x4*)(ABf + (t) * 32); pg8::f32x2 z2 = bfb; \
        _Pragma("unroll") for (int i = 0; i < 8; ++i) { const f32x4 a = ap[i]; z2 = (pg8::f32x2){a.x, a.y} * wfb[2 * i] + z2; z2 = (pg8::f32x2){a.z, a.w} * wfb[2 * i + 1] + z2; } \
        zf = z2.x; zb = z2.y; } while (0)
    const int NT = 256 + (NRC - 256) * 8;
    for (int task = blockIdx.x; task < NT; task += F.G) {
        const int rc = task < 256 ? task : 256 + ((task - 256) >> 3), h = task < 256 ? F.wave : ((task - 256) & 7);
        const bool active = task < 256 || F.wave == 0;
        const bool lat = rc < 256;
        const bf16* Prow0 = P + (size_t)rc * 64 * DINP;
        col = 64 * h + dk;
#pragma unroll
        for (int i = 0; i < 16; ++i) wfb[i] = (pg8::f32x2){w2[i * 512 + col], w2[(16 + i) * 512 + col]} * 1.4426950408889634f;
        bfb = (pg8::f32x2){bg[col], bg[512 + col]} * 1.4426950408889634f;
        __syncthreads();
        if (F.tid < 256) { const int row = F.tid >> 2, part = F.tid & 3; const v4u w = *(const v4u*)(Prow0 + (size_t)row * DINP + C_AB + 8 * part);
            LAS float* d = ABf + row * 32 + 16 * (part & 1) + (part >> 1);
            d[0] = bflo(w.x); d[2] = bfhi(w.x); d[4] = bflo(w.y); d[6] = bfhi(w.y); d[8] = bflo(w.z); d[10] = bfhi(w.z); d[12] = bflo(w.w); d[14] = bfhi(w.w); }
        __syncthreads();
        if (!active) continue;
        const int prw = rc & 63;
        float pf = 0.f, pbx = 0.f;
        for (int t8 = 0; t8 < 64; t8 += 8) {
            float qv[8], kv[8];
#pragma unroll
            for (int tt = 0; tt < 8; ++tt) { const bf16* prow = Prow0 + (size_t)(t8 + tt) * DINP; qv[tt] = bf2f(prow[C_QB + col]); kv[tt] = bf2f(prow[C_KB + col]); }
#pragma unroll
            for (int tt = 0; tt < 8; ++tt) {
                const int t = t8 + tt;
                float zf, zb; GLA_Z(t, zf, zb);
                const float gf = logsig16(zf), gb = logsig16(zb);
                pf += gf; const float cumf = pf, pbe = pbx; pbx += gb;
                float q = qv[tt], k = kv[tt];
                float qp, kp;
                { const unsigned uq = __builtin_bit_cast(unsigned, q), uk = __builtin_bit_cast(unsigned, k);
                  const auto rq = __builtin_amdgcn_permlane16_swap(uq, uq, false, false); const auto rk = __builtin_amdgcn_permlane16_swap(uk, uk, false, false);
                  qp = __builtin_bit_cast(float, (dk & 16) ? rq[0] : rq[1]); kp = __builtin_bit_cast(float, (dk & 16) ? rk[0] : rk[1]); }
                if (lat) { const int ri = (hf ? t : prw) * 16 + f; const float c = RTc[ri], s = RTs[ri];
                    const float ss = s * sgn; q = fmaf(qp, ss, q * c); k = fmaf(kp, ss, k * c); }
                q *= 0.125f;
                const unsigned o = (unsigned)((rc * 64 + t) * 512 + col);
                const unsigned wq = pg8::cvt_pk_bf16(q * __builtin_amdgcn_exp2f(cumf), q * __builtin_amdgcn_exp2f(fminf(-pbe, 115.f))), wk = pg8::cvt_pk_bf16(k * __builtin_amdgcn_exp2f(fminf(-cumf, 115.f)), k * __builtin_amdgcn_exp2f(pbe));
                QF[o] = (bf16)(wq & 0xffffu); QB[o] = (bf16)(wq >> 16); KF[o] = (bf16)(wk & 0xffffu); KB[o] = (bf16)(wk >> 16);
            }
        }
        AL[(size_t)(0 * NRC + rc) * 512 + col] = __builtin_amdgcn_exp2f(pf); AL[(size_t)(1 * NRC + rc) * 512 + col] = __builtin_amdgcn_exp2f(pbx);
    }
#undef GLA_Z
    __syncthreads();
}

__device__ __forceinline__ void stage_vt(Frame& F, const bf16* P, int rc, int h, LAS bf16* VT) {
    const int tp = (F.tid & 31) * 2, d8 = (F.tid >> 5) * 8;
    const bf16* src = P + (size_t)(rc * 64 + tp) * DINP + C_VB + 128 * h + d8;
    const v4u w0 = *(const v4u*)src, w1 = *(const v4u*)(src + DINP);
    LAS unsigned* dst = (LAS unsigned*)(VT + d8 * PITCH + tp);
    dst[0 * (PITCH / 2)] = (w0.x & 0xffffu) | (w1.x << 16); dst[1 * (PITCH / 2)] = (w0.x >> 16) | (w1.x & 0xffff0000u);
    dst[2 * (PITCH / 2)] = (w0.y & 0xffffu) | (w1.y << 16); dst[3 * (PITCH / 2)] = (w0.y >> 16) | (w1.y & 0xffff0000u);
    dst[4 * (PITCH / 2)] = (w0.z & 0xffffu) | (w1.z << 16); dst[5 * (PITCH / 2)] = (w0.z >> 16) | (w1.z & 0xffff0000u);
    dst[6 * (PITCH / 2)] = (w0.w & 0xffffu) | (w1.w << 16); dst[7 * (PITCH / 2)] = (w0.w >> 16) | (w1.w & 0xffff0000u);
}
#define GLA_BAR() do { asm volatile("s_waitcnt lgkmcnt(0)" ::: "memory"); __builtin_amdgcn_s_barrier(); asm volatile("" ::: "memory"); } while (0)
#define GLA_FRAG(base, row, col) (*(const LAS bf16x8*)((base) + (row) * PITCH + (col)))

__device__ __forceinline__ void ph_g1(Frame& F) {
    const bf16* P = (const bf16*)(F.ws + WS_P); const bf16* KFg = (const bf16*)(F.ws + WS_KF); const bf16* KBg = (const bf16*)(F.ws + WS_KB); bf16* UT = (bf16*)(F.ws + WS_UT); const float* AL = (const float*)(F.ws + WS_AL);
    LAS bf16* VT = (LAS bf16*)(F.lds + RING_OFF); LAS bf16* KH0 = VT + 128 * PITCH; LAS bf16* KH1 = KH0 + 64 * PITCH;
    const int r32 = F.lane & 31, hi = F.lane >> 5, dir = F.wave >> 2, db = F.wave & 3;
    for (int u = blockIdx.x; u < NRC * 8; u += F.G) {
        const int rc = u >> 3, h = u & 7;
        __syncthreads();
        stage_vt(F, P, rc, h, VT);
        {
            const int half = F.tid >> 8, tl = F.tid & 255, tp = (tl & 31) * 2, d8 = (tl >> 5) * 8;
            const bf16* src = (half ? KBg : KFg) + (size_t)(rc * 64 + tp) * 512 + 64 * h + d8;
            const v4u w0 = *(const v4u*)src, w1 = *(const v4u*)(src + 512);
            LAS unsigned* dst = (LAS unsigned*)((half ? KH1 : KH0) + d8 * PITCH + tp);
            dst[0 * (PITCH / 2)] = (w0.x & 0xffffu) | (w1.x << 16); dst[1 * (PITCH / 2)] = (w0.x >> 16) | (w1.x & 0xffff0000u);
            dst[2 * (PITCH / 2)] = (w0.y & 0xffffu) | (w1.y << 16); dst[3 * (PITCH / 2)] = (w0.y >> 16) | (w1.y & 0xffff0000u);
            dst[4 * (PITCH / 2)] = (w0.z & 0xffffu) | (w1.z << 16); dst[5 * (PITCH / 2)] = (w0.z >> 16) | (w1.z & 0xffff0000u);
            dst[6 * (PITCH / 2)] = (w0.w & 0xffffu) | (w1.w << 16); dst[7 * (PITCH / 2)] = (w0.w >> 16) | (w1.w & 0xffff0000u); }
        __syncthreads();
        const LAS bf16* KH = dir ? KH1 : KH0;
        f32x16 acc0 = {}, acc1 = {};
#pragma unroll
        for (int ks = 0; ks < 4; ++ks) { const bf16x8 a = GLA_FRAG(VT, 32 * db + r32, 16 * ks + 8 * hi);
            acc0 = __builtin_amdgcn_mfma_f32_32x32x16_bf16(a, GLA_FRAG(KH, r32, 16 * ks + 8 * hi), acc0, 0, 0, 0);
            acc1 = __builtin_amdgcn_mfma_f32_32x32x16_bf16(a, GLA_FRAG(KH, 32 + r32, 16 * ks + 8 * hi), acc1, 0, 0, 0); }
        const int b = rc_batch(rc), chain = (b * 8 + h) * 2 + dir, slot = rc_slot(rc, dir);
        if (dir == 0) { const float a0 = AL[(size_t)rc * 512 + 64 * h + r32], a1 = AL[(size_t)rc * 512 + 64 * h + 32 + r32];
#pragma unroll
            for (int r = 0; r < 16; ++r) { acc0[r] *= a0; acc1[r] *= a1; } }
        bf16* dst = UT + ((size_t)chain * 68 + slot) * 8192;
#pragma unroll
        for (int r = 0; r < 16; ++r) { const int dv = 32 * db + crow(r, hi); const unsigned w2_ = pk2(acc0[r], acc1[r]); dst[dv * 64 + r32] = (bf16)(w2_ & 0xffffu); dst[dv * 64 + 32 + r32] = (bf16)(w2_ >> 16); }
    }
    __syncthreads();
}

__device__ __forceinline__ void ph_g2(Frame& F) {
    const int gt = F.vcu * NWAVES * 64 + F.tid, NGT = F.G * NWAVES * 64;
    const bf16* UT = (const bf16*)(F.ws + WS_UT); bf16* ST = (bf16*)(F.ws + WS_ST); const float* AL = (const float*)(F.ws + WS_AL);
    for (int it = gt; it < 64 * 128 * 16; it += NGT) {
        const int chain = it >> 11, rem = it & 2047, dv = rem >> 4, dk4 = (rem & 15) * 4;
        const int dir = chain & 1, h = (chain >> 1) & 7, b = chain >> 4;
        float S0 = 0.f, S1 = 0.f, S2 = 0.f, S3 = 0.f;
        const size_t base = (size_t)chain * 68 * 8192 + dv * 64 + dk4;
#pragma unroll 17
        for (int s = 0; s < 68; ++s) {
            const v2u uw = *(const v2u*)(UT + base + (size_t)s * 8192);
            const int rc = chain_slot_rc(b, dir, s);
            const f32x4 a = *(const f32x4*)(AL + (size_t)(dir * NRC + rc) * 512 + 64 * h + dk4);
            v2u o; if (dir) { o.x = pk2(S0 * a.x, S1 * a.y); o.y = pk2(S2 * a.z, S3 * a.w); } else { o.x = pk2(S0, S1); o.y = pk2(S2, S3); }
            *(v2u*)(ST + base + (size_t)s * 8192) = o;
            S0 = fmaf(a.x, S0, bflo(uw.x)); S1 = fmaf(a.y, S1, bfhi(uw.x)); S2 = fmaf(a.z, S2, bflo(uw.y)); S3 = fmaf(a.w, S3, bfhi(uw.y));
        }
    }
}

#define GLA_PK4(P, BASE, OUT) do { unsigned a0 = pk2(P[BASE + 0], P[BASE + 1]), a1 = pk2(P[BASE + 2], P[BASE + 3]);   \
    unsigned b0 = pk2(P[BASE + 4], P[BASE + 5]), b1 = pk2(P[BASE + 6], P[BASE + 7]);                              \
    auto r0 = __builtin_amdgcn_permlane32_swap(a0, b0, false, false); auto r1 = __builtin_amdgcn_permlane32_swap(a1, b1, false, false); \
    u32x4 w = {r0[0], r1[0], r0[1], r1[1]}; OUT = *reinterpret_cast<bf16x8*>(&w); } while (0)
template <int DIR>
__device__ __forceinline__ void g3_intra(f32x16& o, const LAS bf16* Kt, const LAS bf16* Qt, const LAS bf16* VT, int jb, int tb, int db, int r32, int hi) {
    f32x16 X = {};
#pragma unroll
    for (int ks = 0; ks < 4; ++ks) X = __builtin_amdgcn_mfma_f32_32x32x16_bf16(GLA_FRAG(Kt, 32 * jb + r32, 16 * ks + 8 * hi), GLA_FRAG(Qt, 32 * tb + r32, 16 * ks + 8 * hi), X, 0, 0, 0);
    if (jb == tb) {
#pragma unroll
        for (int r = 0; r < 16; ++r) { const int tj = crow(r, hi); const bool keep = DIR ? (tj >= r32) : (tj <= r32); X[r] = keep ? X[r] : 0.f; }
    }
    bf16x8 x0, x1; GLA_PK4(X, 0, x0); GLA_PK4(X, 8, x1);
    o = __builtin_amdgcn_mfma_f32_32x32x16_bf16(GLA_FRAG(VT, 32 * db + r32, 32 * jb + 8 * hi), x0, o, 0, 0, 0);
    o = __builtin_amdgcn_mfma_f32_32x32x16_bf16(GLA_FRAG(VT, 32 * db + r32, 32 * jb + 16 + 8 * hi), x1, o, 0, 0, 0);
}
__device__ __forceinline__ void ph_g3(Frame& F, int e, int nrc) {
    const bf16* P = (const bf16*)(F.ws + WS_P); const bf16* ST = (const bf16*)(F.ws + WS_ST); bf16* MIX = (bf16*)(F.ws + WS_MIX);
    const bf16* QFg = (const bf16*)(F.ws + WS_QF); const bf16* KFg = (const bf16*)(F.ws + WS_KF); const bf16* QBg = (const bf16*)(F.ws + WS_QB); const bf16* KBg = (const bf16*)(F.ws + WS_KB);
    const float* gg = (F.ka->in[I_GLAG]) + (size_t)e * 8 * 128;
    LAS bf16* VT = (LAS bf16*)(F.lds + RING_OFF); LAS bf16* QFl = VT + 128 * PITCH; LAS bf16* KFl = QFl + 64 * PITCH; LAS bf16* QBl = KFl + 64 * PITCH; LAS bf16* KBl = QBl + 64 * PITCH;
    LAS float* SS = (LAS float*)(KBl + 64 * PITCH);
    const int r32 = F.lane & 31, hi = F.lane >> 5, tb = F.wave & 1, db = F.wave >> 1;
    const int s_tp = (F.tid & 31) * 2, s_d8 = (F.tid >> 5) * 8, s_t = F.tid >> 3, s_c8 = (F.tid & 7) * 8;
    v4u pv0, pv1, pqf, pkf, pqb, pkb; bf16x8 nsf[4], nsb[4];
    const unsigned lo_v = (unsigned)(s_tp * DINP + s_d8), lo_g = (unsigned)(s_t * 512 + s_c8), lo_s = (unsigned)((32 * db + r32) * 64 + 8 * hi);
#define G3_LOAD(uu) do { const int _rc = (uu) >> 3, _h = (uu) & 7, _b = rc_batch(_rc); \
        const bf16* _vb = P + (size_t)_rc * 64 * DINP + C_VB + 128 * _h; pv0 = *(const v4u*)(_vb + lo_v); pv1 = *(const v4u*)(_vb + DINP + lo_v); \
        const size_t _gu = (size_t)_rc * 64 * 512 + 64 * _h; pqf = *(const v4u*)(QFg + _gu + lo_g); pkf = *(const v4u*)(KFg + _gu + lo_g); pqb = *(const v4u*)(QBg + _gu + lo_g); pkb = *(const v4u*)(KBg + _gu + lo_g); \
        const bf16* _sf = ST + ((size_t)((_b * 8 + _h) * 2 + 0) * 68 + rc_slot(_rc, 0)) * 8192; \
        const bf16* _sb = ST + ((size_t)((_b * 8 + _h) * 2 + 1) * 68 + rc_slot(_rc, 1)) * 8192; \
        _Pragma("unroll") for (int ks = 0; ks < 4; ++ks) { nsf[ks] = *(const bf16x8*)(_sf + lo_s + 16 * ks); nsb[ks] = *(const bf16x8*)(_sb + lo_s + 16 * ks); } } while (0)
    int u = blockIdx.x;
    if (u < nrc * 8) G3_LOAD(u);
    for (; u < nrc * 8; u += F.G) {
        const int rc = u >> 3, h = u & 7;
        GLA_BAR();
        { LAS unsigned* dst = (LAS unsigned*)(VT + s_d8 * PITCH + s_tp);
            dst[0 * (PITCH / 2)] = (pv0.x & 0xffffu) | (pv1.x << 16); dst[1 * (PITCH / 2)] = (pv0.x >> 16) | (pv1.x & 0xffff0000u);
            dst[2 * (PITCH / 2)] = (pv0.y & 0xffffu) | (pv1.y << 16); dst[3 * (PITCH / 2)] = (pv0.y >> 16) | (pv1.y & 0xffff0000u);
            dst[4 * (PITCH / 2)] = (pv0.z & 0xffffu) | (pv1.z << 16); dst[5 * (PITCH / 2)] = (pv0.z >> 16) | (pv1.z & 0xffff0000u);
            dst[6 * (PITCH / 2)] = (pv0.w & 0xffffu) | (pv1.w << 16); dst[7 * (PITCH / 2)] = (pv0.w >> 16) | (pv1.w & 0xffff0000u);
            const int lo = s_t * PITCH + s_c8;
            *(LAS v4u*)(QFl + lo) = pqf; *(LAS v4u*)(KFl + lo) = pkf; *(LAS v4u*)(QBl + lo) = pqb; *(LAS v4u*)(KBl + lo) = pkb; }
        bf16x8 sf[4], sb[4];
#pragma unroll
        for (int ks = 0; ks < 4; ++ks) { sf[ks] = nsf[ks]; sb[ks] = nsb[ks]; }
        GLA_BAR();
        if (u + F.G < nrc * 8) G3_LOAD(u + F.G);
        f32x16 o = {};
#pragma unroll
        for (int ks = 0; ks < 4; ++ks) { o = __builtin_amdgcn_mfma_f32_32x32x16_bf16(sf[ks], GLA_FRAG(QFl, 32 * tb + r32, 16 * ks + 8 * hi), o, 0, 0, 0);
            o = __builtin_amdgcn_mfma_f32_32x32x16_bf16(sb[ks], GLA_FRAG(QBl, 32 * tb + r32, 16 * ks + 8 * hi), o, 0, 0, 0); }
        if (tb == 0) { g3_intra<0>(o, KFl, QFl, VT, 0, 0, db, r32, hi); g3_intra<1>(o, KBl, QBl, VT, 0, 0, db, r32, hi); g3_intra<1>(o, KBl, QBl, VT, 1, 0, db, r32, hi); }
        else         { g3_intra<0>(o, KFl, QFl, VT, 0, 1, db, r32, hi); g3_intra<0>(o, KFl, QFl, VT, 1, 1, db, r32, hi); g3_intra<1>(o, KBl, QBl, VT, 1, 1, db, r32, hi); }
        float ss = 0.f;
#pragma unroll
        for (int r = 0; r < 16; ++r) ss = fmaf(o[r], o[r], ss);
        { auto rr = __builtin_amdgcn_permlane32_swap(__float_as_uint(ss), __float_as_uint(ss), false, false); ss = __uint_as_float(rr[0]) + __uint_as_float(rr[1]); }
        if (hi == 0) SS[db * 64 + 32 * tb + r32] = ss;
        GLA_BAR();
        const int t = 32 * tb + r32;
        const float tot = (SS[t] + SS[64 + t]) + (SS[128 + t] + SS[192 + t]);
        const float rn = __builtin_amdgcn_rsqf(tot * (1.0f / 128.0f) + EPS);
        const size_t row = (size_t)rc * 64 + t;
#pragma unroll
        for (int g4 = 0; g4 < 4; ++g4) { const int dv0 = 32 * db + 8 * g4 + 4 * hi;
            const v2u gw = *(const v2u*)(P + row * DINP + C_GB + 128 * h + dv0); const f32x4 gn = *(const f32x4*)(gg + 128 * h + dv0);
            const float g0 = bflo(gw.x), g1 = bfhi(gw.x), g2 = bflo(gw.y), g3 = bfhi(gw.y);
            const float y0 = o[4 * g4 + 0] * rn * gn.x * (g0 * __builtin_amdgcn_rcpf(1.0f + __expf(-g0))), y1 = o[4 * g4 + 1] * rn * gn.y * (g1 * __builtin_amdgcn_rcpf(1.0f + __expf(-g1)));
            const float y2 = o[4 * g4 + 2] * rn * gn.z * (g2 * __builtin_amdgcn_rcpf(1.0f + __expf(-g2))), y3 = o[4 * g4 + 3] * rn * gn.w * (g3 * __builtin_amdgcn_rcpf(1.0f + __expf(-g3)));
            v2u w; w.x = pk2(y0, y1); w.y = pk2(y2, y3);
            *(v2u*)(MIX + row * D + 1024 + 128 * h + dv0) = w; }
    }
#undef G3_LOAD
    __syncthreads();
}
#undef GLA_PK4
#undef GLA_FRAG
#undef GLA_BAR
}

constexpr int N_PHASES = 54;
__host__ __device__ constexpr bool phase_active(int id) {
    if (id == 0 || id == N_PHASES - 1) return true;
    const int L = (id - 1) / 13, k = (id - 1) % 13; const bool even = (L & 1) == 0;
    if (k == 1 || k == 8) return !even;
    if (k >= 2 && k <= 7) return even;
    return true;
}

__global__ void __launch_bounds__(NWAVES * 64, 2) fwd_kernel(Args args) {
    extern __shared__ __attribute__((aligned(16))) unsigned char lds[];
    Frame F;
    F.lds = (LAS unsigned char*)lds; F.ldsg = lds;
    F.MISC = (volatile LAS unsigned*)(F.lds + MISC_OFF);
    F.tid = threadIdx.x; F.lane = F.tid & 63; F.wave = __builtin_amdgcn_readfirstlane(F.tid >> 6);
    F.G = gridDim.x; { const int bx = blockIdx.x; F.vcu = (F.G % 8 == 0) ? (bx % 8) * (F.G / 8) + bx / 8 : bx; }
    F.ka = (KArgs)__builtin_amdgcn_kernarg_segment_ptr(); F.ws = F.ka->ws;
    for (int u = F.tid; u < (LDS_BYTES - LDSCTL_OFF) / 4; u += NWAVES * 64) ((LAS unsigned*)(F.lds + LDSCTL_OFF))[u] = 0u;
    __syncthreads();
    unsigned* barw = (unsigned*)(F.ws + WS_CTL) + CW_BAR;
    XcdBarrier bar = xcd_barrier_post(barw, F.MISC + 8);
    const int lo = args.ph_lo, hi = args.ph_hi;
    bool started = false;
#ifndef PH_MASK
#define PH_MASK 0xFFFFFFFFu
#endif
#ifndef PH_REP
#define PH_REP 0u
#endif
#define PHASE_BEGIN(id, kind) if (((PH_MASK >> (kind)) & 1u) && lo <= (id) && (id) < hi) { if (started) xcd_barrier(bar); started = true; for (int _rep = 0; _rep < (((PH_REP >> (kind)) & 1u) ? 2 : 1); ++_rep) { \
    { int _t = threadIdx.x; asm volatile("" : "+v"(_t)); F.tid = _t; F.lane = _t & 63; F.wave = __builtin_amdgcn_readfirstlane(_t >> 6); KArgs _k = (KArgs)__builtin_amdgcn_kernarg_segment_ptr(); asm volatile("" : "+s"(_k)); F.ka = _k; F.ws = _k->ws; }
#define PHASE_END } }

    PHASE_BEGIN(0, 0) ph_prologue(F); PHASE_END

    const float* MOD = (const float*)(F.ws + WS_MOD);
    for (int L = 0; L < DEPTH; ++L) {
        const int base = 1 + 13 * L; const bool even = (L & 1) == 0; const int e = L >> 1;
        const float* modl = MOD + (size_t)L * 5 * MODW;
#define XRc ((const float*)(F.ws + WS_XR) + (size_t)MLAT * D)
        const int rows_mix_in = (L <= 2) ? MR : MLAT;
        const int rows_upd = (L <= 1) ? MR : MLAT;

        PHASE_BEGIN(base + 0, 1) {
            ph_norm(F, rows_mix_in, L == 0 ? (F.ka->in[I_X]) : (const float*)nullptr, L == 0 ? (F.ka->in[I_CTX]) : XRc, (F.ka->in[I_N1G]) + (size_t)L * D, modl, 0, D, 4);
            if (L == 0) {
                const f32x4* cs = (const f32x4*)(F.ka->in[I_CTX]); f32x4* xd = (f32x4*)(F.ws + WS_XR) + (size_t)MLAT * D / 4;
                for (int i = F.vcu * NWAVES * 64 + F.tid; i < MCTX * D / 4; i += F.G * NWAVES * 64) xd[i] = cs[i];
            }
        } PHASE_END
        if (!even) {
            PHASE_BEGIN(base + 1, 2) ph_pool(F, rows_upd); PHASE_END
        }
        if (even) {
            PHASE_BEGIN(base + 2, 3) {
                pg8::Gemm g{(const pg8::bf16_t*)(F.ws + WS_H), (const pg8::bf16_t*)(F.ws + WS_WIN) + (size_t)e * DINP * D, MR, DINP, D, D, D, 1, 0, 0};
                pg8::StaticOrder S; S.init(MR, DINP, D, 1, F.G, (int)blockIdx.x);
                pg8::EpiBf16 E{(pg8::bf16_t*)(F.ws + WS_P), DINP};
                pg8::gemm_phase<pg8::EpiBf16, pg8::StaticOrder, false>(F.lds + RING_OFF, g, S, E, F.tid);
            } PHASE_END
            PHASE_BEGIN(base + 3, 4) {
                gla::ph_prep(F, e);
                if (L == 0) {
                    const na::bf16* P = (const na::bf16*)(F.ws + WS_P); na::bf16* MIX = (na::bf16*)(F.ws + WS_MIX);
                    for (int q = blockIdx.x; q < 48; q += F.G) { const int uc = q - 16; if (uc < 0) continue; const int b = uc >> 3, h = uc & 7;
                        na::na_unit<DINP, D>(P, C_QA + 128 * h, C_KA + 128 * h, C_VA + 128 * h, (long)MLAT + b * CTXL, (long)MLAT + b * CTXL, 0, 0, 0, 0,
                                             MIX, 128 * h, (F.ka->in[I_RPB]), (char*)lds + RING_OFF, F.tid); }
                }
            } PHASE_END
            PHASE_BEGIN(base + 4, 5) {
                gla::ph_g1(F);
                const na::bf16* P = (const na::bf16*)(F.ws + WS_P); na::bf16* MIX = (na::bf16*)(F.ws + WS_MIX);
                for (int u = F.vcu; u < 512; u += F.G) { const int b = u >> 7, h = (u >> 4) & 7, i = u & 15;
                    const int klo = i == 0 ? 0 : (i == 15 ? 56 : 4 * i - 4), nband = (i == 0 || i == 15) ? 8 : 12;
                    na::na_unit<DINP, D>(P, C_QA + 128 * h, C_KA + 128 * h, C_VA + 128 * h, (long)b * SEQ + 256 * i, (long)MLAT + b * CTXL, (long)b * SEQ + 64 * klo, nband, klo, 4 * i,
                                         MIX, 128 * h, (F.ka->in[I_RPB]) + ((size_t)e * 8 + h) * 15 * 31, (char*)lds + RING_OFF, F.tid); }
            } PHASE_END
            PHASE_BEGIN(base + 5, 6) {
                gla::ph_g2(F);
            } PHASE_END
            PHASE_BEGIN(base + 6, 7) gla::ph_g3(F, e, L == 0 ? MR / 64 : MLAT / 64); PHASE_END
            PHASE_BEGIN(base + 7, 8) {
                const int M = rows_upd;
                pg8::Gemm g{(const pg8::bf16_t*)(F.ws + WS_MIX), (const pg8::bf16_t*)(F.ws + WS_WOUT) + (size_t)e * D * D, M, D, D, D, D, 1, 0, 0};
                pg8::SplitTailOrder S; S.init(MLAT, M - MLAT, D, D, 4, F.G, (int)blockIdx.x);
                pg8::EpiResid E{(float*)(F.ws + WS_PART), (pg8::bf16_t*)(F.ws + WS_X16), D, modl + 2 * D, MODW, nullptr, 0, MLAT, MCTX};
                pg8::gemm_phase<pg8::EpiResid, pg8::SplitTailOrder, true>(F.lds + RING_OFF, g, S, E, F.tid);
            } PHASE_END
        } else {
            PHASE_BEGIN(base + 8, 9) {
                const int M = rows_upd;
                pg8::Gemm g{(const pg8::bf16_t*)(F.ws + WS_MIX), (const pg8::bf16_t*)(F.ws + WS_WPOOL) + (size_t)e * 4 * 512 * 512, M, 512, 512, D, 512, 4, (size_t)512 * 2, (size_t)512 * 512 * 2};
                pg8::StaticOrder S; S.init(M, 512, 512, 4, F.G, (int)blockIdx.x);
                pg8::EpiResid E{(float*)(F.ws + WS_PART), (pg8::bf16_t*)(F.ws + WS_X16), D, modl + 2 * D, MODW, (F.ka->in[I_POOLS]) + (size_t)e * D, 512, MLAT, MCTX};
                pg8::gemm_phase<pg8::EpiResid, pg8::StaticOrder, true>(F.lds + RING_OFF, g, S, E, F.tid);
            } PHASE_END
        }
        PHASE_BEGIN(base + 9, 10) ph_norm(F, rows_upd, (const float*)nullptr, XRc, (F.ka->in[I_N2G]) + (size_t)L * D, modl, 3 * D, 4 * D, even ? 4 : 1); PHASE_END
        PHASE_BEGIN(base + 10, 11) {
            const int M = rows_upd;
            pg8::Gemm g{(const pg8::bf16_t*)(F.ws + WS_H), (const pg8::bf16_t*)(F.ws + WS_WUP) + (size_t)L * DUP * D, M, DUP, D, D, D, 1, 0, 0};
            pg8::StaticOrder S; S.init(M, DUP, D, 1, F.G, (int)blockIdx.x);
            pg8::EpiGlu E{(pg8::bf16_t*)(F.ws + WS_ACT), LDF, (F.ka->in[I_CONVW]) + (size_t)L * 3 * DFF, (F.ka->in[I_CONVB]) + (size_t)L * DFF, (float*)(F.ws + WS_SB), DFF, (PG8_LAS float*)(F.lds + RING_OFF + 131072)};
            pg8::gemm_phase<pg8::EpiGlu, pg8::StaticOrder, true>(F.lds + RING_OFF, g, S, E, F.tid);
        } PHASE_END
        PHASE_BEGIN(base + 11, 12) ph_glufix(F, rows_upd, (F.ka->in[I_CONVW]) + (size_t)L * 3 * DFF, (F.ka->in[I_CONVB]) + (size_t)L * DFF); PHASE_END
        PHASE_BEGIN(base + 12, 13) {
            const int M = rows_upd;
            pg8::Gemm g{(const pg8::bf16_t*)(F.ws + WS_ACT), (const pg8::bf16_t*)(F.ws + WS_WDOWN) + (size_t)L * D * LDF, M, D, DFF, LDF, LDF, 1, 0, 0};
            pg8::SplitTailOrder S; S.init(MLAT, M - MLAT, D, DFF, 4, F.G, (int)blockIdx.x);
            pg8::EpiResid E{(float*)(F.ws + WS_PART), (pg8::bf16_t*)(F.ws + WS_X16), D, modl + 5 * D, MODW, nullptr, 0, MLAT, MCTX};
            pg8::gemm_phase<pg8::EpiResid, pg8::SplitTailOrder, true>(F.lds + RING_OFF, g, S, E, F.tid);
        } PHASE_END
    }
#ifdef XTRA_BARRIERS
    for (int xb = 0; xb < XTRA_BARRIERS; ++xb) xcd_barrier(bar);
#endif
    PHASE_BEGIN(N_PHASES - 1, 14) ph_final(F); PHASE_END
#undef PHASE_BEGIN
#undef PHASE_END
#undef XRc
}

#ifndef MK_PER_PHASE
#define MK_PER_PHASE 0
#endif
extern "C" void kernel_launch(void* const* d_in, const int* in_sizes, int n_in, void* d_out, int out_size, void* d_ws, size_t ws_size, hipStream_t stream) {
    static int grid = 0;
    if (grid == 0) {
        if (n_in != 21 || in_sizes[0] != MLAT * D || out_size != MLAT * D || ws_size < WS_END) {
            fprintf(stderr, "kernel_launch: shape mismatch: n_in %d in0 %d out %d ws %zu (need %zu); nothing launched\n", n_in, n_in > 0 ? in_sizes[0] : -1, out_size, ws_size, (size_t)WS_END); grid = -1; return; }
        int dev = 0, cus = 0, per_cu = 0;
        if (hipGetDevice(&dev) != hipSuccess || hipDeviceGetAttribute(&cus, hipDeviceAttributeMultiprocessorCount, dev) != hipSuccess) { fprintf(stderr, "kernel_launch: device query failed\n"); grid = -1; return; }
        if (hipFuncSetAttribute((const void*)fwd_kernel, hipFuncAttributeMaxDynamicSharedMemorySize, LDS_BYTES) != hipSuccess) { fprintf(stderr, "kernel_launch: hipFuncSetAttribute failed\n"); grid = -1; return; }
        if (hipOccupancyMaxActiveBlocksPerMultiprocessor(&per_cu, (const void*)fwd_kernel, NWAVES * 64, LDS_BYTES) != hipSuccess || per_cu < 1) {
            fprintf(stderr, "kernel_launch: occupancy query reports %d workgroups per CU\n", per_cu); }
        (void)hipGetLastError();
        grid = cus;
    }
    if (grid < 0) return;
    if (hipMemsetAsync((char*)d_ws + WS_CTL, 0, CTL_ZERO_BYTES, stream) != hipSuccess) { fprintf(stderr, "kernel_launch: memset failed\n"); return; }
    Args a{};
    for (int i = 0; i < 21; ++i) a.in[i] = (const float*)d_in[i];
    a.out = (float*)d_out; a.ws = (unsigned char*)d_ws;
#if MK_PER_PHASE
    for (int p = 0; p < N_PHASES; ++p) { if (!phase_active(p)) continue; a.ph_lo = p; a.ph_hi = p + 1;
        hipLaunchKernelGGL(fwd_kernel, dim3(grid), dim3(NWAVES * 64), LDS_BYTES, stream, a); }
#else
    a.ph_lo = 0; a.ph_hi = N_PHASES;
    hipLaunchKernelGGL(fwd_kernel, dim3(grid), dim3(NWAVES * 64), LDS_BYTES, stream, a);
#endif
    const hipError_t le = hipPeekAtLastError();
    if (le != hipSuccess) fprintf(stderr, "kernel_launch: launch failed: %s\n", hipGetErrorName(le));
}
```
